# Optimizing an MI355X kernel written in HIP

```python
import math
import jax, jax.numpy as jnp
from jax import lax
import numpy as np

D_MODEL = 1024
BATCH = 1
SEQ = 16384
DEPTH = 1

D_MIX = D_MODEL
ATTN_WIDTH = D_MIX // 2
HEAD_DIM = 64
N_HEADS = ATTN_WIDTH // HEAD_DIM
WINDOWS = (128, 512, 2048)
DILATIONS = (1, 4, 16)
BLOCK = 128
PAD_UNIT = max(DILATIONS) * BLOCK
SSM_WIDTH = D_MIX - ATTN_WIDTH
SSM_GROUP = 16
SSM_GROUPS = SSM_WIDTH // SSM_GROUP
SSM_STATE = 64
D_FF = 4 * D_MODEL
PROJ_WIDTH = 3 * ATTN_WIDTH + SSM_WIDTH
EPS = 1e-6
NEG_INF = -1e30
DT_MIN, DT_MAX = 1e-3, 1e-1

kernel_name = "hymba_longnet_s5_hybrid"


def _rmsnorm(x, g):
    xf = x.astype(jnp.float32)
    y = xf * lax.rsqrt(jnp.mean(xf * xf, axis=-1, keepdims=True) + EPS)
    return (y * g.astype(jnp.float32)).astype(x.dtype)


def _dilated_window(q, k, v, dilation, steps):
    b, sp, h, e = q.shape
    n = sp // dilation
    nb = n // BLOCK

    def to_blocks(t):
        t = t.reshape(b, n, dilation, h, e).transpose(0, 2, 3, 1, 4)
        return t.reshape(b, dilation, h, nb, BLOCK, e)

    qb, kb, vb = to_blocks(q), to_blocks(k), to_blocks(v)

    def with_prev(t):
        prev = jnp.pad(t[:, :, :, :-1], ((0, 0), (0, 0), (0, 0), (1, 0), (0, 0), (0, 0)))
        return jnp.concatenate([prev, t], axis=4)

    kw, vw = with_prev(kb), with_prev(vb)
    s = jnp.einsum('brhnqe,brhnke->brhnqk', qb, kw) * (HEAD_DIM ** -0.5)
    qi = jnp.arange(BLOCK)[:, None] + BLOCK
    ki = jnp.arange(2 * BLOCK)[None, :]
    dist = qi - ki
    band = (dist >= 0) & (dist <= steps)
    valid = (jnp.arange(nb)[:, None, None] * BLOCK - BLOCK + ki[None]) >= 0
    mask = band[None] & valid
    s = jnp.where(mask, s, NEG_INF)
    m = jnp.max(s, axis=-1)
    p = jnp.exp(s - m[..., None])
    l = jnp.sum(p, axis=-1)
    acc = jnp.einsum('brhnqk,brhnke->brhnqe', p, vw)

    def to_seq(t):
        t = t.reshape((b, dilation, h, n) + t.shape[5:])
        t = jnp.moveaxis(t, 3, 1)
        return t.reshape((b, sp, h) + t.shape[4:])

    return to_seq(acc), to_seq(m), to_seq(l)


def _dilated_attention(q, k, v):
    b, s, h, e = q.shape
    pad = (-s) % PAD_UNIT
    qf, kf, vf = [jnp.pad(t.astype(jnp.float32), ((0, 0), (0, pad), (0, 0), (0, 0))) for t in (q, k, v)]
    accs, ms, ls = [], [], []
    for w, d in zip(WINDOWS, DILATIONS):
        acc, m, l = _dilated_window(qf, kf, vf, d, w // d)
        accs.append(acc)
        ms.append(m)
        ls.append(l)
    m_all = jnp.stack(ms)
    wts = jnp.exp(m_all - jnp.max(m_all, axis=0, keepdims=True))
    num = jnp.sum(jnp.stack(accs) * wts[..., None], axis=0)
    den = jnp.sum(jnp.stack(ls) * wts, axis=0)
    out = num / den[..., None]
    return out[:, :s].astype(v.dtype)


def _complex_linear_combine(e1, e2):
    a1r, a1i, b1r, b1i = e1
    a2r, a2i, b2r, b2i = e2
    return (a2r * a1r - a2i * a1i,
            a2r * a1i + a2i * a1r,
            a2r * b1r - a2i * b1i + b2r,
            a2r * b1i + a2i * b1r + b2i)


def _s5_mixer(u, a_re, a_im, log_dt, b_re, b_im, c_re, c_im, d_skip, glu_w, glu_b):
    b, s, _ = u.shape
    f32 = jnp.float32
    uf = u.astype(f32).reshape(b, s, SSM_GROUPS, SSM_GROUP)
    lr, li = a_re.astype(f32), a_im.astype(f32)
    dt = jnp.exp(log_dt.astype(f32))[:, None]
    mag = jnp.exp(lr * dt)
    ab_r, ab_i = mag * jnp.cos(li * dt), mag * jnp.sin(li * dt)
    den = lr * lr + li * li
    nr, ni = ab_r - 1.0, ab_i
    cr = (nr * lr + ni * li) / den
    ci = (ni * lr - nr * li) / den
    br, bi = b_re.astype(f32), b_im.astype(f32)
    bb_r = cr[..., None] * br - ci[..., None] * bi
    bb_i = cr[..., None] * bi + ci[..., None] * br
    bu_r = jnp.einsum('bsgc,gpc->bsgp', uf, bb_r)
    bu_i = jnp.einsum('bsgc,gpc->bsgp', uf, bb_i)
    a_r = jnp.broadcast_to(ab_r, bu_r.shape)
    a_i = jnp.broadcast_to(ab_i, bu_i.shape)
    _, _, xr, xi = lax.associative_scan(_complex_linear_combine, (a_r, a_i, bu_r, bu_i), axis=1)
    y = (jnp.einsum('bsgp,gcp->bsgc', xr, c_re.astype(f32))
         - jnp.einsum('bsgp,gcp->bsgc', xi, c_im.astype(f32))
         + d_skip.astype(f32) * uf)
    y = y.reshape(b, s, SSM_WIDTH)
    z = jax.nn.gelu(y)
    out = z * jax.nn.sigmoid(z @ glu_w.astype(f32) + glu_b.astype(f32))
    return out.astype(u.dtype)


def _hybrid_layer(x, norm1_g, w_in, q_norm_g, k_norm_g, ssm_a_re, ssm_a_im, ssm_log_dt,
                  ssm_b_re, ssm_b_im, ssm_c_re, ssm_c_im, ssm_d, glu_w, glu_b,
                  attn_out_norm_g, ssm_out_norm_g, w_out, norm2_g, w_mlp_up, w_mlp_down):
    b, s, _ = x.shape
    xn = _rmsnorm(x, norm1_g)
    proj = xn @ w_in
    q = proj[..., :ATTN_WIDTH].reshape(b, s, N_HEADS, HEAD_DIM)
    k = proj[..., ATTN_WIDTH:2 * ATTN_WIDTH].reshape(b, s, N_HEADS, HEAD_DIM)
    v = proj[..., 2 * ATTN_WIDTH:3 * ATTN_WIDTH].reshape(b, s, N_HEADS, HEAD_DIM)
    u = proj[..., 3 * ATTN_WIDTH:]
    q = _rmsnorm(q, q_norm_g)
    k = _rmsnorm(k, k_norm_g)
    attn = _dilated_attention(q, k, v).reshape(b, s, ATTN_WIDTH)
    ssm = _s5_mixer(u, ssm_a_re, ssm_a_im, ssm_log_dt, ssm_b_re, ssm_b_im,
                    ssm_c_re, ssm_c_im, ssm_d, glu_w, glu_b)
    mix = jnp.concatenate([_rmsnorm(attn, attn_out_norm_g), _rmsnorm(ssm, ssm_out_norm_g)], axis=-1)
    x = x + mix @ w_out
    hdn = jnp.square(jax.nn.relu(_rmsnorm(x, norm2_g) @ w_mlp_up))
    return x + hdn @ w_mlp_down


def setup_inputs(seed: int = 0) -> dict:
    key = jax.random.key(seed)
    ks = jax.random.split(key, 20)
    L, G, P, C = DEPTH, SSM_GROUPS, SSM_STATE, SSM_GROUP
    nrm = lambda k, shape, scale: jax.random.normal(k, shape, jnp.float32) * scale
    x = nrm(ks[0], (BATCH, SEQ, D_MODEL), 1.0)
    norm1_g = 1.0 + nrm(ks[1], (L, D_MODEL), 0.02)
    w_in = nrm(ks[2], (L, D_MODEL, PROJ_WIDTH), D_MODEL ** -0.5)
    q_norm_g = 1.0 + nrm(ks[3], (L, HEAD_DIM), 0.02)
    k_norm_g = 1.0 + nrm(ks[4], (L, HEAD_DIM), 0.02)
    ssm_a_re = -0.5 + nrm(ks[5], (L, G, P), 0.01)
    ssm_a_im = math.pi * jnp.arange(P, dtype=jnp.float32)[None, None, :] + nrm(ks[6], (L, G, P), 0.01)
    ssm_log_dt = jax.random.uniform(ks[7], (L, G), jnp.float32, math.log(DT_MIN), math.log(DT_MAX))
    ssm_b_re = nrm(ks[8], (L, G, P, C), (2 * C) ** -0.5)
    ssm_b_im = nrm(ks[9], (L, G, P, C), (2 * C) ** -0.5)
    ssm_c_re = nrm(ks[10], (L, G, C, P), (2 * P) ** -0.5)
    ssm_c_im = nrm(ks[11], (L, G, C, P), (2 * P) ** -0.5)
    ssm_d = nrm(ks[12], (L, G, C), 1.0)
    glu_w = nrm(ks[13], (L, SSM_WIDTH, SSM_WIDTH), SSM_WIDTH ** -0.5)
    glu_b = nrm(ks[14], (L, SSM_WIDTH), 0.01)
    attn_out_norm_g = 1.0 + nrm(ks[15], (L, ATTN_WIDTH), 0.02)
    ssm_out_norm_g = 1.0 + nrm(ks[16], (L, SSM_WIDTH), 0.02)
    w_out = nrm(ks[17], (L, D_MIX, D_MODEL), D_MIX ** -0.5)
    norm2_g = 1.0 + nrm(ks[18], (L, D_MODEL), 0.02)
    k_up, k_down = jax.random.split(ks[19])
    w_mlp_up = nrm(k_up, (L, D_MODEL, D_FF), D_MODEL ** -0.5)
    w_mlp_down = nrm(k_down, (L, D_FF, D_MODEL), D_FF ** -0.5)
    return {"x": x, "norm1_g": norm1_g, "w_in": w_in, "q_norm_g": q_norm_g, "k_norm_g": k_norm_g,
            "ssm_a_re": ssm_a_re, "ssm_a_im": ssm_a_im, "ssm_log_dt": ssm_log_dt,
            "ssm_b_re": ssm_b_re, "ssm_b_im": ssm_b_im, "ssm_c_re": ssm_c_re, "ssm_c_im": ssm_c_im,
            "ssm_d": ssm_d, "glu_w": glu_w, "glu_b": glu_b,
            "attn_out_norm_g": attn_out_norm_g, "ssm_out_norm_g": ssm_out_norm_g,
            "w_out": w_out, "norm2_g": norm2_g, "w_mlp_up": w_mlp_up, "w_mlp_down": w_mlp_down}


def reference(x, norm1_g, w_in, q_norm_g, k_norm_g, ssm_a_re, ssm_a_im, ssm_log_dt,
              ssm_b_re, ssm_b_im, ssm_c_re, ssm_c_im, ssm_d, glu_w, glu_b,
              attn_out_norm_g, ssm_out_norm_g, w_out, norm2_g, w_mlp_up, w_mlp_down):
    h = x
    for l in range(DEPTH):
        h = _hybrid_layer(h, norm1_g[l], w_in[l], q_norm_g[l], k_norm_g[l], ssm_a_re[l], ssm_a_im[l],
                          ssm_log_dt[l], ssm_b_re[l], ssm_b_im[l], ssm_c_re[l], ssm_c_im[l], ssm_d[l],
                          glu_w[l], glu_b[l], attn_out_norm_g[l], ssm_out_norm_g[l], w_out[l],
                          norm2_g[l], w_mlp_up[l], w_mlp_down[l])
    return h
```

```cpp
#include <hip/hip_runtime.h>
#include <cstdio>
#include <cstdint>

#ifndef MK_SPLIT
#define MK_SPLIT 0
#endif

constexpr int M = 16384, D = 1024, AW = 512, HD = 64, NH = 8, SW = 512, SG = 16, NG = 32, SP = 64, FF = 4096, PW = 2048;
constexpr float EPS = 1e-6f;
constexpr float C2 = 0.125f * 1.4426950408889634f;
constexpr int TILE = 256, LCH = 16, NCH = TILE / LCH, NTILE = M / TILE;
constexpr int NWAVES = 8, NTHREADS = 512;

constexpr size_t MiB = 1u << 20;
constexpr size_t WS_CTL = 0, CTL_ZERO_BYTES = 1 * MiB;
constexpr size_t WS_TM = 1 * MiB;
constexpr size_t WS_WST = 2 * MiB;
constexpr size_t WS_WCR = 4 * MiB;
constexpr size_t WS_ALP = 6 * MiB;
constexpr size_t WS_ATP = 7 * MiB;
constexpr size_t WS_WIN = 8 * MiB, WS_WGLU = 12 * MiB, WS_WOUT = 13 * MiB, WS_WUP = 15 * MiB, WS_WDOWN = 23 * MiB;
constexpr size_t WS_SSQA = 31 * MiB, WS_SSQS = 31 * MiB + 512 * 1024, WS_SSQ2 = 32 * MiB;
constexpr size_t WS_STILE = 34 * MiB;
constexpr size_t WS_XLOC = 35 * MiB;
constexpr size_t WS_XN = 52 * MiB;
constexpr size_t WS_H = 84 * MiB;
constexpr size_t WS_Q = 84 * MiB, WS_K = 100 * MiB, WS_V = 116 * MiB, WS_U = 132 * MiB, WS_ATT = 148 * MiB, WS_Z = 164 * MiB, WS_SSMO = 180 * MiB;
constexpr size_t WS_END = 212 * MiB;
constexpr int CW_BAR = 4096;

constexpr int LDS_BYTES = 147456;
constexpr int MISC_OFF = 131072 + 320;

#define GAS __attribute__((address_space(1)))
#define LAS __attribute__((address_space(3)))
typedef unsigned short bf16;
typedef unsigned v4u __attribute__((ext_vector_type(4)));
typedef float f32x4 __attribute__((ext_vector_type(4)));
typedef float f32x2 __attribute__((ext_vector_type(2)));

__device__ __forceinline__ unsigned f2bf(float f) { unsigned u = __builtin_bit_cast(unsigned, f); return (u + 0x7fffu + ((u >> 16) & 1u)) >> 16; }
__device__ __forceinline__ unsigned pk2(float lo, float hi) { return f2bf(lo) | (f2bf(hi) << 16); }
__device__ __forceinline__ float bf2f(bf16 h) { return __builtin_bit_cast(float, (unsigned)h << 16); }
__device__ __forceinline__ float bflo(unsigned w) { return __builtin_bit_cast(float, w << 16); }
__device__ __forceinline__ float bfhi(unsigned w) { return __builtin_bit_cast(float, w & 0xffff0000u); }
__device__ __forceinline__ float wave_sum(float v) {
#pragma unroll
    for (int o = 1; o < 64; o <<= 1) v += __shfl_xor(v, o);
    return v;
}
__device__ __forceinline__ float dot8(v4u a, v4u b) {
    return bflo(a.x) * bflo(b.x) + bfhi(a.x) * bfhi(b.x) + bflo(a.y) * bflo(b.y) + bfhi(a.y) * bfhi(b.y)
         + bflo(a.z) * bflo(b.z) + bfhi(a.z) * bfhi(b.z) + bflo(a.w) * bflo(b.w) + bfhi(a.w) * bfhi(b.w);
}
__device__ __forceinline__ float dot_bf16(const bf16* a, const bf16* b, int K) {
    float acc = 0.f;
    for (int k = 0; k < K; k += 8) acc += dot8(*(const v4u*)(a + k), *(const v4u*)(b + k));
    return acc;
}

#define XB_TMO      128
#define XB_XCNT(j)  (256  + 64 * (j))
#define XB_XSUB(j)  (1280 + 64 * (j))
#define XB_XGEN(j)  (2304 + 64 * (j))
#define XB_TOP      3328
#define XB_TOPGEN   3392
#define XCD_BAR_WORDS 3456
#define XB_SPIN_CAP (1u << 18)
__device__ __forceinline__ unsigned xb_ld(unsigned* p)              { return __hip_atomic_load(p, __ATOMIC_RELAXED, __HIP_MEMORY_SCOPE_AGENT); }
__device__ __forceinline__ unsigned xb_add(unsigned* p, unsigned v) { return __hip_atomic_fetch_add(p, v, __ATOMIC_RELAXED, __HIP_MEMORY_SCOPE_AGENT); }
__device__ __forceinline__ unsigned xb_xcc_id() { return (unsigned)__builtin_amdgcn_s_getreg((3 << 11) | 20) & 0xFu; }
#define XB_SPIN(cond, bar) do { unsigned _sp = 0; while (cond) { __builtin_amdgcn_s_sleep(1); \
    if ((++_sp & 255u) == 0u) { if (xb_ld(&(bar)[XB_TMO])) break; if (_sp > XB_SPIN_CAP) { atomicAdd(&(bar)[XB_TMO], 1u); break; } } } } while (0)
struct XcdBarrier { unsigned* bar; unsigned x; volatile LAS unsigned* st; };
__device__ __forceinline__ XcdBarrier xcd_barrier_post(unsigned* bar, volatile LAS unsigned* st) {
    XcdBarrier b; b.bar = bar; b.x = xb_xcc_id(); b.st = st;
    if (threadIdx.x == 0) (void)xb_add(&bar[XB_XCNT(b.x)], 1u);
    return b;
}
__device__ __forceinline__ void xcd_barrier_complete(unsigned* bar, unsigned x, unsigned& nloc, unsigned& nx) {
    const unsigned G = gridDim.x * gridDim.y * gridDim.z;
    unsigned sum, cnt, mine, sp = 0u;
    for (;;) {
        sum = 0u; cnt = 0u; mine = 0u;
#pragma unroll
        for (unsigned j = 0; j < 16; ++j) { const unsigned c = xb_ld(&bar[XB_XCNT(j)]); sum += c; cnt += (c > 0u) ? 1u : 0u; mine = (j == x) ? c : mine; }
        if (sum == G) break;
        __builtin_amdgcn_s_sleep(1);
        if ((++sp & 255u) == 0u) { if (xb_ld(&bar[XB_TMO])) break; if (sp > XB_SPIN_CAP) { atomicAdd(&bar[XB_TMO], 1u); break; } }
    }
    nloc = mine > 0u ? mine : 1u; nx = cnt > 0u ? cnt : 1u;
}
__device__ __forceinline__ void xcd_barrier(const XcdBarrier& b) {
    asm volatile("s_waitcnt vmcnt(0)" ::: "memory");
    __syncthreads();
    if (threadIdx.x == 0) {
        unsigned* bar = b.bar;
        __builtin_amdgcn_s_waitcnt(0);
        unsigned nloc = b.st[0], nx = b.st[1];
        if (nloc == 0u) { xcd_barrier_complete(bar, b.x, nloc, nx); b.st[0] = nloc; b.st[1] = nx; }
        const unsigned old = xb_add(&bar[XB_XSUB(b.x)], 1u);
        const unsigned gen = old / nloc;
        if (old + 1u == (gen + 1u) * nloc) {
            __builtin_amdgcn_fence(__ATOMIC_RELEASE, "agent");
            asm volatile("s_waitcnt vmcnt(0)" ::: "memory");
            const unsigned og = xb_add(&bar[XB_TOP], 1u);
            const unsigned tg = og / nx;
            if (og + 1u == (tg + 1u) * nx) xb_add(&bar[XB_TOPGEN], 1u);
            else XB_SPIN(xb_ld(&bar[XB_TOPGEN]) == tg, bar);
            __builtin_amdgcn_fence(__ATOMIC_ACQUIRE, "agent");
            xb_add(&bar[XB_XGEN(b.x)], 1u);
            asm volatile("s_waitcnt vmcnt(0)" ::: "memory");
        } else {
            XB_SPIN(xb_ld(&bar[XB_XGEN(b.x)]) == gen, bar);
            __builtin_amdgcn_fence(__ATOMIC_ACQUIRE, "agent");
            asm volatile("s_waitcnt vmcnt(0)" ::: "memory");
        }
    }
    __syncthreads();
}

struct Args { const float* in[21]; float* out; unsigned char* ws; int ph_lo, ph_hi; };
struct Frame {
    LAS unsigned char* lds;
    int tid, lane, wave, G, bid;
    const float* in[21]; float* out; unsigned char* ws;
};
#define P_X 0
#define P_G1 1
#define P_WIN 2
#define P_GQ 3
#define P_GK 4
#define P_ARE 5
#define P_AIM 6
#define P_LDT 7
#define P_BRE 8
#define P_BIM 9
#define P_CRE 10
#define P_CIM 11
#define P_DSK 12
#define P_GLUW 13
#define P_GLUB 14
#define P_GA 15
#define P_GS 16
#define P_WOUT 17
#define P_G2 18
#define P_WUP 19
#define P_WDOWN 20

__device__ __forceinline__ void p0_transpose_item(const float* W, int K, int N, bf16* WT, const float* g_lo, const float* g_hi, int split, LAS float* scr, int item, int lane) {
    const int nblk = N / 32, kb = item / nblk, nb = item % nblk, k0 = 64 * kb, n0 = 32 * nb;
#pragma unroll 8
    for (int i = 0; i < 32; ++i) { const int kk = 2 * i + (lane >> 5); const int k = k0 + kk;
        const float g = g_lo ? (k < split ? g_lo[k] : g_hi[k - split]) : 1.f;
        scr[kk * 33 + (lane & 31)] = W[(size_t)k * N + n0 + (lane & 31)] * g; }
    asm volatile("s_waitcnt lgkmcnt(0)" ::: "memory");
    const int c = lane & 7;
#pragma unroll
    for (int j = 0; j < 4; ++j) { const int n = (lane >> 3) + 8 * j; const LAS float* s = scr + (8 * c) * 33 + n;
        v4u o; o.x = pk2(s[0 * 33], s[1 * 33]); o.y = pk2(s[2 * 33], s[3 * 33]); o.z = pk2(s[4 * 33], s[5 * 33]); o.w = pk2(s[6 * 33], s[7 * 33]);
        *(GAS v4u*)(WT + (size_t)(n0 + n) * K + k0 + 8 * c) = o; }
    asm volatile("s_waitcnt lgkmcnt(0)" ::: "memory");
}
__device__ __forceinline__ void rms_row_to_bf16(const float* xrow, bf16* orow, int lane) {
    const GAS f32x4* xr = (const GAS f32x4*)xrow + lane;
    f32x4 v[4]; float s = 0.f;
#pragma unroll
    for (int j = 0; j < 4; ++j) { v[j] = xr[64 * j]; s += (v[j].x * v[j].x + v[j].y * v[j].y) + (v[j].z * v[j].z + v[j].w * v[j].w); }
    const float rstd = 1.f / sqrtf(wave_sum(s) * (1.f / D) + EPS);
    GAS unsigned long long* o8 = (GAS unsigned long long*)orow + lane;
#pragma unroll
    for (int j = 0; j < 4; ++j) o8[64 * j] = (unsigned long long)pk2(v[j].x * rstd, v[j].y * rstd) | ((unsigned long long)pk2(v[j].z * rstd, v[j].w * rstd) << 32);
}
struct cd { double re, im; };
__device__ __forceinline__ cd cmul(cd a, cd b) { return cd{a.re * b.re - a.im * b.im, a.re * b.im + a.im * b.re}; }
__device__ __forceinline__ void p0_ssm_tables(Frame& F, int g) {
    cd* apow = (cd*)(__attribute__((address_space(3))) cd*)(F.lds);
    cd* bbar = apow + 17 * 64;
    cd* cc = bbar + 64 * 16;
    const float* a_re = F.in[P_ARE] + g * 64; const float* a_im = F.in[P_AIM] + g * 64;
    const double dt = exp((double)F.in[P_LDT][g]);
    const int tid = F.tid;
    for (int i = tid; i < 17 * 64; i += NTHREADS) { const int j = i >> 6, p = i & 63; const double lr = a_re[p], li = a_im[p];
        const double mag = exp(j * lr * dt), ang = j * li * dt; apow[i] = cd{mag * cos(ang), mag * sin(ang)}; }
    for (int i = tid; i < 64 * 16; i += NTHREADS) { const int p = i >> 4, c = i & 15; const double lr = a_re[p], li = a_im[p];
        const double mag = exp(lr * dt), ang = li * dt; const double abr = mag * cos(ang), abi = mag * sin(ang);
        const double den = lr * lr + li * li, nr = abr - 1.0, ni = abi; const double cr = (nr * lr + ni * li) / den, ci = (ni * lr - nr * li) / den;
        const double br = F.in[P_BRE][(g * 64 + p) * 16 + c], bi = F.in[P_BIM][(g * 64 + p) * 16 + c];
        bbar[i] = cd{cr * br - ci * bi, cr * bi + ci * br}; }
    for (int i = tid; i < 16 * 64; i += NTHREADS) cc[i] = cd{(double)F.in[P_CRE][g * 1024 + i], (double)F.in[P_CIM][g * 1024 + i]};
    __syncthreads();
    bf16* TM = (bf16*)(F.ws + WS_TM) + (size_t)g * 17 * 256;
    bf16* WST = (bf16*)(F.ws + WS_WST) + (size_t)g * 128 * 256;
    bf16* WCR = (bf16*)(F.ws + WS_WCR) + (size_t)g * 256 * 128;
    f32x2* ALP = (f32x2*)(F.ws + WS_ALP) + (size_t)g * 16 * 64;
    f32x2* ATP = (f32x2*)(F.ws + WS_ATP) + (size_t)g * 64 * 64;
    for (int i = tid; i < 17 * 256; i += NTHREADS) { const int l1 = i >> 8, c = (i >> 4) & 15, c2 = i & 15; double s = 0.0;
        if (l1 > 0) { const int lag = l1 - 1;
            for (int p = 0; p < 64; ++p) { const cd t = cmul(cmul(cc[c * 64 + p], apow[lag * 64 + p]), bbar[p * 16 + c2]); s += t.re; }
            if (lag == 0 && c == c2) s += (double)F.in[P_DSK][g * 16 + c]; }
        TM[i] = (bf16)f2bf((float)s); }
    for (int i = tid; i < 128 * 256; i += NTHREADS) { const int q = i >> 8, k = i & 255, s = k >> 4, c2 = k & 15, p = q & 63;
        const cd w = cmul(apow[(15 - s) * 64 + p], bbar[p * 16 + c2]); WST[i] = (bf16)f2bf((float)(q < 64 ? w.re : w.im)); }
    for (int i = tid; i < 256 * 128; i += NTHREADS) { const int n = i >> 7, q = i & 127, t = n >> 4, c = n & 15, p = q & 63;
        const cd w = cmul(cc[c * 64 + p], apow[(t + 1) * 64 + p]); WCR[i] = (bf16)f2bf((float)(q < 64 ? w.re : -w.im)); }
    for (int i = tid; i < 16 * 64; i += NTHREADS) { const int j = i >> 6, p = i & 63; const double lr = a_re[p], li = a_im[p];
        const double n = 16.0 * j; const double mag = exp(n * lr * dt), ang = n * li * dt; ALP[i] = (f32x2){(float)(mag * cos(ang)), (float)(mag * sin(ang))}; }
    for (int i = tid; i < 64 * 64; i += NTHREADS) { const int m = i >> 6, p = i & 63; const double lr = a_re[p], li = a_im[p];
        const double n = 256.0 * m; const double mag = exp(n * lr * dt), ang = n * li * dt; ATP[i] = (f32x2){(float)(mag * cos(ang)), (float)(mag * sin(ang))}; }
    __syncthreads();
}
__device__ __forceinline__ void p0_prologue(Frame& F) {
    if (F.bid < NG) p0_ssm_tables(F, F.bid);
    LAS float* scr = (LAS float*)(F.lds + F.wave * 16384);
    const int gw = F.bid * NWAVES + F.wave, NGW = F.G * NWAVES;
    constexpr int I_IN = (D / 64) * (PW / 32), I_GLU = (SW / 64) * (SW / 32), I_OUT = (D / 64) * (D / 32), I_UP = (D / 64) * (FF / 32), I_DOWN = (FF / 64) * (D / 32);
    constexpr int NITEMS = I_IN + I_GLU + I_OUT + I_UP + I_DOWN;
    for (int it = gw; it < NITEMS; it += NGW) {
        int r = it;
        if (r < I_IN) { p0_transpose_item(F.in[P_WIN], D, PW, (bf16*)(F.ws + WS_WIN), F.in[P_G1], F.in[P_G1], D, scr, r, F.lane); continue; } r -= I_IN;
        if (r < I_GLU) { p0_transpose_item(F.in[P_GLUW], SW, SW, (bf16*)(F.ws + WS_WGLU), nullptr, nullptr, 0, scr, r, F.lane); continue; } r -= I_GLU;
        if (r < I_OUT) { p0_transpose_item(F.in[P_WOUT], D, D, (bf16*)(F.ws + WS_WOUT), F.in[P_GA], F.in[P_GS], AW, scr, r, F.lane); continue; } r -= I_OUT;
        if (r < I_UP) { p0_transpose_item(F.in[P_WUP], D, FF, (bf16*)(F.ws + WS_WUP), F.in[P_G2], F.in[P_G2], D, scr, r, F.lane); continue; } r -= I_UP;
        p0_transpose_item(F.in[P_WDOWN], FF, D, (bf16*)(F.ws + WS_WDOWN), nullptr, nullptr, 0, scr, r, F.lane);
    }
    for (int m = gw; m < M; m += NGW) rms_row_to_bf16(F.in[P_X] + (size_t)m * D, (bf16*)(F.ws + WS_XN) + (size_t)m * D, F.lane);
}

__device__ __forceinline__ float att_shift(Frame& F) {
    float mq = 0.f, mk = 0.f;
    for (int i = 0; i < 64; ++i) { mq = fmaxf(mq, fabsf(F.in[P_GQ][i])); mk = fmaxf(mk, fabsf(F.in[P_GK][i])); }
    return 64.f * mq * mk * C2 * 1.0001f;
}
__device__ __forceinline__ void p1_naive(Frame& F) {
    const bf16* XN = (const bf16*)(F.ws + WS_XN); const bf16* W = (const bf16*)(F.ws + WS_WIN);
    const size_t total = (size_t)M * PW, nthr = (size_t)F.G * NTHREADS;
    for (size_t idx = (size_t)F.bid * NTHREADS + F.tid; idx < total; idx += nthr) {
        const int m = (int)(idx / PW), n = (int)(idx % PW);
        const float acc = dot_bf16(XN + (size_t)m * D, W + (size_t)n * D, D);
        const int seg = n >> 9, c = n & 511;
        float v = acc;
        if (seg < 2) { const float ss = wave_sum(acc * acc); const float r = 1.f / sqrtf(ss * (1.f / 64.f) + EPS);
            v = acc * r * (seg == 0 ? F.in[P_GQ][c & 63] * C2 : F.in[P_GK][c & 63]); }
        bf16* dst = (bf16*)(F.ws + (seg == 0 ? WS_Q : seg == 1 ? WS_K : seg == 2 ? WS_V : WS_U));
        dst[(size_t)m * AW + c] = (bf16)f2bf(v);
    }
}
__device__ __forceinline__ void p2_attn_naive(Frame& F) {
    const bf16* Q = (const bf16*)(F.ws + WS_Q); const bf16* K = (const bf16*)(F.ws + WS_K); const bf16* V = (const bf16*)(F.ws + WS_V);
    bf16* ATT = (bf16*)(F.ws + WS_ATT); float* SSQA = (float*)(F.ws + WS_SSQA);
    const float shift = att_shift(F);
    const int gw = F.bid * NWAVES + F.wave, NGW = F.G * NWAVES;
    for (int it = gw; it < M * NH; it += NGW) {
        const int m = it >> 3, h = it & 7; const int col = h * 64 + F.lane;
        const float q = bf2f(Q[(size_t)m * AW + col]);
        float o = 0.f, l = 0.f;
        for (int di = 0; di < 3; ++di) { const int d = di == 0 ? 1 : di == 1 ? 4 : 16;
            for (int mm = 0; mm <= 128; ++mm) { const int j = m - d * mm; if (j < 0) break;
                const float s = wave_sum(q * bf2f(K[(size_t)j * AW + col]));
                const float p = exp2f(s - shift);
                l += p; o += p * bf2f(V[(size_t)j * AW + col]); } }
        const float r = o / l;
        ATT[(size_t)m * AW + col] = (bf16)f2bf(r);
        const float ss = wave_sum(r * r);
        if (F.lane == 0) SSQA[m * 8 + h] = ss;
    }
}
__device__ __forceinline__ void p2_ssmA_naive(Frame& F) {
    const bf16* U = (const bf16*)(F.ws + WS_U);
    const size_t nthr = (size_t)F.G * NTHREADS;
    for (size_t idx = (size_t)F.bid * NTHREADS + F.tid; idx < (size_t)NTILE * NG * 64; idx += nthr) {
        const int p = (int)(idx & 63), g = (int)((idx >> 6) & 31), tile = (int)(idx >> 11);
        const bf16* Wr = (const bf16*)(F.ws + WS_WST) + ((size_t)g * 128 + p) * 256; const bf16* Wi = Wr + 64 * 256;
        const f32x2 al = ((const f32x2*)(F.ws + WS_ALP))[(g * 16 + 1) * 64 + p];
        float* XLOC = (float*)(F.ws + WS_XLOC) + ((size_t)(tile * NG + g) * 16) * 128;
        float xr = 0.f, xi = 0.f;
        for (int j = 0; j < NCH; ++j) {
            XLOC[j * 128 + p] = xr; XLOC[j * 128 + 64 + p] = xi;
            float sr = 0.f, si = 0.f;
            for (int k = 0; k < 256; ++k) { const float u = bf2f(U[(size_t)(tile * TILE + j * LCH + (k >> 4)) * SW + g * 16 + (k & 15)]); sr += u * bf2f(Wr[k]); si += u * bf2f(Wi[k]); }
            const float nr = al.x * xr - al.y * xi + sr, ni = al.x * xi + al.y * xr + si; xr = nr; xi = ni;
        }
        float* ST = (float*)(F.ws + WS_STILE) + (size_t)(tile * NG + g) * 128; ST[p] = xr; ST[64 + p] = xi;
    }
}
__device__ __forceinline__ float gelu_tanh(float y) { const float t = tanhf(0.7978845608028654f * (y + 0.044715f * y * y * y)); return 0.5f * y * (1.f + t); }
__device__ __forceinline__ void p3_ssmB_naive(Frame& F) {
    const bf16* U = (const bf16*)(F.ws + WS_U); bf16* Z = (bf16*)(F.ws + WS_Z);
    LAS float* xp = (LAS float*)F.lds;
    for (int pair = F.bid; pair < NTILE * NG; pair += F.G) {
        const int tile = pair >> 5, g = pair & 31;
        if (F.tid < 64) { const int p = F.tid; float tr = 0.f, ti = 0.f;
            const f32x2* ATP = (const f32x2*)(F.ws + WS_ATP) + (size_t)g * 64 * 64;
            for (int j = 0; j < tile; ++j) { const f32x2 a = ATP[(tile - 1 - j) * 64 + p]; const float* ST = (const float*)(F.ws + WS_STILE) + (size_t)(j * NG + g) * 128;
                const float sr = ST[p], si = ST[64 + p]; tr += a.x * sr - a.y * si; ti += a.x * si + a.y * sr; }
            const float* XLOC = (const float*)(F.ws + WS_XLOC) + ((size_t)(tile * NG + g) * 16) * 128;
            const f32x2* ALP = (const f32x2*)(F.ws + WS_ALP) + (size_t)g * 16 * 64;
            for (int j = 0; j < NCH; ++j) { const f32x2 a = ALP[j * 64 + p];
                xp[j * 128 + p] = XLOC[j * 128 + p] + a.x * tr - a.y * ti; xp[j * 128 + 64 + p] = XLOC[j * 128 + 64 + p] + a.x * ti + a.y * tr; } }
        __syncthreads();
        const bf16* TM = (const bf16*)(F.ws + WS_TM) + (size_t)g * 17 * 256; const bf16* WCR = (const bf16*)(F.ws + WS_WCR) + (size_t)g * 256 * 128;
        for (int o = F.tid; o < TILE * 16; o += NTHREADS) { const int tl = o >> 4, c = o & 15, j = tl >> 4, t = tl & 15; float y = 0.f;
            for (int s = 0; s <= t; ++s) { const bf16* tm = TM + ((t - s + 1) * 16 + c) * 16; const bf16* u = U + (size_t)(tile * TILE + j * LCH + s) * SW + g * 16;
                for (int c2 = 0; c2 < 16; ++c2) y += bf2f(tm[c2]) * bf2f(u[c2]); }
            const bf16* wc = WCR + (size_t)(t * 16 + c) * 128;
            for (int q = 0; q < 128; ++q) y += xp[j * 128 + q] * bf2f(wc[q]);
            Z[(size_t)(tile * TILE + tl) * SW + g * 16 + c] = (bf16)f2bf(gelu_tanh(y)); }
        __syncthreads();
    }
}
__device__ __forceinline__ void p4_glu_naive(Frame& F) {
    const bf16* Z = (const bf16*)(F.ws + WS_Z); const bf16* W = (const bf16*)(F.ws + WS_WGLU); bf16* O = (bf16*)(F.ws + WS_SSMO); float* SSQS = (float*)(F.ws + WS_SSQS);
    const size_t total = (size_t)M * SW, nthr = (size_t)F.G * NTHREADS;
    for (size_t idx = (size_t)F.bid * NTHREADS + F.tid; idx < total; idx += nthr) {
        const int m = (int)(idx >> 9), n = (int)(idx & 511);
        const float acc = dot_bf16(Z + (size_t)m * SW, W + (size_t)n * SW, SW) + F.in[P_GLUB][n];
        const float z = bf2f(Z[(size_t)m * SW + n]); const float o = z / (1.f + expf(-acc));
        O[(size_t)m * SW + n] = (bf16)f2bf(o);
        const float ss = wave_sum(o * o); if (F.lane == 0) SSQS[m * 8 + (n >> 6)] = ss;
    }
}
__device__ __forceinline__ void p5_out_naive(Frame& F) {
    const bf16* A = (const bf16*)(F.ws + WS_ATT); const bf16* S = (const bf16*)(F.ws + WS_SSMO); const bf16* W = (const bf16*)(F.ws + WS_WOUT);
    const float* SSQA = (const float*)(F.ws + WS_SSQA); const float* SSQS = (const float*)(F.ws + WS_SSQS); float* SSQ2 = (float*)(F.ws + WS_SSQ2); bf16* X1B = (bf16*)(F.ws + WS_XN);
    const size_t total = (size_t)M * D, nthr = (size_t)F.G * NTHREADS;
    for (size_t idx = (size_t)F.bid * NTHREADS + F.tid; idx < total; idx += nthr) {
        const int m = (int)(idx >> 10), n = (int)(idx & 1023);
        float sa = 0.f, ss = 0.f;
        for (int i = 0; i < 8; ++i) { sa += SSQA[m * 8 + i]; ss += SSQS[m * 8 + i]; }
        const float ra = 1.f / sqrtf(sa * (1.f / 512.f) + EPS), rs = 1.f / sqrtf(ss * (1.f / 512.f) + EPS);
        const float accA = dot_bf16(A + (size_t)m * AW, W + (size_t)n * D, AW), accS = dot_bf16(S + (size_t)m * SW, W + (size_t)n * D + AW, SW);
        const float x1 = F.in[P_X][(size_t)m * D + n] + ra * accA + rs * accS;
        F.out[(size_t)m * D + n] = x1; X1B[(size_t)m * D + n] = (bf16)f2bf(x1);
        const float q = wave_sum(x1 * x1); if (F.lane == 0) SSQ2[m * 16 + (n >> 6)] = q;
    }
}
__device__ __forceinline__ void p6_up_naive(Frame& F) {
    const bf16* A = (const bf16*)(F.ws + WS_XN); const bf16* W = (const bf16*)(F.ws + WS_WUP); const float* SSQ2 = (const float*)(F.ws + WS_SSQ2); bf16* H = (bf16*)(F.ws + WS_H);
    const size_t total = (size_t)M * FF, nthr = (size_t)F.G * NTHREADS;
    for (size_t idx = (size_t)F.bid * NTHREADS + F.tid; idx < total; idx += nthr) {
        const int m = (int)(idx >> 12), n = (int)(idx & 4095);
        float s2 = 0.f; for (int i = 0; i < 16; ++i) s2 += SSQ2[m * 16 + i];
        const float r2 = 1.f / sqrtf(s2 * (1.f / 1024.f) + EPS);
        const float a = fmaxf(r2 * dot_bf16(A + (size_t)m * D, W + (size_t)n * D, D), 0.f);
        H[(size_t)m * FF + n] = (bf16)f2bf(a * a);
    }
}
__device__ __forceinline__ void p7_down_naive(Frame& F) {
    const bf16* H = (const bf16*)(F.ws + WS_H); const bf16* W = (const bf16*)(F.ws + WS_WDOWN);
    const size_t total = (size_t)M * D, nthr = (size_t)F.G * NTHREADS;
    for (size_t idx = (size_t)F.bid * NTHREADS + F.tid; idx < total; idx += nthr) {
        const int m = (int)(idx >> 10), n = (int)(idx & 1023);
        F.out[(size_t)m * D + n] += dot_bf16(H + (size_t)m * FF, W + (size_t)n * FF, FF);
    }
}

constexpr int N_PHASES = 8;
__global__ void __launch_bounds__(NTHREADS, 2) mk_fwd(Args args) {
    extern __shared__ __attribute__((aligned(16))) unsigned char lds_raw[];
    Frame F;
    F.lds = (LAS unsigned char*)lds_raw;
    F.tid = threadIdx.x; F.lane = F.tid & 63; F.wave = __builtin_amdgcn_readfirstlane(F.tid >> 6);
    F.G = gridDim.x; F.bid = blockIdx.x;
#pragma unroll
    for (int i = 0; i < 21; ++i) F.in[i] = args.in[i];
    F.out = args.out; F.ws = args.ws;
    volatile LAS unsigned* MISC = (volatile LAS unsigned*)(F.lds + MISC_OFF);
    for (int u = F.tid; u < 64; u += NTHREADS) MISC[u] = 0u;
    __syncthreads();
    unsigned* ctl = (unsigned*)(F.ws + WS_CTL);
    XcdBarrier bar; bar.bar = ctl + CW_BAR; bar.x = 0; bar.st = nullptr;
    if (!MK_SPLIT) bar = xcd_barrier_post(ctl + CW_BAR, MISC + 8);
    const int lo = args.ph_lo, hi = args.ph_hi;
#define IN(k) (lo <= (k) && (k) < hi)
#define SEAM(k) do { if (IN(k) && IN((k) + 1)) xcd_barrier(bar); } while (0)
    if (IN(0)) { p0_prologue(F); } SEAM(0);
    if (IN(1)) { p1_naive(F); } SEAM(1);
    if (IN(2)) { p2_ssmA_naive(F); p2_attn_naive(F); } SEAM(2);
    if (IN(3)) { p3_ssmB_naive(F); } SEAM(3);
    if (IN(4)) { p4_glu_naive(F); } SEAM(4);
    if (IN(5)) { p5_out_naive(F); } SEAM(5);
    if (IN(6)) { p6_up_naive(F); } SEAM(6);
    if (IN(7)) { p7_down_naive(F); }
#undef IN
#undef SEAM
}

extern "C" void kernel_launch(void* const* d_in, const int* in_sizes, int n_in, void* d_out, int out_size, void* d_ws, size_t ws_size, hipStream_t stream) {
    static int grid = 0;
    if (grid == 0) {
        if (n_in != 21 || in_sizes[0] != M * D || out_size != M * D || ws_size < WS_END) { fprintf(stderr, "kernel_launch: unexpected shapes (n_in %d, in0 %d, out %d, ws %zu)\n", n_in, n_in > 0 ? in_sizes[0] : -1, out_size, ws_size); grid = -1; return; }
        int dev = 0, cus = 0;
        if (hipGetDevice(&dev) != hipSuccess || hipDeviceGetAttribute(&cus, hipDeviceAttributeMultiprocessorCount, dev) != hipSuccess) { grid = -1; return; }
        if (hipFuncSetAttribute((const void*)mk_fwd, hipFuncAttributeMaxDynamicSharedMemorySize, LDS_BYTES) != hipSuccess) { fprintf(stderr, "kernel_launch: hipFuncSetAttribute failed\n"); grid = -1; return; }
        int per_cu = 0;
        if (hipOccupancyMaxActiveBlocksPerMultiprocessor(&per_cu, (const void*)mk_fwd, NTHREADS, LDS_BYTES) != hipSuccess || per_cu < 1) fprintf(stderr, "kernel_launch: occupancy query says %d\n", per_cu);
        (void)hipGetLastError();
        grid = cus;
    }
    if (grid < 0) return;
    (void)hipMemsetAsync((char*)d_ws + WS_CTL, 0, CTL_ZERO_BYTES, stream);
    Args a{};
    for (int i = 0; i < 21; ++i) a.in[i] = (const float*)d_in[i];
    a.out = (float*)d_out; a.ws = (unsigned char*)d_ws;
    if (MK_SPLIT) {
        for (int p = 0; p < N_PHASES; ++p) { a.ph_lo = p; a.ph_hi = p + 1; hipLaunchKernelGGL(mk_fwd, dim3(grid), dim3(NTHREADS), LDS_BYTES, stream, a); }
    } else {
        a.ph_lo = 0; a.ph_hi = N_PHASES; hipLaunchKernelGGL(mk_fwd, dim3(grid), dim3(NTHREADS), LDS_BYTES, stream, a);
    }
}
```

```cpp
#include <hip/hip_runtime.h>
#include <cstdio>
#include <cstdint>

#ifndef FAST_MASK
#define FAST_MASK 0xFF
#endif
#ifndef MK_SPLIT
#define MK_SPLIT 0
#endif

constexpr int M = 16384, D = 1024, AW = 512, HD = 64, NH = 8, SW = 512, SG = 16, NG = 32, SP = 64, FF = 4096, PW = 2048;
constexpr float EPS = 1e-6f;
constexpr float C2 = 0.125f * 1.4426950408889634f;
constexpr int TILE = 256, LCH = 16, NCH = TILE / LCH, NTILE = M / TILE;
constexpr int NWAVES = 8, NTHREADS = 512;

constexpr size_t MiB = 1u << 20;
constexpr size_t WS_CTL = 0, CTL_ZERO_BYTES = 1 * MiB;
constexpr size_t WS_TM = 1 * MiB;
constexpr size_t WS_WST = 2 * MiB;
constexpr size_t WS_WCR = 4 * MiB;
constexpr size_t WS_ALP = 6 * MiB;
constexpr size_t WS_ATP = 7 * MiB;
constexpr size_t WS_WIN = 8 * MiB, WS_WGLU = 12 * MiB, WS_WOUT = 13 * MiB, WS_WUP = 15 * MiB, WS_WDOWN = 23 * MiB;
constexpr size_t WS_SSQA = 31 * MiB, WS_SSQS = 31 * MiB + 512 * 1024, WS_SSQ2 = 32 * MiB;
constexpr size_t WS_STILE = 34 * MiB;
constexpr size_t WS_XLOC = 35 * MiB;
constexpr size_t WS_XN = 52 * MiB;
constexpr size_t WS_H = 84 * MiB;
constexpr size_t WS_Q = 84 * MiB, WS_K = 100 * MiB, WS_V = 116 * MiB, WS_U = 132 * MiB, WS_MIX = 148 * MiB  , WS_Z = 180 * MiB;
constexpr size_t WS_END = 212 * MiB;
constexpr int CW_BAR = 4096;

constexpr int LDS_BYTES = 147456;
constexpr int MISC_OFF = 131072 + 320, ROWTAB_OFF = 131072 + 1024;

#define GAS __attribute__((address_space(1)))
#define LAS __attribute__((address_space(3)))
typedef unsigned short bf16;
typedef unsigned v4u __attribute__((ext_vector_type(4)));
typedef float f32x4 __attribute__((ext_vector_type(4)));
typedef float f32x2 __attribute__((ext_vector_type(2)));

__device__ __forceinline__ unsigned f2bf(float f) { unsigned u = __builtin_bit_cast(unsigned, f); return (u + 0x7fffu + ((u >> 16) & 1u)) >> 16; }
__device__ __forceinline__ unsigned pk2(float lo, float hi) { return f2bf(lo) | (f2bf(hi) << 16); }
__device__ __forceinline__ float bf2f(bf16 h) { return __builtin_bit_cast(float, (unsigned)h << 16); }
__device__ __forceinline__ float bflo(unsigned w) { return __builtin_bit_cast(float, w << 16); }
__device__ __forceinline__ float bfhi(unsigned w) { return __builtin_bit_cast(float, w & 0xffff0000u); }
__device__ __forceinline__ float wave_sum(float v) {
#pragma unroll
    for (int o = 1; o < 64; o <<= 1) v += __shfl_xor(v, o);
    return v;
}
__device__ __forceinline__ float dot8(v4u a, v4u b) {
    return bflo(a.x) * bflo(b.x) + bfhi(a.x) * bfhi(b.x) + bflo(a.y) * bflo(b.y) + bfhi(a.y) * bfhi(b.y)
         + bflo(a.z) * bflo(b.z) + bfhi(a.z) * bfhi(b.z) + bflo(a.w) * bflo(b.w) + bfhi(a.w) * bfhi(b.w);
}
__device__ __forceinline__ float dot_bf16(const bf16* a, const bf16* b, int K) {
    float acc = 0.f;
    for (int k = 0; k < K; k += 8) acc += dot8(*(const v4u*)(a + k), *(const v4u*)(b + k));
    return acc;
}

#define XB_TMO      128
#define XB_XCNT(j)  (256  + 64 * (j))
#define XB_XSUB(j)  (1280 + 64 * (j))
#define XB_XGEN(j)  (2304 + 64 * (j))
#define XB_TOP      3328
#define XB_TOPGEN   3392
#define XCD_BAR_WORDS 3456
#define XB_SPIN_CAP (1u << 18)
__device__ __forceinline__ unsigned xb_ld(unsigned* p)              { return __hip_atomic_load(p, __ATOMIC_RELAXED, __HIP_MEMORY_SCOPE_AGENT); }
__device__ __forceinline__ unsigned xb_add(unsigned* p, unsigned v) { return __hip_atomic_fetch_add(p, v, __ATOMIC_RELAXED, __HIP_MEMORY_SCOPE_AGENT); }
__device__ __forceinline__ unsigned xb_xcc_id() { return (unsigned)__builtin_amdgcn_s_getreg((3 << 11) | 20) & 0xFu; }
#define XB_SPIN(cond, bar) do { unsigned _sp = 0; while (cond) { __builtin_amdgcn_s_sleep(1); \
    if ((++_sp & 255u) == 0u) { if (xb_ld(&(bar)[XB_TMO])) break; if (_sp > XB_SPIN_CAP) { atomicAdd(&(bar)[XB_TMO], 1u); break; } } } } while (0)
struct XcdBarrier { unsigned* bar; unsigned x; volatile LAS unsigned* st; };
__device__ __forceinline__ XcdBarrier xcd_barrier_post(unsigned* bar, volatile LAS unsigned* st) {
    XcdBarrier b; b.bar = bar; b.x = xb_xcc_id(); b.st = st;
    if (threadIdx.x == 0) (void)xb_add(&bar[XB_XCNT(b.x)], 1u);
    return b;
}
__device__ __forceinline__ void xcd_barrier_complete(unsigned* bar, unsigned x, unsigned& nloc, unsigned& nx) {
    const unsigned G = gridDim.x * gridDim.y * gridDim.z;
    unsigned sum, cnt, mine, sp = 0u;
    for (;;) {
        sum = 0u; cnt = 0u; mine = 0u;
#pragma unroll
        for (unsigned j = 0; j < 16; ++j) { const unsigned c = xb_ld(&bar[XB_XCNT(j)]); sum += c; cnt += (c > 0u) ? 1u : 0u; mine = (j == x) ? c : mine; }
        if (sum == G) break;
        __builtin_amdgcn_s_sleep(1);
        if ((++sp & 255u) == 0u) { if (xb_ld(&bar[XB_TMO])) break; if (sp > XB_SPIN_CAP) { atomicAdd(&bar[XB_TMO], 1u); break; } }
    }
    nloc = mine > 0u ? mine : 1u; nx = cnt > 0u ? cnt : 1u;
}
__device__ __forceinline__ void xcd_barrier(const XcdBarrier& b) {
    asm volatile("s_waitcnt vmcnt(0)" ::: "memory");
    __syncthreads();
    if (threadIdx.x == 0) {
        unsigned* bar = b.bar;
        __builtin_amdgcn_s_waitcnt(0);
        unsigned nloc = b.st[0], nx = b.st[1];
        if (nloc == 0u) { xcd_barrier_complete(bar, b.x, nloc, nx); b.st[0] = nloc; b.st[1] = nx; }
        const unsigned old = xb_add(&bar[XB_XSUB(b.x)], 1u);
        const unsigned gen = old / nloc;
        if (old + 1u == (gen + 1u) * nloc) {
            __builtin_amdgcn_fence(__ATOMIC_RELEASE, "agent");
            asm volatile("s_waitcnt vmcnt(0)" ::: "memory");
            const unsigned og = xb_add(&bar[XB_TOP], 1u);
            const unsigned tg = og / nx;
            if (og + 1u == (tg + 1u) * nx) xb_add(&bar[XB_TOPGEN], 1u);
            else XB_SPIN(xb_ld(&bar[XB_TOPGEN]) == tg, bar);
            __builtin_amdgcn_fence(__ATOMIC_ACQUIRE, "agent");
            xb_add(&bar[XB_XGEN(b.x)], 1u);
            asm volatile("s_waitcnt vmcnt(0)" ::: "memory");
        } else {
            XB_SPIN(xb_ld(&bar[XB_XGEN(b.x)]) == gen, bar);
            __builtin_amdgcn_fence(__ATOMIC_ACQUIRE, "agent");
            asm volatile("s_waitcnt vmcnt(0)" ::: "memory");
        }
    }
    __syncthreads();
}


namespace pg8 {
#define PG8_LAS __attribute__((address_space(3)))
typedef unsigned short bf16_t;
typedef short bf16x8 __attribute__((ext_vector_type(8)));
typedef float f32x4 __attribute__((ext_vector_type(4)));
typedef unsigned u32x4 __attribute__((ext_vector_type(4)));
typedef unsigned u32x2 __attribute__((ext_vector_type(2)));
constexpr int BM = 256, BK = 64, HALF = 128, HTB = HALF * BK * 2, STAGE_BYTES = 8 * HTB, NXCD = 8, WGM = 8;
__host__ __device__ __forceinline__ int lds_byte(int r, int c) { const int st = (r >> 4) * 2 + (c >> 5), rr = r & 15, cc = c & 31, ob = rr * 64 + cc * 2; return st * 1024 + (ob ^ (((ob >> 9) & 1) << 5)); }
__host__ __device__ __forceinline__ void stage_rc(int b, int& R, int& C) { const int st = b / 1024, sb = b % 1024, swz = sb ^ (((sb >> 9) & 1) << 5); R = (st >> 1) * 16 + swz / 64; C = (st & 1) * 32 + (swz % 64) / 2; }
__host__ __device__ __forceinline__ int perm32(int rho) { const int n = rho >> 4, i = rho & 15; return 8 * (i >> 2) + 4 * n + (i & 3); }
struct Unit { int pm, pn; };
struct Gemm { const bf16_t* A; const bf16_t* Bt; int M, N, K; };
struct StaticOrder {
    int nM, nN, nwg, G, c;
    __host__ __device__ void init(int M, int N, int G_, int c_) { nM = M / BM; nN = N / BM; nwg = nM * nN; G = G_; c = c_; }
    __host__ __device__ bool next(int i, Unit& u) const {
        const long L = (long)i * G + c; if (L >= nwg) return false;
        int wgid = (int)L; { const int q = nwg / NXCD, r = nwg % NXCD, xcd = wgid % NXCD, off = wgid / NXCD; wgid = (xcd < r ? xcd * (q + 1) : r * (q + 1) + (xcd - r) * q) + off; }
        const int nig = WGM * nN, gid = wgid / nig, fm = gid * WGM, gsz = (nM - fm) < WGM ? (nM - fm) : WGM;
        u.pm = fm + ((wgid % nig) % gsz); u.pn = (wgid % nig) / gsz; return true;
    }
    __device__ __forceinline__ void a_ready(const Unit&) const {}
    __device__ __forceinline__ void done(const Unit&) const {}
};
__device__ __forceinline__ unsigned cvt_pk_bf16(float lo, float hi) { unsigned r; asm volatile("v_cvt_pk_bf16_f32 %0, %1, %2" : "=v"(r) : "v"(lo), "v"(hi)); return r; }

template <int MODE> struct BMap {
    static constexpr int BHALF_ROWS = (MODE == 2) ? 32 : 128;
    __host__ __device__ static __forceinline__ int brow(int R) { return MODE == 0 ? R : MODE == 1 ? ((R & ~31) + perm32(R & 31)) : (64 * (R >> 5) + perm32(R & 31)); }
};

template <class Epi, class Sched, bool ALIGN_EPI = true>
__device__ __forceinline__ void gemm_phase(PG8_LAS unsigned char* lds, const Gemm g, const Sched& S, const Epi& E) {
    const int tid = threadIdx.x, wid = __builtin_amdgcn_readfirstlane(tid >> 6), lane = tid & 63, wr = wid >> 2, wc = wid & 3, fr = lane & 15, fq = lane >> 4;
    const int K = g.K, nt = K / BK;
    unsigned voffA[2], voffB[2];
#pragma unroll
    for (int i = 0; i < 2; ++i) { int R, C; stage_rc(tid * 16 + i * 8192, R, C); const int Rb = BMap<Epi::MODE>::brow(R);
        voffA[i] = (unsigned)(R * K + C) * 2u; voffB[i] = (unsigned)(Rb * K + C) * 2u; }
    const size_t kstep = (size_t)(BK * 2);
    const size_t hstepA = (size_t)HALF * K * 2, hstepB = (size_t)BMap<Epi::MODE>::BHALF_ROWS * K * 2;
    const size_t tstep = (size_t)BM * K * 2;
    const unsigned ldsw = (unsigned)wid * 1024u;
    const int aoff = lds_byte(wr * 64 + fr, fq * 8), boff = lds_byte(wc * 32 + fr, fq * 8);
#define PG8_SA(b, h) (((b) * 2 + (h)) * HTB)
#define PG8_SB(b, h) ((4 + (b) * 2 + (h)) * HTB)
#define PG8_STAGE(bufoff, gbase, voff) do { _Pragma("unroll") for (int _i = 0; _i < 2; ++_i) \
        __builtin_amdgcn_global_load_lds((const unsigned*)((const char*)(gbase) + (voff)[_i]), (PG8_LAS unsigned*)(lds + (bufoff) + ldsw + _i * 8192), 16, 0, 0); } while (0)
#define PG8_LDA(dst, b, h) do { _Pragma("unroll") for (int m = 0; m < 4; ++m) _Pragma("unroll") for (int k = 0; k < 2; ++k) dst[m][k] = *(const PG8_LAS bf16x8*)(lds + PG8_SA(b, h) + aoff + m * 2048 + k * 1024); } while (0)
#define PG8_LDB(dst, b, h) do { _Pragma("unroll") for (int n = 0; n < 2; ++n) _Pragma("unroll") for (int k = 0; k < 2; ++k) dst[n][k] = *(const PG8_LAS bf16x8*)(lds + PG8_SB(b, h) + boff + n * 2048 + k * 1024); } while (0)
#define PG8_MMA(ai, bj, At, Bt) do { __builtin_amdgcn_s_setprio(1); _Pragma("unroll") for (int m = 0; m < 4; ++m) _Pragma("unroll") for (int n = 0; n < 2; ++n) _Pragma("unroll") for (int k = 0; k < 2; ++k) \
        acc[ai][bj][m][n] = __builtin_amdgcn_mfma_f32_16x16x32_bf16(Bt[n][k], At[m][k], acc[ai][bj][m][n], 0, 0, 0); __builtin_amdgcn_s_setprio(0); } while (0)
#define PG8_WAIT_V(n) asm volatile("s_waitcnt vmcnt(" #n ")" ::: "memory")
#define PG8_WAIT_L(n) asm volatile("s_waitcnt lgkmcnt(" #n ")" ::: "memory")
#define PG8_BAR __builtin_amdgcn_s_barrier()
#define PG8_SCHED __builtin_amdgcn_sched_barrier(0)
    Unit cur, nxt; int ui = 0;
    if (!S.next(0, cur)) return;
    f32x4 acc[2][2][4][2];
#pragma unroll
    for (int a = 0; a < 2; ++a)
#pragma unroll
        for (int b = 0; b < 2; ++b)
#pragma unroll
            for (int m = 0; m < 4; ++m)
#pragma unroll
                for (int n = 0; n < 2; ++n) acc[a][b][m][n] = (f32x4){0.f, 0.f, 0.f, 0.f};
    bf16x8 At[4][2], B0[2][2], B1[2][2];
    const char* cA = (const char*)g.A + (size_t)cur.pm * tstep; const char* cB = (const char*)g.Bt + (size_t)cur.pn * tstep;
    S.a_ready(cur);
    PG8_STAGE(PG8_SB(0, 0), cB, voffB); PG8_STAGE(PG8_SB(0, 1), cB + hstepB, voffB); PG8_STAGE(PG8_SA(0, 0), cA, voffA); PG8_STAGE(PG8_SA(0, 1), cA + hstepA, voffA);
    if (wr == 1) PG8_BAR;
    PG8_WAIT_V(2); PG8_BAR;
    PG8_STAGE(PG8_SB(1, 0), cB + kstep, voffB); PG8_STAGE(PG8_SA(1, 0), cA + kstep, voffA); PG8_STAGE(PG8_SB(1, 1), cB + hstepB + kstep, voffB);
    PG8_WAIT_V(6); PG8_BAR;
    for (;;) {
        const bool has_next = S.next(ui + 1, nxt);
        const char* nA = has_next ? (const char*)g.A + (size_t)nxt.pm * tstep : cA; const char* nB = has_next ? (const char*)g.Bt + (size_t)nxt.pn * tstep : cB;
        for (int t = 0; t < nt; t += 2) {
            const bool last = (t == nt - 2);
            const char* a1 = cA + (size_t)(t + 1) * kstep;
            const char* a2 = last ? nA : cA + (size_t)(t + 2) * kstep; const char* b2 = last ? nB : cB + (size_t)(t + 2) * kstep;
            const char* a3 = a2 + kstep; const char* b3 = b2 + kstep;
            if (last && has_next) S.a_ready(nxt);
            if constexpr (Epi::MIDK > 0) { if (t == Epi::MIDK) E.midk(acc, wr, fr, lds); }
            PG8_LDB(B0, 0, 0); PG8_LDB(B1, 0, 1); PG8_SCHED; PG8_LDA(At, 0, 0); PG8_STAGE(PG8_SA(1, 1), a1 + hstepA, voffA);
            PG8_WAIT_V(8); PG8_WAIT_L(0); PG8_BAR; PG8_MMA(0, 0, At, B0); PG8_MMA(0, 1, At, B1); PG8_BAR; PG8_SCHED;
            PG8_LDA(At, 0, 1); PG8_STAGE(PG8_SB(0, 0), b2, voffB); PG8_STAGE(PG8_SB(0, 1), b2 + hstepB, voffB); PG8_STAGE(PG8_SA(0, 0), a2, voffA);
            PG8_WAIT_V(8); PG8_WAIT_L(0); PG8_BAR; PG8_MMA(1, 0, At, B0); PG8_MMA(1, 1, At, B1); PG8_BAR; PG8_SCHED;
            PG8_LDB(B0, 1, 0); PG8_LDB(B1, 1, 1); PG8_SCHED; PG8_LDA(At, 1, 0); PG8_STAGE(PG8_SA(0, 1), a2 + hstepA, voffA);
            PG8_WAIT_V(8); PG8_WAIT_L(0); PG8_BAR; PG8_MMA(0, 0, At, B0); PG8_MMA(0, 1, At, B1); PG8_BAR; PG8_SCHED;
            PG8_LDA(At, 1, 1); PG8_STAGE(PG8_SB(1, 0), b3, voffB); PG8_STAGE(PG8_SB(1, 1), b3 + hstepB, voffB); PG8_STAGE(PG8_SA(1, 0), a3, voffA);
            PG8_WAIT_V(8); PG8_WAIT_L(0); PG8_BAR; PG8_MMA(1, 0, At, B0); PG8_MMA(1, 1, At, B1); PG8_BAR; PG8_SCHED;
        }
        if constexpr (ALIGN_EPI) { if (wr == 0) PG8_BAR; }
        E(acc, cur, wr, wc, fr, fq, lds); S.done(cur);
        if (!has_next) break;
#pragma unroll
        for (int a = 0; a < 2; ++a)
#pragma unroll
            for (int b = 0; b < 2; ++b)
#pragma unroll
                for (int m = 0; m < 4; ++m)
#pragma unroll
                    for (int n = 0; n < 2; ++n) acc[a][b][m][n] = (f32x4){0.f, 0.f, 0.f, 0.f};
        cur = nxt; cA = nA; cB = nB; ++ui;
        if constexpr (ALIGN_EPI) { if (wr == 1) PG8_BAR; }
    }
    PG8_WAIT_V(0);
    if constexpr (!ALIGN_EPI) { if (wr == 0) PG8_BAR; }
    PG8_BAR;
#undef PG8_SA
#undef PG8_SB
#undef PG8_STAGE
#undef PG8_LDA
#undef PG8_LDB
#undef PG8_MMA
#undef PG8_WAIT_V
#undef PG8_WAIT_L
#undef PG8_BAR
#undef PG8_SCHED
}

struct EpiInProj {
    static constexpr int MODE = 2, MIDK = 0;
    bf16_t *Qb, *Kb, *Vb, *Ub; const float *gq, *gk;
    __device__ __forceinline__ void operator()(const f32x4 (&acc)[2][2][4][2], const Unit& u, int wr, int wc, int fr, int fq, PG8_LAS unsigned char*) const {
        const int seg = u.pn >> 1; bf16_t* base = seg == 0 ? Qb : seg == 1 ? Kb : seg == 2 ? Vb : Ub;
        const int col0 = (u.pn & 1) * 256 + wc * 64 + 8 * fq, row0 = u.pm * BM + wr * 64 + fr;
        f32x4 gv[2][2];
#pragma unroll
        for (int bj = 0; bj < 2; ++bj)
#pragma unroll
            for (int n = 0; n < 2; ++n) { gv[bj][n] = (f32x4){1.f, 1.f, 1.f, 1.f};
                if (seg == 0) gv[bj][n] = *(const f32x4*)(gq + 32 * bj + 8 * fq + 4 * n) * C2; else if (seg == 1) gv[bj][n] = *(const f32x4*)(gk + 32 * bj + 8 * fq + 4 * n); }
#pragma unroll
        for (int ai = 0; ai < 2; ++ai)
#pragma unroll
            for (int m = 0; m < 4; ++m) {
                float r = 1.f;
                if (seg < 2) { float ss = 0.f;
#pragma unroll
                    for (int bj = 0; bj < 2; ++bj)
#pragma unroll
                        for (int n = 0; n < 2; ++n) { const f32x4 x = acc[ai][bj][m][n]; ss += (x[0] * x[0] + x[1] * x[1]) + (x[2] * x[2] + x[3] * x[3]); }
                    ss += __shfl_xor(ss, 16); ss += __shfl_xor(ss, 32); r = 1.f / sqrtf(ss * (1.f / 64.f) + EPS); }
                bf16_t* rowp = base + (size_t)(row0 + ai * HALF + m * 16) * AW + col0;
#pragma unroll
                for (int bj = 0; bj < 2; ++bj) { const f32x4 v0 = acc[ai][bj][m][0] * (gv[bj][0] * r), v1 = acc[ai][bj][m][1] * (gv[bj][1] * r);
                    u32x4 w; w.x = cvt_pk_bf16(v0[0], v0[1]); w.y = cvt_pk_bf16(v0[2], v0[3]); w.z = cvt_pk_bf16(v1[0], v1[1]); w.w = cvt_pk_bf16(v1[2], v1[3]);
                    *(u32x4*)(rowp + bj * 32) = w; } }
    }
};
struct EpiGlu {
    static constexpr int MODE = 1, MIDK = 0;
    const bf16_t* Z; bf16_t* O; const float* bias; float* ssq;
    __device__ __forceinline__ void operator()(const f32x4 (&acc)[2][2][4][2], const Unit& u, int wr, int wc, int fr, int fq, PG8_LAS unsigned char*) const {
        const int col0 = u.pn * BM + wc * 32 + 8 * fq, row0 = u.pm * BM + wr * 64 + fr;
        f32x4 bv[2][2];
#pragma unroll
        for (int bj = 0; bj < 2; ++bj)
#pragma unroll
            for (int n = 0; n < 2; ++n) bv[bj][n] = *(const f32x4*)(bias + col0 + bj * HALF + 4 * n);
#pragma unroll
        for (int ai = 0; ai < 2; ++ai)
#pragma unroll
            for (int m = 0; m < 4; ++m) { const int row = row0 + ai * HALF + m * 16; float ss = 0.f;
#pragma unroll
                for (int bj = 0; bj < 2; ++bj) { const u32x4 zr = *(const u32x4*)(Z + (size_t)row * SW + col0 + bj * HALF);
                    const float zf[8] = {bflo(zr.x), bfhi(zr.x), bflo(zr.y), bfhi(zr.y), bflo(zr.z), bfhi(zr.z), bflo(zr.w), bfhi(zr.w)};
                    float o[8];
#pragma unroll
                    for (int e = 0; e < 8; ++e) { const float a = acc[ai][bj][m][e >> 2][e & 3] + bv[bj][e >> 2][e & 3];
                        o[e] = zf[e] * __builtin_amdgcn_rcpf(1.f + __builtin_amdgcn_exp2f(-1.4426950408889634f * a)); ss += o[e] * o[e]; }
                    u32x4 w; w.x = cvt_pk_bf16(o[0], o[1]); w.y = cvt_pk_bf16(o[2], o[3]); w.z = cvt_pk_bf16(o[4], o[5]); w.w = cvt_pk_bf16(o[6], o[7]);
                    *(u32x4*)(O + (size_t)row * D + col0 + bj * HALF) = w; }
                ss += __shfl_xor(ss, 16); ss += __shfl_xor(ss, 32);
                if (fq == 0) ssq[row * 8 + u.pn * 4 + wc] = ss; }
    }
};
struct EpiOut {
    static constexpr int MODE = 0, MIDK = 8;
    const float* x; float* out; bf16_t* x1b; float* ssq2;
    __device__ __forceinline__ void midk(f32x4 (&acc)[2][2][4][2], int wr, int fr, PG8_LAS unsigned char* lds) const {
        const PG8_LAS f32x2* tab = (const PG8_LAS f32x2*)(lds + ROWTAB_OFF);
#pragma unroll
        for (int ai = 0; ai < 2; ++ai)
#pragma unroll
            for (int m = 0; m < 4; ++m) { const float s = tab[ai * HALF + wr * 64 + m * 16 + fr].x;
#pragma unroll
                for (int bj = 0; bj < 2; ++bj)
#pragma unroll
                    for (int n = 0; n < 2; ++n) acc[ai][bj][m][n] *= s; }
    }
    __device__ __forceinline__ void operator()(const f32x4 (&acc)[2][2][4][2], const Unit& u, int wr, int wc, int fr, int fq, PG8_LAS unsigned char* lds) const {
        const PG8_LAS f32x2* tab = (const PG8_LAS f32x2*)(lds + ROWTAB_OFF);
        const int col0 = u.pn * BM + wc * 32 + 4 * fq;
#pragma unroll
        for (int ai = 0; ai < 2; ++ai)
#pragma unroll
            for (int m = 0; m < 4; ++m) { const int rl = ai * HALF + wr * 64 + m * 16 + fr; const float rs = tab[rl].y; const size_t off = (size_t)(u.pm * BM + rl) * D + col0; float ss = 0.f;
#pragma unroll
                for (int bj = 0; bj < 2; ++bj)
#pragma unroll
                    for (int n = 0; n < 2; ++n) { const f32x4 xv = *(const f32x4*)(x + off + bj * HALF + n * 16); const f32x4 o = xv + acc[ai][bj][m][n] * rs;
                        *(f32x4*)(out + off + bj * HALF + n * 16) = o; ss += (o[0] * o[0] + o[1] * o[1]) + (o[2] * o[2] + o[3] * o[3]);
                        u32x2 w; w.x = cvt_pk_bf16(o[0], o[1]); w.y = cvt_pk_bf16(o[2], o[3]); *(u32x2*)(x1b + off + bj * HALF + n * 16) = w; }
                ss += __shfl_xor(ss, 16); ss += __shfl_xor(ss, 32);
                if (fq == 0) ssq2[(u.pm * BM + rl) * 16 + u.pn * 4 + wc] = ss; }
    }
};
struct EpiUp {
    static constexpr int MODE = 1, MIDK = 0;
    bf16_t* H;
    __device__ __forceinline__ void operator()(const f32x4 (&acc)[2][2][4][2], const Unit& u, int wr, int wc, int fr, int fq, PG8_LAS unsigned char* lds) const {
        const PG8_LAS f32x2* tab = (const PG8_LAS f32x2*)(lds + ROWTAB_OFF);
        const int col0 = u.pn * BM + wc * 32 + 8 * fq;
#pragma unroll
        for (int ai = 0; ai < 2; ++ai)
#pragma unroll
            for (int m = 0; m < 4; ++m) { const int rl = ai * HALF + wr * 64 + m * 16 + fr; const float r2 = tab[rl].x; bf16_t* rowp = H + (size_t)(u.pm * BM + rl) * FF + col0;
#pragma unroll
                for (int bj = 0; bj < 2; ++bj) { f32x4 v0 = acc[ai][bj][m][0] * r2, v1 = acc[ai][bj][m][1] * r2;
#pragma unroll
                    for (int e = 0; e < 4; ++e) { const float a = fmaxf(v0[e], 0.f), b = fmaxf(v1[e], 0.f); v0[e] = a * a; v1[e] = b * b; }
                    u32x4 w; w.x = cvt_pk_bf16(v0[0], v0[1]); w.y = cvt_pk_bf16(v0[2], v0[3]); w.z = cvt_pk_bf16(v1[0], v1[1]); w.w = cvt_pk_bf16(v1[2], v1[3]);
                    *(u32x4*)(rowp + bj * HALF) = w; } }
    }
};
struct EpiDown {
    static constexpr int MODE = 0, MIDK = 0;
    float* out;
    __device__ __forceinline__ void operator()(const f32x4 (&acc)[2][2][4][2], const Unit& u, int wr, int wc, int fr, int fq, PG8_LAS unsigned char*) const {
        const int col0 = u.pn * BM + wc * 32 + 4 * fq;
#pragma unroll
        for (int ai = 0; ai < 2; ++ai)
#pragma unroll
            for (int m = 0; m < 4; ++m) { const size_t off = (size_t)(u.pm * BM + ai * HALF + wr * 64 + m * 16 + fr) * D + col0;
#pragma unroll
                for (int bj = 0; bj < 2; ++bj)
#pragma unroll
                    for (int n = 0; n < 2; ++n) { float* p = out + off + bj * HALF + n * 16; *(f32x4*)p = *(const f32x4*)p + acc[ai][bj][m][n]; } }
    }
};
}


namespace att {
typedef short bf16x8 __attribute__((ext_vector_type(8)));
typedef short s16x4 __attribute__((ext_vector_type(4)));
typedef float f32x16 __attribute__((ext_vector_type(16)));
typedef __attribute__((address_space(3))) unsigned char* ldsp;
typedef short v4i16_t __attribute__((ext_vector_type(4)));
constexpr int LBUF_OFF = 131072 + 3072;
__device__ __forceinline__ int crow(int r, int hi) { return (r & 3) + 8 * (r >> 2) + 4 * hi; }
__device__ __forceinline__ unsigned cvtpk(float lo, float hi) { unsigned r; asm volatile("v_cvt_pk_bf16_f32 %0, %1, %2" : "=v"(r) : "v"(lo), "v"(hi)); return r; }
__device__ __forceinline__ s16x4 vtr(ldsp p) { return __builtin_bit_cast(s16x4, __builtin_amdgcn_ds_read_tr16_b64_v4i16((__attribute__((address_space(3))) v4i16_t*)p)); }

__device__ __forceinline__ void load_tile(const bf16* Kg, const bf16* Vg, int tok0, int d, ldsp buf, int lane) {
    { int tk = tok0 + d * (lane & 31); tk = tk < 0 ? 0 : tk; const bf16* src = Kg + (size_t)tk * AW + (lane >> 5) * 8;
#pragma unroll
      for (int c = 0; c < 4; ++c) __builtin_amdgcn_global_load_lds((const unsigned*)(src + c * 16), (__attribute__((address_space(3))) unsigned*)(buf + c * 1024), 16, 0, 0); }
#pragma unroll
    for (int pi = 0; pi < 4; ++pi) { int tk = tok0 + d * (16 * (pi & 1) + (lane >> 2)); tk = tk < 0 ? 0 : tk;
        const bf16* src = Vg + (size_t)tk * AW + (pi >> 1) * 32 + (lane & 3) * 8;
        __builtin_amdgcn_global_load_lds((const unsigned*)src, (__attribute__((address_space(3))) unsigned*)(buf + 4096 + pi * 1024), 16, 0, 0); }
}

template <int NBLK>
__device__ __forceinline__ void window(const bf16* Qg, const bf16* Kg, const bf16* Vg, int tb, int d, ldsp wbuf, f32x16 (&o)[NBLK][2], float (&l)[NBLK], float nshift, int lane) {
    const int r32 = lane & 31, hi = lane >> 5;
    constexpr int NT = NBLK + 4;
    load_tile(Kg, Vg, tb - 128 * d, d, wbuf, lane);
    bf16x8 q[NBLK][4];
#pragma unroll
    for (int b = 0; b < NBLK; ++b)
#pragma unroll
        for (int d0 = 0; d0 < 4; ++d0) q[b][d0] = *(const bf16x8*)(Qg + (size_t)(tb + d * (32 * b + r32)) * AW + d0 * 16 + hi * 8);
    f32x16 negs;
#pragma unroll
    for (int r = 0; r < 16; ++r) negs[r] = nshift;
    const int lbase = r32 - 4 * hi;
    int tok0 = tb - 128 * d;
#pragma unroll 1
    for (int T = 0; T < NT; ++T) {
        const ldsp cb = wbuf + (T & 1) * 8192;
        if (T + 1 < NT) { load_tile(Kg, Vg, tok0 + 32 * d, d, wbuf + ((T + 1) & 1) * 8192, lane); asm volatile("s_waitcnt vmcnt(8)" ::: "memory"); }
        else asm volatile("s_waitcnt vmcnt(0)" ::: "memory");
        bf16x8 kf[4];
#pragma unroll
        for (int d0 = 0; d0 < 4; ++d0) kf[d0] = *(const __attribute__((address_space(3))) bf16x8*)(cb + (2 * d0 + hi) * 512 + r32 * 16);
        bf16x8 vf[2][2];
        { const ldsp vp = cb + 4096 + ((lane >> 4) & 1) * 32 + (lane & 3) * 8 + (4 * hi + ((lane & 15) >> 2)) * 64;
#pragma unroll
          for (int s = 0; s < 2; ++s)
#pragma unroll
            for (int dh = 0; dh < 2; ++dh) { const s16x4 lo = vtr(vp + dh * 2048 + s * 1024), hh = vtr(vp + dh * 2048 + s * 1024 + 512);
                vf[s][dh] = (bf16x8){lo[0], lo[1], lo[2], lo[3], hh[0], hh[1], hh[2], hh[3]}; } }
        const int kmin = tok0 < 0 ? (-tok0 + d - 1) / d : 0;
#pragma unroll
        for (int b = 0; b < NBLK; ++b) {
            const int tb_ = T - b;
            if (tb_ < 0 || tb_ > 4) continue;
            f32x16 S = __builtin_amdgcn_mfma_f32_32x32x16_bf16(kf[0], q[b][0], negs, 0, 0, 0);
            S = __builtin_amdgcn_mfma_f32_32x32x16_bf16(kf[1], q[b][1], S, 0, 0, 0);
            S = __builtin_amdgcn_mfma_f32_32x32x16_bf16(kf[2], q[b][2], S, 0, 0, 0);
            S = __builtin_amdgcn_mfma_f32_32x32x16_bf16(kf[3], q[b][3], S, 0, 0, 0);
            const int dl = 128 - 32 * tb_;
            float p[16]; float ls = 0.f;
            if (tb_ >= 1 && tb_ <= 3 && kmin == 0) {
#pragma unroll
                for (int r = 0; r < 16; ++r) { p[r] = __builtin_amdgcn_exp2f(S[r]); ls += p[r]; }
            } else {
                const int x = lbase + dl;
#pragma unroll
                for (int r = 0; r < 16; ++r) { const int cr = (r & 3) + 8 * (r >> 2); const bool ok = ((unsigned)(x - cr) <= 128u) && (cr + 4 * hi >= kmin);
                    p[r] = ok ? __builtin_amdgcn_exp2f(S[r]) : 0.f; ls += p[r]; }
            }
            l[b] += ls;
            bf16x8 pa[2];
#pragma unroll
            for (int s = 0; s < 2; ++s) { typedef unsigned u4 __attribute__((ext_vector_type(4)));
                u4 w; w.x = cvtpk(p[8 * s + 0], p[8 * s + 1]); w.y = cvtpk(p[8 * s + 2], p[8 * s + 3]); w.z = cvtpk(p[8 * s + 4], p[8 * s + 5]); w.w = cvtpk(p[8 * s + 6], p[8 * s + 7]);
                pa[s] = __builtin_bit_cast(bf16x8, w); }
#pragma unroll
            for (int dh = 0; dh < 2; ++dh) { o[b][dh] = __builtin_amdgcn_mfma_f32_32x32x16_bf16(pa[0], vf[0][dh], o[b][dh], 0, 0, 0);
                                             o[b][dh] = __builtin_amdgcn_mfma_f32_32x32x16_bf16(pa[1], vf[1][dh], o[b][dh], 0, 0, 0); }
        }
        tok0 += 32 * d;
        asm volatile("s_waitcnt lgkmcnt(0)" ::: "memory");
    }
}

template <int MODE>
__device__ __forceinline__ void exchange1(const f32x16 (&o)[1][2], float l, int tl0, int d, int j, f32x16 (&oc)[2][2], float (&lc)[2], ldsp lds, int w, int lane) {
    const int r32 = lane & 31, hi = lane >> 5;
    __attribute__((address_space(3))) float* buf = (__attribute__((address_space(3))) float*)lds;
    __attribute__((address_space(3))) float* lbuf = (__attribute__((address_space(3))) float*)(lds + LBUF_OFF);
    __syncthreads();
#pragma unroll
    for (int dh = 0; dh < 2; ++dh)
#pragma unroll
        for (int r = 0; r < 16; ++r) buf[(tl0 + d * crow(r, hi)) * 64 + dh * 32 + r32] = o[0][dh][r];
    { const float lt = l + __shfl_xor(l, 32); if (hi == 0) lbuf[tl0 + d * r32] = lt; }
    __syncthreads();
    if (MODE == 16 || ((w >> 1) & 1) == j) {
#pragma unroll
        for (int b = 0; b < 2; ++b) {
#pragma unroll
            for (int dh = 0; dh < 2; ++dh)
#pragma unroll
                for (int r = 0; r < 16; ++r) { if (MODE == 16 && (r & 1) != j) continue; oc[b][dh][r] += buf[(64 * w + 32 * b + crow(r, hi)) * 64 + dh * 32 + r32]; }
            const float lv = lbuf[64 * w + 32 * b + r32];
            lc[b] += (MODE == 16 && (r32 & 1) != j) ? 0.f : lv; }
    }
    __syncthreads();
}

__device__ __forceinline__ void unit(const bf16* Q, const bf16* K, const bf16* V, bf16* MIXo, float* SSQA, int h, int i0, float nshift, ldsp lds, int tid_in) {
    int tid = tid_in; asm volatile("" : "+v"(tid));
    const int lane = tid & 63, w = __builtin_amdgcn_readfirstlane(tid >> 6), r32 = lane & 31, hi = lane >> 5;
    const bf16* Qg = Q + h * 64; const bf16* Kg = K + h * 64; const bf16* Vg = V + h * 64;
    const ldsp wbuf = lds + w * 16384;
    f32x16 oc[2][2]; float lc[2] = {0.f, 0.f};
#pragma unroll
    for (int b = 0; b < 2; ++b)
#pragma unroll
        for (int dh = 0; dh < 2; ++dh)
#pragma unroll
            for (int r = 0; r < 16; ++r) oc[b][dh][r] = 0.f;
    window<2>(Qg, Kg, Vg, i0 + 64 * w, 1, wbuf, oc, lc, nshift, lane);
    lc[0] += __shfl_xor(lc[0], 32); lc[1] += __shfl_xor(lc[1], 32);
#pragma unroll 1
    for (int j = 0; j < 2; ++j) { f32x16 o1[1][2]; float l1[1] = {0.f};
#pragma unroll
        for (int dh = 0; dh < 2; ++dh)
#pragma unroll
            for (int r = 0; r < 16; ++r) o1[0][dh][r] = 0.f;
        const int tl0 = (w & 3) + 128 * (2 * (w >> 2) + j);
        window<1>(Qg, Kg, Vg, i0 + tl0, 4, wbuf, o1, l1, nshift, lane);
        exchange1<4>(o1, l1[0], tl0, 4, j, oc, lc, lds, w, lane); }
#pragma unroll 1
    for (int j = 0; j < 2; ++j) { f32x16 o1[1][2]; float l1[1] = {0.f};
#pragma unroll
        for (int dh = 0; dh < 2; ++dh)
#pragma unroll
            for (int r = 0; r < 16; ++r) o1[0][dh][r] = 0.f;
        const int tl0 = 2 * w + j;
        window<1>(Qg, Kg, Vg, i0 + tl0, 16, wbuf, o1, l1, nshift, lane);
        exchange1<16>(o1, l1[0], tl0, 16, j, oc, lc, lds, w, lane); }
    __attribute__((address_space(3))) float* buf = (__attribute__((address_space(3))) float*)lds;
    __attribute__((address_space(3))) float* lbuf = (__attribute__((address_space(3))) float*)(lds + LBUF_OFF);
#pragma unroll
    for (int b = 0; b < 2; ++b) {
#pragma unroll
        for (int dh = 0; dh < 2; ++dh)
#pragma unroll
            for (int r = 0; r < 16; ++r) buf[(64 * w + 32 * b + crow(r, hi)) * 64 + dh * 32 + r32] = oc[b][dh][r];
        if (hi == 0) lbuf[64 * w + 32 * b + r32] = lc[b]; }
    __syncthreads();
#pragma unroll
    for (int k = 0; k < 8; ++k) { const int item = tid + 512 * k, tok = item >> 3, ch = item & 7;
        const f32x4 a = *(const __attribute__((address_space(3))) f32x4*)(buf + tok * 64 + ch * 8), c = *(const __attribute__((address_space(3))) f32x4*)(buf + tok * 64 + ch * 8 + 4);
        const float inv = 1.f / lbuf[tok];
        const f32x4 x = a * inv, y = c * inv;
        float ss = (x[0] * x[0] + x[1] * x[1]) + (x[2] * x[2] + x[3] * x[3]) + (y[0] * y[0] + y[1] * y[1]) + (y[2] * y[2] + y[3] * y[3]);
        v4u wv; wv.x = cvtpk(x[0], x[1]); wv.y = cvtpk(x[2], x[3]); wv.z = cvtpk(y[0], y[1]); wv.w = cvtpk(y[2], y[3]);
        *(v4u*)(MIXo + (size_t)(i0 + tok) * D + h * 64 + ch * 8) = wv;
        ss += __shfl_xor(ss, 1); ss += __shfl_xor(ss, 2); ss += __shfl_xor(ss, 4);
        if (ch == 0) SSQA[(i0 + tok) * 8 + h] = ss; }
    __syncthreads();
}
}


namespace ssm {
typedef short bf16x8 __attribute__((ext_vector_type(8)));
typedef __attribute__((address_space(3))) unsigned char* ldsp;
__device__ __forceinline__ void load_u_frags(const bf16* U, int tile, int g, int lane, bf16x8 (&a)[8]) {
    const int chunk = lane & 15, kq = lane >> 4;
    const bf16* p = U + (size_t)(tile * TILE + 16 * chunk + (kq >> 1)) * SW + 16 * g + 8 * (kq & 1);
#pragma unroll
    for (int ks = 0; ks < 8; ++ks) a[ks] = *(const bf16x8*)(p + (size_t)(2 * ks) * SW);
}
__device__ __forceinline__ void phaseA(const unsigned char* ws_, int tile, int g, ldsp scr, int lane) {
    unsigned char* ws = const_cast<unsigned char*>(ws_);
    bf16x8 a[8]; load_u_frags((const bf16*)(ws + WS_U), tile, g, lane, a);
    const bf16* W = (const bf16*)(ws + WS_WST) + (size_t)g * 128 * 256 + (size_t)(lane & 15) * 256 + 8 * (lane >> 4);
    __attribute__((address_space(3))) float* s = (__attribute__((address_space(3))) float*)scr;
#pragma unroll
    for (int nt = 0; nt < 8; ++nt) { f32x4 acc = {0.f, 0.f, 0.f, 0.f};
#pragma unroll
        for (int ks = 0; ks < 8; ++ks) { const bf16x8 b = *(const bf16x8*)(W + (size_t)nt * 16 * 256 + 32 * ks); acc = __builtin_amdgcn_mfma_f32_16x16x32_bf16(a[ks], b, acc, 0, 0, 0); }
#pragma unroll
        for (int e = 0; e < 4; ++e) s[(4 * (lane >> 4) + e) * 128 + 16 * nt + (lane & 15)] = acc[e]; }
    asm volatile("s_waitcnt lgkmcnt(0)" ::: "memory");
    const int p = lane;
    const f32x2 al = ((const f32x2*)(ws + WS_ALP))[(g * 16 + 1) * 64 + p];
    float* XLOC = (float*)(ws + WS_XLOC) + ((size_t)(tile * NG + g) * 16) * 128;
    float xr = 0.f, xi = 0.f;
#pragma unroll
    for (int j = 0; j < NCH; ++j) { XLOC[j * 128 + p] = xr; XLOC[j * 128 + 64 + p] = xi;
        const float sr = s[j * 128 + p], si = s[j * 128 + 64 + p];
        const float nr = al.x * xr - al.y * xi + sr, ni = al.x * xi + al.y * xr + si; xr = nr; xi = ni; }
    float* ST = (float*)(ws + WS_STILE) + (size_t)(tile * NG + g) * 128; ST[p] = xr; ST[64 + p] = xi;
    asm volatile("s_waitcnt lgkmcnt(0)" ::: "memory");
}
__device__ __forceinline__ void phaseB(const unsigned char* ws_, int tile, int g, ldsp scr, int lane) {
    unsigned char* ws = const_cast<unsigned char*>(ws_);
    { const int p = lane; float tr = 0.f, ti = 0.f;
      const f32x2* ATP = (const f32x2*)(ws + WS_ATP) + (size_t)g * 64 * 64; const float* ST = (const float*)(ws + WS_STILE) + (size_t)g * 128;
      for (int j = 0; j < tile; ++j) { const f32x2 a = ATP[(tile - 1 - j) * 64 + p]; const float sr = ST[(size_t)j * NG * 128 + p], si = ST[(size_t)j * NG * 128 + 64 + p];
          tr += a.x * sr - a.y * si; ti += a.x * si + a.y * sr; }
      const float* XLOC = (const float*)(ws + WS_XLOC) + ((size_t)(tile * NG + g) * 16) * 128;
      const f32x2* ALP = (const f32x2*)(ws + WS_ALP) + (size_t)g * 16 * 64;
      __attribute__((address_space(3))) bf16* xp = (__attribute__((address_space(3))) bf16*)scr;
#pragma unroll
      for (int j = 0; j < NCH; ++j) { const f32x2 a = ALP[j * 64 + p];
          xp[j * 128 + p] = (bf16)f2bf(XLOC[j * 128 + p] + a.x * tr - a.y * ti); xp[j * 128 + 64 + p] = (bf16)f2bf(XLOC[j * 128 + 64 + p] + a.x * ti + a.y * tr); } }
    asm volatile("s_waitcnt lgkmcnt(0)" ::: "memory");
    const int c = lane & 15, kq = lane >> 4;
    bf16x8 ax[4];
#pragma unroll
    for (int ks = 0; ks < 4; ++ks) ax[ks] = *(const __attribute__((address_space(3))) bf16x8*)(scr + c * 256 + (32 * ks + 8 * kq) * 2);
    bf16x8 au[8]; load_u_frags((const bf16*)(ws + WS_U), tile, g, lane, au);
    const bf16* WC = (const bf16*)(ws + WS_WCR) + (size_t)g * 256 * 128 + (size_t)c * 128 + 8 * kq;
    const bf16* TMg = (const bf16*)(ws + WS_TM) + (size_t)g * 17 * 256 + c * 16 + 8 * (kq & 1);
    __attribute__((address_space(3))) bf16* zt = (__attribute__((address_space(3))) bf16*)(scr + 4096);
#pragma unroll
    for (int t = 0; t < 16; ++t) { f32x4 acc = {0.f, 0.f, 0.f, 0.f};
#pragma unroll
        for (int ks = 0; ks < 4; ++ks) { const bf16x8 b = *(const bf16x8*)(WC + (size_t)t * 16 * 128 + 32 * ks); acc = __builtin_amdgcn_mfma_f32_16x16x32_bf16(ax[ks], b, acc, 0, 0, 0); }
#pragma unroll
        for (int ks = 0; ks <= t / 2; ++ks) { const int li = t - 2 * ks - (kq >> 1) + 1;
            const bf16x8 b = *(const bf16x8*)(TMg + (li < 0 ? 0 : li) * 256); acc = __builtin_amdgcn_mfma_f32_16x16x32_bf16(au[ks], b, acc, 0, 0, 0); }
#pragma unroll
        for (int e = 0; e < 4; ++e) { const float y = acc[e]; const float u2 = 1.5957691216057308f * (y + 0.044715f * y * y * y);
            const float z = y * __builtin_amdgcn_rcpf(1.f + __builtin_amdgcn_exp2f(-1.4426950408889634f * u2));
            zt[(16 * (4 * kq + e) + t) * 16 + c] = (bf16)f2bf(z); }
        asm volatile("" ::: "memory"); }
    asm volatile("s_waitcnt lgkmcnt(0)" ::: "memory");
    bf16* Z = (bf16*)(ws + WS_Z) + (size_t)tile * TILE * SW + 16 * g;
#pragma unroll
    for (int k = 0; k < 8; ++k) { const int item = lane + 64 * k, tok = item >> 1, hf = item & 1;
        const v4u v = *(const __attribute__((address_space(3))) v4u*)(scr + 4096 + tok * 32 + hf * 16);
        *(v4u*)(Z + (size_t)tok * SW + 8 * hf) = v; }
    asm volatile("s_waitcnt lgkmcnt(0)" ::: "memory");
}
}

struct Args { const float* in[21]; float* out; unsigned char* ws; int ph_lo, ph_hi; };
struct Frame {
    LAS unsigned char* lds;
    int tid, lane, wave, G, bid;
    const float* in[21]; float* out; unsigned char* ws;
};
#define P_X 0
#define P_G1 1
#define P_WIN 2
#define P_GQ 3
#define P_GK 4
#define P_ARE 5
#define P_AIM 6
#define P_LDT 7
#define P_BRE 8
#define P_BIM 9
#define P_CRE 10
#define P_CIM 11
#define P_DSK 12
#define P_GLUW 13
#define P_GLUB 14
#define P_GA 15
#define P_GS 16
#define P_WOUT 17
#define P_G2 18
#define P_WUP 19
#define P_WDOWN 20

__device__ __forceinline__ void p0_transpose_item(const float* W, int K, int N, bf16* WT, const float* g_lo, const float* g_hi, int split, LAS float* scr, int item, int lane) {
    const int nblk = N / 32, kb = item / nblk, nb = item % nblk, k0 = 64 * kb, n0 = 32 * nb;
#pragma unroll 8
    for (int i = 0; i < 32; ++i) { const int kk = 2 * i + (lane >> 5); const int k = k0 + kk;
        const float g = g_lo ? (k < split ? g_lo[k] : g_hi[k - split]) : 1.f;
        scr[kk * 33 + (lane & 31)] = W[(size_t)k * N + n0 + (lane & 31)] * g; }
    asm volatile("s_waitcnt lgkmcnt(0)" ::: "memory");
    const int c = lane & 7;
#pragma unroll
    for (int j = 0; j < 4; ++j) { const int n = (lane >> 3) + 8 * j; const LAS float* s = scr + (8 * c) * 33 + n;
        v4u o; o.x = pk2(s[0 * 33], s[1 * 33]); o.y = pk2(s[2 * 33], s[3 * 33]); o.z = pk2(s[4 * 33], s[5 * 33]); o.w = pk2(s[6 * 33], s[7 * 33]);
        *(GAS v4u*)(WT + (size_t)(n0 + n) * K + k0 + 8 * c) = o; }
    asm volatile("s_waitcnt lgkmcnt(0)" ::: "memory");
}
__device__ __forceinline__ void rms_row_to_bf16(const float* xrow, bf16* orow, int lane) {
    const GAS f32x4* xr = (const GAS f32x4*)xrow + lane;
    f32x4 v[4]; float s = 0.f;
#pragma unroll
    for (int j = 0; j < 4; ++j) { v[j] = xr[64 * j]; s += (v[j].x * v[j].x + v[j].y * v[j].y) + (v[j].z * v[j].z + v[j].w * v[j].w); }
    const float rstd = 1.f / sqrtf(wave_sum(s) * (1.f / D) + EPS);
    GAS unsigned long long* o8 = (GAS unsigned long long*)orow + lane;
#pragma unroll
    for (int j = 0; j < 4; ++j) o8[64 * j] = (unsigned long long)pk2(v[j].x * rstd, v[j].y * rstd) | ((unsigned long long)pk2(v[j].z * rstd, v[j].w * rstd) << 32);
}
struct cd { double re, im; };
__device__ __forceinline__ cd cmul(cd a, cd b) { return cd{a.re * b.re - a.im * b.im, a.re * b.im + a.im * b.re}; }
__device__ __forceinline__ void p0_ssm_tables(Frame& F, int g) {
    cd* apow = (cd*)(__attribute__((address_space(3))) cd*)(F.lds);
    cd* bbar = apow + 17 * 64;
    cd* cc = bbar + 64 * 16;
    const float* a_re = F.in[P_ARE] + g * 64; const float* a_im = F.in[P_AIM] + g * 64;
    const double dt = exp((double)F.in[P_LDT][g]);
    const int tid = F.tid;
    for (int i = tid; i < 17 * 64; i += NTHREADS) { const int j = i >> 6, p = i & 63; const double lr = a_re[p], li = a_im[p];
        const double mag = exp(j * lr * dt), ang = j * li * dt; apow[i] = cd{mag * cos(ang), mag * sin(ang)}; }
    for (int i = tid; i < 64 * 16; i += NTHREADS) { const int p = i >> 4, c = i & 15; const double lr = a_re[p], li = a_im[p];
        const double mag = exp(lr * dt), ang = li * dt; const double abr = mag * cos(ang), abi = mag * sin(ang);
        const double den = lr * lr + li * li, nr = abr - 1.0, ni = abi; const double cr = (nr * lr + ni * li) / den, ci = (ni * lr - nr * li) / den;
        const double br = F.in[P_BRE][(g * 64 + p) * 16 + c], bi = F.in[P_BIM][(g * 64 + p) * 16 + c];
        bbar[i] = cd{cr * br - ci * bi, cr * bi + ci * br}; }
    for (int i = tid; i < 16 * 64; i += NTHREADS) cc[i] = cd{(double)F.in[P_CRE][g * 1024 + i], (double)F.in[P_CIM][g * 1024 + i]};
    __syncthreads();
    bf16* TM = (bf16*)(F.ws + WS_TM) + (size_t)g * 17 * 256;
    bf16* WST = (bf16*)(F.ws + WS_WST) + (size_t)g * 128 * 256;
    bf16* WCR = (bf16*)(F.ws + WS_WCR) + (size_t)g * 256 * 128;
    f32x2* ALP = (f32x2*)(F.ws + WS_ALP) + (size_t)g * 16 * 64;
    f32x2* ATP = (f32x2*)(F.ws + WS_ATP) + (size_t)g * 64 * 64;
    for (int i = tid; i < 17 * 256; i += NTHREADS) { const int l1 = i >> 8, c = (i >> 4) & 15, c2 = i & 15; double s = 0.0;
        if (l1 > 0) { const int lag = l1 - 1;
            for (int p = 0; p < 64; ++p) { const cd t = cmul(cmul(cc[c * 64 + p], apow[lag * 64 + p]), bbar[p * 16 + c2]); s += t.re; }
            if (lag == 0 && c == c2) s += (double)F.in[P_DSK][g * 16 + c]; }
        TM[i] = (bf16)f2bf((float)s); }
    for (int i = tid; i < 128 * 256; i += NTHREADS) { const int q = i >> 8, k = i & 255, s = k >> 4, c2 = k & 15, p = q & 63;
        const cd w = cmul(apow[(15 - s) * 64 + p], bbar[p * 16 + c2]); WST[i] = (bf16)f2bf((float)(q < 64 ? w.re : w.im)); }
    for (int i = tid; i < 256 * 128; i += NTHREADS) { const int n = i >> 7, q = i & 127, t = n >> 4, c = n & 15, p = q & 63;
        const cd w = cmul(cc[c * 64 + p], apow[(t + 1) * 64 + p]); WCR[i] = (bf16)f2bf((float)(q < 64 ? w.re : -w.im)); }
    for (int i = tid; i < 16 * 64; i += NTHREADS) { const int j = i >> 6, p = i & 63; const double lr = a_re[p], li = a_im[p];
        const double n = 16.0 * j; const double mag = exp(n * lr * dt), ang = n * li * dt; ALP[i] = (f32x2){(float)(mag * cos(ang)), (float)(mag * sin(ang))}; }
    for (int i = tid; i < 64 * 64; i += NTHREADS) { const int m = i >> 6, p = i & 63; const double lr = a_re[p], li = a_im[p];
        const double n = 256.0 * m; const double mag = exp(n * lr * dt), ang = n * li * dt; ATP[i] = (f32x2){(float)(mag * cos(ang)), (float)(mag * sin(ang))}; }
    __syncthreads();
}
__device__ __forceinline__ void p0_prologue(Frame& F) {
    if (F.bid < NG) p0_ssm_tables(F, F.bid);
    LAS float* scr = (LAS float*)(F.lds + F.wave * 16384);
    const int gw = F.bid * NWAVES + F.wave, NGW = F.G * NWAVES;
    constexpr int I_IN = (D / 64) * (PW / 32), I_GLU = (SW / 64) * (SW / 32), I_OUT = (D / 64) * (D / 32), I_UP = (D / 64) * (FF / 32), I_DOWN = (FF / 64) * (D / 32);
    constexpr int NITEMS = I_IN + I_GLU + I_OUT + I_UP + I_DOWN;
    for (int it = gw; it < NITEMS; it += NGW) {
        int r = it;
        if (r < I_IN) { p0_transpose_item(F.in[P_WIN], D, PW, (bf16*)(F.ws + WS_WIN), F.in[P_G1], F.in[P_G1], D, scr, r, F.lane); continue; } r -= I_IN;
        if (r < I_GLU) { p0_transpose_item(F.in[P_GLUW], SW, SW, (bf16*)(F.ws + WS_WGLU), nullptr, nullptr, 0, scr, r, F.lane); continue; } r -= I_GLU;
        if (r < I_OUT) { p0_transpose_item(F.in[P_WOUT], D, D, (bf16*)(F.ws + WS_WOUT), F.in[P_GA], F.in[P_GS], AW, scr, r, F.lane); continue; } r -= I_OUT;
        if (r < I_UP) { p0_transpose_item(F.in[P_WUP], D, FF, (bf16*)(F.ws + WS_WUP), F.in[P_G2], F.in[P_G2], D, scr, r, F.lane); continue; } r -= I_UP;
        p0_transpose_item(F.in[P_WDOWN], FF, D, (bf16*)(F.ws + WS_WDOWN), nullptr, nullptr, 0, scr, r, F.lane);
    }
    for (int m = gw; m < M; m += NGW) rms_row_to_bf16(F.in[P_X] + (size_t)m * D, (bf16*)(F.ws + WS_XN) + (size_t)m * D, F.lane);
}

__device__ __forceinline__ float att_shift(Frame& F) {
    float mq = 0.f, mk = 0.f;
    for (int i = 0; i < 64; ++i) { mq = fmaxf(mq, fabsf(F.in[P_GQ][i])); mk = fmaxf(mk, fabsf(F.in[P_GK][i])); }
    return 64.f * mq * mk * C2 * 1.0001f;
}
__device__ __forceinline__ void p1_naive(Frame& F) {
    const bf16* XN = (const bf16*)(F.ws + WS_XN); const bf16* W = (const bf16*)(F.ws + WS_WIN);
    const size_t total = (size_t)M * PW, nthr = (size_t)F.G * NTHREADS;
    for (size_t idx = (size_t)F.bid * NTHREADS + F.tid; idx < total; idx += nthr) {
        const int m = (int)(idx / PW), n = (int)(idx % PW);
        const float acc = dot_bf16(XN + (size_t)m * D, W + (size_t)n * D, D);
        const int seg = n >> 9, c = n & 511;
        float v = acc;
        if (seg < 2) { const float ss = wave_sum(acc * acc); const float r = 1.f / sqrtf(ss * (1.f / 64.f) + EPS);
            v = acc * r * (seg == 0 ? F.in[P_GQ][c & 63] * C2 : F.in[P_GK][c & 63]); }
        bf16* dst = (bf16*)(F.ws + (seg == 0 ? WS_Q : seg == 1 ? WS_K : seg == 2 ? WS_V : WS_U));
        dst[(size_t)m * AW + c] = (bf16)f2bf(v);
    }
}
__device__ __forceinline__ void p2_attn_naive(Frame& F) {
    const bf16* Q = (const bf16*)(F.ws + WS_Q); const bf16* K = (const bf16*)(F.ws + WS_K); const bf16* V = (const bf16*)(F.ws + WS_V);
    bf16* ATT = (bf16*)(F.ws + WS_MIX); float* SSQA = (float*)(F.ws + WS_SSQA);
    const float shift = att_shift(F);
    const int gw = F.bid * NWAVES + F.wave, NGW = F.G * NWAVES;
    for (int it = gw; it < M * NH; it += NGW) {
        const int m = it >> 3, h = it & 7; const int col = h * 64 + F.lane;
        const float q = bf2f(Q[(size_t)m * AW + col]);
        float o = 0.f, l = 0.f;
        for (int di = 0; di < 3; ++di) { const int d = di == 0 ? 1 : di == 1 ? 4 : 16;
            for (int mm = 0; mm <= 128; ++mm) { const int j = m - d * mm; if (j < 0) break;
                const float s = wave_sum(q * bf2f(K[(size_t)j * AW + col]));
                const float p = exp2f(s - shift);
                l += p; o += p * bf2f(V[(size_t)j * AW + col]); } }
        const float r = o / l;
        ATT[(size_t)m * D + col] = (bf16)f2bf(r);
        const float ss = wave_sum(r * r);
        if (F.lane == 0) SSQA[m * 8 + h] = ss;
    }
}
__device__ __forceinline__ void p2_ssmA_naive(Frame& F) {
    const bf16* U = (const bf16*)(F.ws + WS_U);
    const size_t nthr = (size_t)F.G * NTHREADS;
    for (size_t idx = (size_t)F.bid * NTHREADS + F.tid; idx < (size_t)NTILE * NG * 64; idx += nthr) {
        const int p = (int)(idx & 63), g = (int)((idx >> 6) & 31), tile = (int)(idx >> 11);
        const bf16* Wr = (const bf16*)(F.ws + WS_WST) + ((size_t)g * 128 + p) * 256; const bf16* Wi = Wr + 64 * 256;
        const f32x2 al = ((const f32x2*)(F.ws + WS_ALP))[(g * 16 + 1) * 64 + p];
        float* XLOC = (float*)(F.ws + WS_XLOC) + ((size_t)(tile * NG + g) * 16) * 128;
        float xr = 0.f, xi = 0.f;
        for (int j = 0; j < NCH; ++j) {
            XLOC[j * 128 + p] = xr; XLOC[j * 128 + 64 + p] = xi;
            float sr = 0.f, si = 0.f;
            for (int k = 0; k < 256; ++k) { const float u = bf2f(U[(size_t)(tile * TILE + j * LCH + (k >> 4)) * SW + g * 16 + (k & 15)]); sr += u * bf2f(Wr[k]); si += u * bf2f(Wi[k]); }
            const float nr = al.x * xr - al.y * xi + sr, ni = al.x * xi + al.y * xr + si; xr = nr; xi = ni;
        }
        float* ST = (float*)(F.ws + WS_STILE) + (size_t)(tile * NG + g) * 128; ST[p] = xr; ST[64 + p] = xi;
    }
}
__device__ __forceinline__ float gelu_tanh(float y) { const float t = tanhf(0.7978845608028654f * (y + 0.044715f * y * y * y)); return 0.5f * y * (1.f + t); }
__device__ __forceinline__ void p3_ssmB_naive(Frame& F) {
    const bf16* U = (const bf16*)(F.ws + WS_U); bf16* Z = (bf16*)(F.ws + WS_Z);
    LAS float* xp = (LAS float*)F.lds;
    for (int pair = F.bid; pair < NTILE * NG; pair += F.G) {
        const int tile = pair >> 5, g = pair & 31;
        if (F.tid < 64) { const int p = F.tid; float tr = 0.f, ti = 0.f;
            const f32x2* ATP = (const f32x2*)(F.ws + WS_ATP) + (size_t)g * 64 * 64;
            for (int j = 0; j < tile; ++j) { const f32x2 a = ATP[(tile - 1 - j) * 64 + p]; const float* ST = (const float*)(F.ws + WS_STILE) + (size_t)(j * NG + g) * 128;
                const float sr = ST[p], si = ST[64 + p]; tr += a.x * sr - a.y * si; ti += a.x * si + a.y * sr; }
            const float* XLOC = (const float*)(F.ws + WS_XLOC) + ((size_t)(tile * NG + g) * 16) * 128;
            const f32x2* ALP = (const f32x2*)(F.ws + WS_ALP) + (size_t)g * 16 * 64;
            for (int j = 0; j < NCH; ++j) { const f32x2 a = ALP[j * 64 + p];
                xp[j * 128 + p] = XLOC[j * 128 + p] + a.x * tr - a.y * ti; xp[j * 128 + 64 + p] = XLOC[j * 128 + 64 + p] + a.x * ti + a.y * tr; } }
        __syncthreads();
        const bf16* TM = (const bf16*)(F.ws + WS_TM) + (size_t)g * 17 * 256; const bf16* WCR = (const bf16*)(F.ws + WS_WCR) + (size_t)g * 256 * 128;
        for (int o = F.tid; o < TILE * 16; o += NTHREADS) { const int tl = o >> 4, c = o & 15, j = tl >> 4, t = tl & 15; float y = 0.f;
            for (int s = 0; s <= t; ++s) { const bf16* tm = TM + ((t - s + 1) * 16 + c) * 16; const bf16* u = U + (size_t)(tile * TILE + j * LCH + s) * SW + g * 16;
                for (int c2 = 0; c2 < 16; ++c2) y += bf2f(tm[c2]) * bf2f(u[c2]); }
            const bf16* wc = WCR + (size_t)(t * 16 + c) * 128;
            for (int q = 0; q < 128; ++q) y += xp[j * 128 + q] * bf2f(wc[q]);
            Z[(size_t)(tile * TILE + tl) * SW + g * 16 + c] = (bf16)f2bf(gelu_tanh(y)); }
        __syncthreads();
    }
}
__device__ __forceinline__ void p4_glu_naive(Frame& F) {
    const bf16* Z = (const bf16*)(F.ws + WS_Z); const bf16* W = (const bf16*)(F.ws + WS_WGLU); bf16* O = (bf16*)(F.ws + WS_MIX) + AW; float* SSQS = (float*)(F.ws + WS_SSQS);
    const size_t total = (size_t)M * SW, nthr = (size_t)F.G * NTHREADS;
    for (size_t idx = (size_t)F.bid * NTHREADS + F.tid; idx < total; idx += nthr) {
        const int m = (int)(idx >> 9), n = (int)(idx & 511);
        const float acc = dot_bf16(Z + (size_t)m * SW, W + (size_t)n * SW, SW) + F.in[P_GLUB][n];
        const float z = bf2f(Z[(size_t)m * SW + n]); const float o = z / (1.f + expf(-acc));
        O[(size_t)m * D + n] = (bf16)f2bf(o);
        const float ss = wave_sum(o * o); if (F.lane == 0) SSQS[m * 8 + (n >> 6)] = ss;
    }
}
__device__ __forceinline__ void p5_out_naive(Frame& F) {
    const bf16* A = (const bf16*)(F.ws + WS_MIX); const bf16* S = (const bf16*)(F.ws + WS_MIX) + AW; const bf16* W = (const bf16*)(F.ws + WS_WOUT);
    const float* SSQA = (const float*)(F.ws + WS_SSQA); const float* SSQS = (const float*)(F.ws + WS_SSQS); float* SSQ2 = (float*)(F.ws + WS_SSQ2); bf16* X1B = (bf16*)(F.ws + WS_XN);
    const size_t total = (size_t)M * D, nthr = (size_t)F.G * NTHREADS;
    for (size_t idx = (size_t)F.bid * NTHREADS + F.tid; idx < total; idx += nthr) {
        const int m = (int)(idx >> 10), n = (int)(idx & 1023);
        float sa = 0.f, ss = 0.f;
        for (int i = 0; i < 8; ++i) { sa += SSQA[m * 8 + i]; ss += SSQS[m * 8 + i]; }
        const float ra = 1.f / sqrtf(sa * (1.f / 512.f) + EPS), rs = 1.f / sqrtf(ss * (1.f / 512.f) + EPS);
        const float accA = dot_bf16(A + (size_t)m * D, W + (size_t)n * D, AW), accS = dot_bf16(S + (size_t)m * D, W + (size_t)n * D + AW, SW);
        const float x1 = F.in[P_X][(size_t)m * D + n] + ra * accA + rs * accS;
        F.out[(size_t)m * D + n] = x1; X1B[(size_t)m * D + n] = (bf16)f2bf(x1);
        const float q = wave_sum(x1 * x1); if (F.lane == 0) SSQ2[m * 16 + (n >> 6)] = q;
    }
}
__device__ __forceinline__ void p6_up_naive(Frame& F) {
    const bf16* A = (const bf16*)(F.ws + WS_XN); const bf16* W = (const bf16*)(F.ws + WS_WUP); const float* SSQ2 = (const float*)(F.ws + WS_SSQ2); bf16* H = (bf16*)(F.ws + WS_H);
    const size_t total = (size_t)M * FF, nthr = (size_t)F.G * NTHREADS;
    for (size_t idx = (size_t)F.bid * NTHREADS + F.tid; idx < total; idx += nthr) {
        const int m = (int)(idx >> 12), n = (int)(idx & 4095);
        float s2 = 0.f; for (int i = 0; i < 16; ++i) s2 += SSQ2[m * 16 + i];
        const float r2 = 1.f / sqrtf(s2 * (1.f / 1024.f) + EPS);
        const float a = fmaxf(r2 * dot_bf16(A + (size_t)m * D, W + (size_t)n * D, D), 0.f);
        H[(size_t)m * FF + n] = (bf16)f2bf(a * a);
    }
}
__device__ __forceinline__ void p7_down_naive(Frame& F) {
    const bf16* H = (const bf16*)(F.ws + WS_H); const bf16* W = (const bf16*)(F.ws + WS_WDOWN);
    const size_t total = (size_t)M * D, nthr = (size_t)F.G * NTHREADS;
    for (size_t idx = (size_t)F.bid * NTHREADS + F.tid; idx < total; idx += nthr) {
        const int m = (int)(idx >> 10), n = (int)(idx & 1023);
        F.out[(size_t)m * D + n] += dot_bf16(H + (size_t)m * FF, W + (size_t)n * FF, FF);
    }
}


__device__ __forceinline__ int wg_pm(int c) { return 8 * (c & 7) + ((c >> 3) & 7); }
__device__ __forceinline__ void p1_fast(Frame& F) {
    pg8::Gemm g{(const bf16*)(F.ws + WS_XN), (const bf16*)(F.ws + WS_WIN), M, PW, D}; pg8::StaticOrder S; S.init(M, PW, F.G, F.bid);
    pg8::EpiInProj E{(bf16*)(F.ws + WS_Q), (bf16*)(F.ws + WS_K), (bf16*)(F.ws + WS_V), (bf16*)(F.ws + WS_U), F.in[P_GQ], F.in[P_GK]};
    pg8::gemm_phase<pg8::EpiInProj, pg8::StaticOrder, true>(F.lds, g, S, E);
}
__device__ __forceinline__ void p4_fast(Frame& F) {
    pg8::Gemm g{(const bf16*)(F.ws + WS_Z), (const bf16*)(F.ws + WS_WGLU), M, SW, SW}; pg8::StaticOrder S; S.init(M, SW, F.G, F.bid);
    pg8::EpiGlu E{(const bf16*)(F.ws + WS_Z), (bf16*)(F.ws + WS_MIX) + AW, F.in[P_GLUB], (float*)(F.ws + WS_SSQS)};
    pg8::gemm_phase<pg8::EpiGlu, pg8::StaticOrder, true>(F.lds, g, S, E);
}
__device__ __forceinline__ void p5_fast(Frame& F) {
    LAS f32x2* tab = (LAS f32x2*)(F.lds + ROWTAB_OFF);
    if (F.tid < 256) { const int row = wg_pm(F.bid) * 256 + F.tid; const f32x4* a = (const f32x4*)((const float*)(F.ws + WS_SSQA) + row * 8); const f32x4* s = (const f32x4*)((const float*)(F.ws + WS_SSQS) + row * 8);
        const f32x4 a0 = a[0], a1 = a[1], s0 = s[0], s1 = s[1];
        const float sa = ((a0[0] + a0[1]) + (a0[2] + a0[3])) + ((a1[0] + a1[1]) + (a1[2] + a1[3])), ss = ((s0[0] + s0[1]) + (s0[2] + s0[3])) + ((s1[0] + s1[1]) + (s1[2] + s1[3]));
        const float ra = 1.f / sqrtf(sa * (1.f / 512.f) + EPS), rs = 1.f / sqrtf(ss * (1.f / 512.f) + EPS);
        tab[F.tid] = (f32x2){ra / rs, rs}; }
    __syncthreads();
    pg8::Gemm g{(const bf16*)(F.ws + WS_MIX), (const bf16*)(F.ws + WS_WOUT), M, D, D}; pg8::StaticOrder S; S.init(M, D, F.G, F.bid);
    pg8::EpiOut E{F.in[P_X], F.out, (bf16*)(F.ws + WS_XN), (float*)(F.ws + WS_SSQ2)};
    pg8::gemm_phase<pg8::EpiOut, pg8::StaticOrder, true>(F.lds, g, S, E);
}
__device__ __forceinline__ void p6_fast(Frame& F) {
    LAS f32x2* tab = (LAS f32x2*)(F.lds + ROWTAB_OFF);
    if (F.tid < 256) { const int row = wg_pm(F.bid) * 256 + F.tid; const f32x4* q = (const f32x4*)((const float*)(F.ws + WS_SSQ2) + row * 16); float s = 0.f;
#pragma unroll
        for (int i = 0; i < 4; ++i) { const f32x4 v = q[i]; s += (v[0] + v[1]) + (v[2] + v[3]); }
        tab[F.tid] = (f32x2){1.f / sqrtf(s * (1.f / 1024.f) + EPS), 0.f}; }
    __syncthreads();
    pg8::Gemm g{(const bf16*)(F.ws + WS_XN), (const bf16*)(F.ws + WS_WUP), M, FF, D}; pg8::StaticOrder S; S.init(M, FF, F.G, F.bid);
    pg8::EpiUp E{(bf16*)(F.ws + WS_H)};
    pg8::gemm_phase<pg8::EpiUp, pg8::StaticOrder, true>(F.lds, g, S, E);
}
__device__ __forceinline__ void p7_fast(Frame& F) {
    pg8::Gemm g{(const bf16*)(F.ws + WS_H), (const bf16*)(F.ws + WS_WDOWN), M, D, FF}; pg8::StaticOrder S; S.init(M, D, F.G, F.bid);
    pg8::EpiDown E{F.out};
    pg8::gemm_phase<pg8::EpiDown, pg8::StaticOrder, true>(F.lds, g, S, E);
}


__device__ __forceinline__ void p2_attn_fast(Frame& F) {
    float mq = fabsf(F.in[P_GQ][F.lane]), mk = fabsf(F.in[P_GK][F.lane]);
#pragma unroll
    for (int o = 1; o < 64; o <<= 1) { mq = fmaxf(mq, __shfl_xor(mq, o)); mk = fmaxf(mk, __shfl_xor(mk, o)); }
    const float nshift = -(64.f * mq * mk * C2 * 1.0001f);
    for (int u = F.bid; u < NH * (M / 512); u += F.G)
        att::unit((const bf16*)(F.ws + WS_Q), (const bf16*)(F.ws + WS_K), (const bf16*)(F.ws + WS_V), (bf16*)(F.ws + WS_MIX), (float*)(F.ws + WS_SSQA), u & 7, (u >> 3) * 512, nshift, F.lds, F.tid);
}


__device__ __forceinline__ void p2_ssmA_fast(Frame& F) {
    for (int id = F.bid * NWAVES + F.wave; id < NTILE * NG; id += F.G * NWAVES) { const int g = (id >> 3) & 31, tile = (id >> 8) * 8 + (id & 7);
        ssm::phaseA(F.ws, tile, g, F.lds + F.wave * 16384, F.lane); }
}
__device__ __forceinline__ void p3_ssmB_fast(Frame& F) {
    for (int id = F.bid * NWAVES + F.wave; id < NTILE * NG; id += F.G * NWAVES) { const int g = (id >> 3) & 31, tile = (id >> 8) * 8 + (id & 7);
        ssm::phaseB(F.ws, tile, g, F.lds + F.wave * 16384, F.lane); }
}

constexpr int N_PHASES = 8;
__global__ void __launch_bounds__(NTHREADS, 2) mk_fwd(Args args) {
    extern __shared__ __attribute__((aligned(16))) unsigned char lds_raw[];
    Frame F;
    F.lds = (LAS unsigned char*)lds_raw;
    F.tid = threadIdx.x; F.lane = F.tid & 63; F.wave = __builtin_amdgcn_readfirstlane(F.tid >> 6);
    F.G = gridDim.x; F.bid = blockIdx.x;
#pragma unroll
    for (int i = 0; i < 21; ++i) F.in[i] = args.in[i];
    F.out = args.out; F.ws = args.ws;
    volatile LAS unsigned* MISC = (volatile LAS unsigned*)(F.lds + MISC_OFF);
    for (int u = F.tid; u < 64; u += NTHREADS) MISC[u] = 0u;
    __syncthreads();
    unsigned* ctl = (unsigned*)(F.ws + WS_CTL);
    XcdBarrier bar; bar.bar = ctl + CW_BAR; bar.x = 0; bar.st = nullptr;
    if (!MK_SPLIT) bar = xcd_barrier_post(ctl + CW_BAR, MISC + 8);
    const int lo = args.ph_lo, hi = args.ph_hi;
#define IN(k) (lo <= (k) && (k) < hi)
#define SEAM(k) do { if (IN(k) && IN((k) + 1)) xcd_barrier(bar); } while (0)
    if (IN(0)) { p0_prologue(F); } SEAM(0);
    if (IN(1)) { if (FAST_MASK & 2) p1_fast(F); else p1_naive(F); } SEAM(1);
    if (IN(2)) { if (FAST_MASK & 1) p2_ssmA_fast(F); else p2_ssmA_naive(F); if (FAST_MASK & 4) p2_attn_fast(F); else p2_attn_naive(F); } SEAM(2);
    if (IN(3)) { if (FAST_MASK & 8) p3_ssmB_fast(F); else p3_ssmB_naive(F); } SEAM(3);
    if (IN(4)) { if (FAST_MASK & 16) p4_fast(F); else p4_glu_naive(F); } SEAM(4);
    if (IN(5)) { if (FAST_MASK & 32) p5_fast(F); else p5_out_naive(F); } SEAM(5);
    if (IN(6)) { if (FAST_MASK & 64) p6_fast(F); else p6_up_naive(F); } SEAM(6);
    if (IN(7)) { if (FAST_MASK & 128) p7_fast(F); else p7_down_naive(F); }
#undef IN
#undef SEAM
}

extern "C" void kernel_launch(void* const* d_in, const int* in_sizes, int n_in, void* d_out, int out_size, void* d_ws, size_t ws_size, hipStream_t stream) {
    static int grid = 0;
    if (grid == 0) {
        if (n_in != 21 || in_sizes[0] != M * D || out_size != M * D || ws_size < WS_END) { fprintf(stderr, "kernel_launch: unexpected shapes (n_in %d, in0 %d, out %d, ws %zu)\n", n_in, n_in > 0 ? in_sizes[0] : -1, out_size, ws_size); grid = -1; return; }
        int dev = 0, cus = 0;
        if (hipGetDevice(&dev) != hipSuccess || hipDeviceGetAttribute(&cus, hipDeviceAttributeMultiprocessorCount, dev) != hipSuccess) { grid = -1; return; }
        if (hipFuncSetAttribute((const void*)mk_fwd, hipFuncAttributeMaxDynamicSharedMemorySize, LDS_BYTES) != hipSuccess) { fprintf(stderr, "kernel_launch: hipFuncSetAttribute failed\n"); grid = -1; return; }
        int per_cu = 0;
        if (hipOccupancyMaxActiveBlocksPerMultiprocessor(&per_cu, (const void*)mk_fwd, NTHREADS, LDS_BYTES) != hipSuccess || per_cu < 1) fprintf(stderr, "kernel_launch: occupancy query says %d\n", per_cu);
        (void)hipGetLastError();
        grid = cus;
    }
    if (grid < 0) return;
    (void)hipMemsetAsync((char*)d_ws + WS_CTL, 0, CTL_ZERO_BYTES, stream);
    Args a{};
    for (int i = 0; i < 21; ++i) a.in[i] = (const float*)d_in[i];
    a.out = (float*)d_out; a.ws = (unsigned char*)d_ws;
    if (MK_SPLIT) {
        for (int p = 0; p < N_PHASES; ++p) { a.ph_lo = p; a.ph_hi = p + 1; hipLaunchKernelGGL(mk_fwd, dim3(grid), dim3(NTHREADS), LDS_BYTES, stream, a); }
    } else {
        a.ph_lo = 0; a.ph_hi = N_PHASES; hipLaunchKernelGGL(mk_fwd, dim3(grid), dim3(NTHREADS), LDS_BYTES, stream, a);
    }
}
```

```cpp
#include <hip/hip_runtime.h>
#include <cstdio>
#include <cstdint>

#ifndef FAST_MASK
#define FAST_MASK 0xFF
#endif
#ifndef REP_MASK
#define REP_MASK 0
#endif
#ifndef REP_N
#define REP_N 3
#endif
#ifndef ATT_TILE_REP
#define ATT_TILE_REP 1
#endif
#ifndef ATT_EXP
#define ATT_EXP 0
#endif
#ifndef MK_SPLIT
#define MK_SPLIT 0
#endif

constexpr int M = 16384, D = 1024, AW = 512, HD = 64, NH = 8, SW = 512, SG = 16, NG = 32, SP = 64, FF = 4096, PW = 2048;
constexpr float EPS = 1e-6f;
constexpr float C2 = 0.125f * 1.4426950408889634f;
constexpr int TILE = 256, LCH = 16, NCH = TILE / LCH, NTILE = M / TILE;
constexpr int NWAVES = 8, NTHREADS = 512;

constexpr size_t MiB = 1u << 20;
constexpr size_t WS_CTL = 0, CTL_ZERO_BYTES = 1 * MiB;
constexpr size_t WS_TM = 1 * MiB;
constexpr size_t WS_WST = 2 * MiB;
constexpr size_t WS_WCR = 4 * MiB;
constexpr size_t WS_ALP = 6 * MiB;
constexpr size_t WS_ATP = 7 * MiB;
constexpr size_t WS_WIN = 8 * MiB, WS_WGLU = 12 * MiB, WS_WOUT = 13 * MiB, WS_WUP = 15 * MiB, WS_WDOWN = 23 * MiB;
constexpr size_t WS_SSQA = 31 * MiB, WS_SSQS = 31 * MiB + 512 * 1024, WS_SSQ2 = 32 * MiB;
constexpr size_t WS_STILE = 34 * MiB;
constexpr size_t WS_XLOC = 35 * MiB;
constexpr size_t WS_XN = 52 * MiB;
constexpr size_t WS_H = 84 * MiB;
constexpr size_t WS_Q = 84 * MiB, WS_K = 100 * MiB, WS_V = 116 * MiB, WS_U = 132 * MiB, WS_MIX = 148 * MiB  , WS_Z = 180 * MiB;
constexpr size_t WS_END = 212 * MiB;
constexpr int CW_BAR = 4096;

constexpr int LDS_BYTES = 147456;
constexpr int MISC_OFF = 131072 + 320, ROWTAB_OFF = 131072 + 1024;

#define GAS __attribute__((address_space(1)))
#define LAS __attribute__((address_space(3)))
typedef unsigned short bf16;
typedef unsigned v4u __attribute__((ext_vector_type(4)));
typedef float f32x4 __attribute__((ext_vector_type(4)));
typedef float f32x2 __attribute__((ext_vector_type(2)));

__device__ __forceinline__ unsigned f2bf(float f) { unsigned u = __builtin_bit_cast(unsigned, f); return (u + 0x7fffu + ((u >> 16) & 1u)) >> 16; }
__device__ __forceinline__ unsigned pk2(float lo, float hi) { return f2bf(lo) | (f2bf(hi) << 16); }
__device__ __forceinline__ float bf2f(bf16 h) { return __builtin_bit_cast(float, (unsigned)h << 16); }
__device__ __forceinline__ float bflo(unsigned w) { return __builtin_bit_cast(float, w << 16); }
__device__ __forceinline__ float bfhi(unsigned w) { return __builtin_bit_cast(float, w & 0xffff0000u); }
__device__ __forceinline__ float wave_sum(float v) {
#pragma unroll
    for (int o = 1; o < 64; o <<= 1) v += __shfl_xor(v, o);
    return v;
}
__device__ __forceinline__ float dot8(v4u a, v4u b) {
    return bflo(a.x) * bflo(b.x) + bfhi(a.x) * bfhi(b.x) + bflo(a.y) * bflo(b.y) + bfhi(a.y) * bfhi(b.y)
         + bflo(a.z) * bflo(b.z) + bfhi(a.z) * bfhi(b.z) + bflo(a.w) * bflo(b.w) + bfhi(a.w) * bfhi(b.w);
}
__device__ __forceinline__ float dot_bf16(const bf16* a, const bf16* b, int K) {
    float acc = 0.f;
    for (int k = 0; k < K; k += 8) acc += dot8(*(const v4u*)(a + k), *(const v4u*)(b + k));
    return acc;
}

#define XB_TMO      128
#define XB_XCNT(j)  (256  + 64 * (j))
#define XB_XSUB(j)  (1280 + 64 * (j))
#define XB_XGEN(j)  (2304 + 64 * (j))
#define XB_TOP      3328
#define XB_TOPGEN   3392
#define XCD_BAR_WORDS 3456
#define XB_SPIN_CAP (1u << 18)
__device__ __forceinline__ unsigned xb_ld(unsigned* p)              { return __hip_atomic_load(p, __ATOMIC_RELAXED, __HIP_MEMORY_SCOPE_AGENT); }
__device__ __forceinline__ unsigned xb_add(unsigned* p, unsigned v) { return __hip_atomic_fetch_add(p, v, __ATOMIC_RELAXED, __HIP_MEMORY_SCOPE_AGENT); }
__device__ __forceinline__ unsigned xb_xcc_id() { return (unsigned)__builtin_amdgcn_s_getreg((3 << 11) | 20) & 0xFu; }
#define XB_SPIN(cond, bar) do { unsigned _sp = 0; while (cond) { __builtin_amdgcn_s_sleep(1); \
    if ((++_sp & 255u) == 0u) { if (xb_ld(&(bar)[XB_TMO])) break; if (_sp > XB_SPIN_CAP) { atomicAdd(&(bar)[XB_TMO], 1u); break; } } } } while (0)
struct XcdBarrier { unsigned* bar; unsigned x; volatile LAS unsigned* st; };
__device__ __forceinline__ XcdBarrier xcd_barrier_post(unsigned* bar, volatile LAS unsigned* st) {
    XcdBarrier b; b.bar = bar; b.x = xb_xcc_id(); b.st = st;
    if (threadIdx.x == 0) (void)xb_add(&bar[XB_XCNT(b.x)], 1u);
    return b;
}
__device__ __forceinline__ void xcd_barrier_complete(unsigned* bar, unsigned x, unsigned& nloc, unsigned& nx) {
    const unsigned G = gridDim.x * gridDim.y * gridDim.z;
    unsigned sum, cnt, mine, sp = 0u;
    for (;;) {
        sum = 0u; cnt = 0u; mine = 0u;
#pragma unroll
        for (unsigned j = 0; j < 16; ++j) { const unsigned c = xb_ld(&bar[XB_XCNT(j)]); sum += c; cnt += (c > 0u) ? 1u : 0u; mine = (j == x) ? c : mine; }
        if (sum == G) break;
        __builtin_amdgcn_s_sleep(1);
        if ((++sp & 255u) == 0u) { if (xb_ld(&bar[XB_TMO])) break; if (sp > XB_SPIN_CAP) { atomicAdd(&bar[XB_TMO], 1u); break; } }
    }
    nloc = mine > 0u ? mine : 1u; nx = cnt > 0u ? cnt : 1u;
}
__device__ __forceinline__ void xcd_barrier(const XcdBarrier& b) {
    asm volatile("s_waitcnt vmcnt(0)" ::: "memory");
    __syncthreads();
    if (threadIdx.x == 0) {
        unsigned* bar = b.bar;
        __builtin_amdgcn_s_waitcnt(0);
        unsigned nloc = b.st[0], nx = b.st[1];
        if (nloc == 0u) { xcd_barrier_complete(bar, b.x, nloc, nx); b.st[0] = nloc; b.st[1] = nx; }
        const unsigned old = xb_add(&bar[XB_XSUB(b.x)], 1u);
        const unsigned gen = old / nloc;
        if (old + 1u == (gen + 1u) * nloc) {
            __builtin_amdgcn_fence(__ATOMIC_RELEASE, "agent");
            asm volatile("s_waitcnt vmcnt(0)" ::: "memory");
            const unsigned og = xb_add(&bar[XB_TOP], 1u);
            const unsigned tg = og / nx;
            if (og + 1u == (tg + 1u) * nx) xb_add(&bar[XB_TOPGEN], 1u);
            else XB_SPIN(xb_ld(&bar[XB_TOPGEN]) == tg, bar);
            __builtin_amdgcn_fence(__ATOMIC_ACQUIRE, "agent");
            xb_add(&bar[XB_XGEN(b.x)], 1u);
            asm volatile("s_waitcnt vmcnt(0)" ::: "memory");
        } else {
            XB_SPIN(xb_ld(&bar[XB_XGEN(b.x)]) == gen, bar);
            __builtin_amdgcn_fence(__ATOMIC_ACQUIRE, "agent");
            asm volatile("s_waitcnt vmcnt(0)" ::: "memory");
        }
    }
    __syncthreads();
}


namespace pg8 {
#define PG8_LAS __attribute__((address_space(3)))
typedef unsigned short bf16_t;
typedef short bf16x8 __attribute__((ext_vector_type(8)));
typedef float f32x4 __attribute__((ext_vector_type(4)));
typedef unsigned u32x4 __attribute__((ext_vector_type(4)));
typedef unsigned u32x2 __attribute__((ext_vector_type(2)));
constexpr int BM = 256, BK = 64, HALF = 128, HTB = HALF * BK * 2, STAGE_BYTES = 8 * HTB, NXCD = 8, WGM = 8;
__host__ __device__ __forceinline__ int lds_byte(int r, int c) { const int st = (r >> 4) * 2 + (c >> 5), rr = r & 15, cc = c & 31, ob = rr * 64 + cc * 2; return st * 1024 + (ob ^ (((ob >> 9) & 1) << 5)); }
__host__ __device__ __forceinline__ void stage_rc(int b, int& R, int& C) { const int st = b / 1024, sb = b % 1024, swz = sb ^ (((sb >> 9) & 1) << 5); R = (st >> 1) * 16 + swz / 64; C = (st & 1) * 32 + (swz % 64) / 2; }
__host__ __device__ __forceinline__ int perm32(int rho) { const int n = rho >> 4, i = rho & 15; return 8 * (i >> 2) + 4 * n + (i & 3); }
struct Unit { int pm, pn; };
struct Gemm { const bf16_t* A; const bf16_t* Bt; int M, N, K; };
struct StaticOrder {
    int nM, nN, nwg, G, c;
    __host__ __device__ void init(int M, int N, int G_, int c_) { nM = M / BM; nN = N / BM; nwg = nM * nN; G = G_; c = c_; }
    __host__ __device__ bool next(int i, Unit& u) const {
        const long L = (long)i * G + c; if (L >= nwg) return false;
        int wgid = (int)L; { const int q = nwg / NXCD, r = nwg % NXCD, xcd = wgid % NXCD, off = wgid / NXCD; wgid = (xcd < r ? xcd * (q + 1) : r * (q + 1) + (xcd - r) * q) + off; }
        const int nig = WGM * nN, gid = wgid / nig, fm = gid * WGM, gsz = (nM - fm) < WGM ? (nM - fm) : WGM;
        u.pm = fm + ((wgid % nig) % gsz); u.pn = (wgid % nig) / gsz; return true;
    }
    __device__ __forceinline__ void a_ready(const Unit&) const {}
    __device__ __forceinline__ void done(const Unit&) const {}
};
__device__ __forceinline__ unsigned cvt_pk_bf16(float lo, float hi) { unsigned r; asm volatile("v_cvt_pk_bf16_f32 %0, %1, %2" : "=v"(r) : "v"(lo), "v"(hi)); return r; }

template <int MODE> struct BMap {
    static constexpr int BHALF_ROWS = (MODE == 2) ? 32 : 128;
    __host__ __device__ static __forceinline__ int brow(int R) { return MODE == 0 ? R : MODE == 1 ? ((R & ~31) + perm32(R & 31)) : (64 * (R >> 5) + perm32(R & 31)); }
};

template <class Epi, class Sched, bool ALIGN_EPI = true>
__device__ __forceinline__ void gemm_phase(PG8_LAS unsigned char* lds, const Gemm g, const Sched& S, const Epi& E) {
    const int tid = threadIdx.x, wid = __builtin_amdgcn_readfirstlane(tid >> 6), lane = tid & 63, wr = wid >> 2, wc = wid & 3, fr = lane & 15, fq = lane >> 4;
    const int K = g.K, nt = K / BK;
    unsigned voffA[2], voffB[2];
#pragma unroll
    for (int i = 0; i < 2; ++i) { int R, C; stage_rc(tid * 16 + i * 8192, R, C); const int Rb = BMap<Epi::MODE>::brow(R);
        voffA[i] = (unsigned)(R * K + C) * 2u; voffB[i] = (unsigned)(Rb * K + C) * 2u; }
    const size_t kstep = (size_t)(BK * 2);
    const size_t hstepA = (size_t)HALF * K * 2, hstepB = (size_t)BMap<Epi::MODE>::BHALF_ROWS * K * 2;
    const size_t tstep = (size_t)BM * K * 2;
    const unsigned ldsw = (unsigned)wid * 1024u;
    const int aoff = lds_byte(wr * 64 + fr, fq * 8), boff = lds_byte(wc * 32 + fr, fq * 8);
#define PG8_SA(b, h) (((b) * 2 + (h)) * HTB)
#define PG8_SB(b, h) ((4 + (b) * 2 + (h)) * HTB)
#define PG8_STAGE(bufoff, gbase, voff) do { _Pragma("unroll") for (int _i = 0; _i < 2; ++_i) \
        __builtin_amdgcn_global_load_lds((const unsigned*)((const char*)(gbase) + (voff)[_i]), (PG8_LAS unsigned*)(lds + (bufoff) + ldsw + _i * 8192), 16, 0, 0); } while (0)
#define PG8_LDA(dst, b, h) do { _Pragma("unroll") for (int m = 0; m < 4; ++m) _Pragma("unroll") for (int k = 0; k < 2; ++k) dst[m][k] = *(const PG8_LAS bf16x8*)(lds + PG8_SA(b, h) + aoff + m * 2048 + k * 1024); } while (0)
#define PG8_LDB(dst, b, h) do { _Pragma("unroll") for (int n = 0; n < 2; ++n) _Pragma("unroll") for (int k = 0; k < 2; ++k) dst[n][k] = *(const PG8_LAS bf16x8*)(lds + PG8_SB(b, h) + boff + n * 2048 + k * 1024); } while (0)
#define PG8_MMA(ai, bj, At, Bt) do { __builtin_amdgcn_s_setprio(1); _Pragma("unroll") for (int m = 0; m < 4; ++m) _Pragma("unroll") for (int n = 0; n < 2; ++n) _Pragma("unroll") for (int k = 0; k < 2; ++k) \
        acc[ai][bj][m][n] = __builtin_amdgcn_mfma_f32_16x16x32_bf16(Bt[n][k], At[m][k], acc[ai][bj][m][n], 0, 0, 0); __builtin_amdgcn_s_setprio(0); } while (0)
#define PG8_WAIT_V(n) asm volatile("s_waitcnt vmcnt(" #n ")" ::: "memory")
#define PG8_WAIT_L(n) asm volatile("s_waitcnt lgkmcnt(" #n ")" ::: "memory")
#define PG8_BAR __builtin_amdgcn_s_barrier()
#define PG8_SCHED __builtin_amdgcn_sched_barrier(0)
    Unit cur, nxt; int ui = 0;
    if (!S.next(0, cur)) return;
    f32x4 acc[2][2][4][2];
#pragma unroll
    for (int a = 0; a < 2; ++a)
#pragma unroll
        for (int b = 0; b < 2; ++b)
#pragma unroll
            for (int m = 0; m < 4; ++m)
#pragma unroll
                for (int n = 0; n < 2; ++n) acc[a][b][m][n] = (f32x4){0.f, 0.f, 0.f, 0.f};
    bf16x8 At[4][2], B0[2][2], B1[2][2];
    const char* cA = (const char*)g.A + (size_t)cur.pm * tstep; const char* cB = (const char*)g.Bt + (size_t)cur.pn * tstep;
    S.a_ready(cur);
    PG8_STAGE(PG8_SB(0, 0), cB, voffB); PG8_STAGE(PG8_SB(0, 1), cB + hstepB, voffB); PG8_STAGE(PG8_SA(0, 0), cA, voffA); PG8_STAGE(PG8_SA(0, 1), cA + hstepA, voffA);
    if (wr == 1) PG8_BAR;
    PG8_WAIT_V(2); PG8_BAR;
    PG8_STAGE(PG8_SB(1, 0), cB + kstep, voffB); PG8_STAGE(PG8_SA(1, 0), cA + kstep, voffA); PG8_STAGE(PG8_SB(1, 1), cB + hstepB + kstep, voffB);
    PG8_WAIT_V(6); PG8_BAR;
    for (;;) {
        const bool has_next = S.next(ui + 1, nxt);
        const char* nA = has_next ? (const char*)g.A + (size_t)nxt.pm * tstep : cA; const char* nB = has_next ? (const char*)g.Bt + (size_t)nxt.pn * tstep : cB;
        for (int t = 0; t < nt; t += 2) {
            const bool last = (t == nt - 2);
            const char* a1 = cA + (size_t)(t + 1) * kstep;
            const char* a2 = last ? nA : cA + (size_t)(t + 2) * kstep; const char* b2 = last ? nB : cB + (size_t)(t + 2) * kstep;
            const char* a3 = a2 + kstep; const char* b3 = b2 + kstep;
            if (last && has_next) S.a_ready(nxt);
            if constexpr (Epi::MIDK > 0) { if (t == Epi::MIDK) E.midk(acc, wr, fr, lds); }
            PG8_LDB(B0, 0, 0); PG8_LDB(B1, 0, 1); PG8_SCHED; PG8_LDA(At, 0, 0); PG8_STAGE(PG8_SA(1, 1), a1 + hstepA, voffA);
            PG8_WAIT_V(8); PG8_WAIT_L(0); PG8_BAR; PG8_MMA(0, 0, At, B0); PG8_MMA(0, 1, At, B1); PG8_BAR; PG8_SCHED;
            PG8_LDA(At, 0, 1); PG8_STAGE(PG8_SB(0, 0), b2, voffB); PG8_STAGE(PG8_SB(0, 1), b2 + hstepB, voffB); PG8_STAGE(PG8_SA(0, 0), a2, voffA);
            PG8_WAIT_V(8); PG8_WAIT_L(0); PG8_BAR; PG8_MMA(1, 0, At, B0); PG8_MMA(1, 1, At, B1); PG8_BAR; PG8_SCHED;
            PG8_LDB(B0, 1, 0); PG8_LDB(B1, 1, 1); PG8_SCHED; PG8_LDA(At, 1, 0); PG8_STAGE(PG8_SA(0, 1), a2 + hstepA, voffA);
            PG8_WAIT_V(8); PG8_WAIT_L(0); PG8_BAR; PG8_MMA(0, 0, At, B0); PG8_MMA(0, 1, At, B1); PG8_BAR; PG8_SCHED;
            PG8_LDA(At, 1, 1); PG8_STAGE(PG8_SB(1, 0), b3, voffB); PG8_STAGE(PG8_SB(1, 1), b3 + hstepB, voffB); PG8_STAGE(PG8_SA(1, 0), a3, voffA);
            PG8_WAIT_V(8); PG8_WAIT_L(0); PG8_BAR; PG8_MMA(1, 0, At, B0); PG8_MMA(1, 1, At, B1); PG8_BAR; PG8_SCHED;
        }
        if constexpr (ALIGN_EPI) { if (wr == 0) PG8_BAR; }
        E(acc, cur, wr, wc, fr, fq, lds); S.done(cur);
        if (!has_next) break;
#pragma unroll
        for (int a = 0; a < 2; ++a)
#pragma unroll
            for (int b = 0; b < 2; ++b)
#pragma unroll
                for (int m = 0; m < 4; ++m)
#pragma unroll
                    for (int n = 0; n < 2; ++n) acc[a][b][m][n] = (f32x4){0.f, 0.f, 0.f, 0.f};
        cur = nxt; cA = nA; cB = nB; ++ui;
        if constexpr (ALIGN_EPI) { if (wr == 1) PG8_BAR; }
    }
    PG8_WAIT_V(0);
    if constexpr (!ALIGN_EPI) { if (wr == 0) PG8_BAR; }
    PG8_BAR;
#undef PG8_SA
#undef PG8_SB
#undef PG8_STAGE
#undef PG8_LDA
#undef PG8_LDB
#undef PG8_MMA
#undef PG8_WAIT_V
#undef PG8_WAIT_L
#undef PG8_BAR
#undef PG8_SCHED
}

struct EpiInProj {
    static constexpr int MODE = 2, MIDK = 0;
    bf16_t *Qb, *Kb, *Vb, *Ub; const float *gq, *gk;
    __device__ __forceinline__ void operator()(const f32x4 (&acc)[2][2][4][2], const Unit& u, int wr, int wc, int fr, int fq, PG8_LAS unsigned char*) const {
        const int seg = u.pn >> 1; bf16_t* base = seg == 0 ? Qb : seg == 1 ? Kb : seg == 2 ? Vb : Ub;
        const int col0 = (u.pn & 1) * 256 + wc * 64 + 8 * fq, row0 = u.pm * BM + wr * 64 + fr;
        f32x4 gv[2][2];
#pragma unroll
        for (int bj = 0; bj < 2; ++bj)
#pragma unroll
            for (int n = 0; n < 2; ++n) { gv[bj][n] = (f32x4){1.f, 1.f, 1.f, 1.f};
                if (seg == 0) gv[bj][n] = *(const f32x4*)(gq + 32 * bj + 8 * fq + 4 * n) * C2; else if (seg == 1) gv[bj][n] = *(const f32x4*)(gk + 32 * bj + 8 * fq + 4 * n); }
#pragma unroll
        for (int ai = 0; ai < 2; ++ai)
#pragma unroll
            for (int m = 0; m < 4; ++m) {
                float r = 1.f;
                if (seg < 2) { float ss = 0.f;
#pragma unroll
                    for (int bj = 0; bj < 2; ++bj)
#pragma unroll
                        for (int n = 0; n < 2; ++n) { const f32x4 x = acc[ai][bj][m][n]; ss += (x[0] * x[0] + x[1] * x[1]) + (x[2] * x[2] + x[3] * x[3]); }
                    ss += __shfl_xor(ss, 16); ss += __shfl_xor(ss, 32); r = 1.f / sqrtf(ss * (1.f / 64.f) + EPS); }
                bf16_t* rowp = base + (size_t)(row0 + ai * HALF + m * 16) * AW + col0;
#pragma unroll
                for (int bj = 0; bj < 2; ++bj) { const f32x4 v0 = acc[ai][bj][m][0] * (gv[bj][0] * r), v1 = acc[ai][bj][m][1] * (gv[bj][1] * r);
                    u32x4 w; w.x = cvt_pk_bf16(v0[0], v0[1]); w.y = cvt_pk_bf16(v0[2], v0[3]); w.z = cvt_pk_bf16(v1[0], v1[1]); w.w = cvt_pk_bf16(v1[2], v1[3]);
                    *(u32x4*)(rowp + bj * 32) = w; } }
    }
};
struct EpiGlu {
    static constexpr int MODE = 1, MIDK = 0;
    const bf16_t* Z; bf16_t* O; const float* bias; float* ssq;
    __device__ __forceinline__ void operator()(const f32x4 (&acc)[2][2][4][2], const Unit& u, int wr, int wc, int fr, int fq, PG8_LAS unsigned char*) const {
        const int col0 = u.pn * BM + wc * 32 + 8 * fq, row0 = u.pm * BM + wr * 64 + fr;
        f32x4 bv[2][2];
#pragma unroll
        for (int bj = 0; bj < 2; ++bj)
#pragma unroll
            for (int n = 0; n < 2; ++n) bv[bj][n] = *(const f32x4*)(bias + col0 + bj * HALF + 4 * n);
#pragma unroll
        for (int ai = 0; ai < 2; ++ai)
#pragma unroll
            for (int m = 0; m < 4; ++m) { const int row = row0 + ai * HALF + m * 16; float ss = 0.f;
#pragma unroll
                for (int bj = 0; bj < 2; ++bj) { const u32x4 zr = *(const u32x4*)(Z + (size_t)row * SW + col0 + bj * HALF);
                    const float zf[8] = {bflo(zr.x), bfhi(zr.x), bflo(zr.y), bfhi(zr.y), bflo(zr.z), bfhi(zr.z), bflo(zr.w), bfhi(zr.w)};
                    float o[8];
#pragma unroll
                    for (int e = 0; e < 8; ++e) { const float a = acc[ai][bj][m][e >> 2][e & 3] + bv[bj][e >> 2][e & 3];
                        o[e] = zf[e] * __builtin_amdgcn_rcpf(1.f + __builtin_amdgcn_exp2f(-1.4426950408889634f * a)); ss += o[e] * o[e]; }
                    u32x4 w; w.x = cvt_pk_bf16(o[0], o[1]); w.y = cvt_pk_bf16(o[2], o[3]); w.z = cvt_pk_bf16(o[4], o[5]); w.w = cvt_pk_bf16(o[6], o[7]);
                    *(u32x4*)(O + (size_t)row * D + col0 + bj * HALF) = w; }
                ss += __shfl_xor(ss, 16); ss += __shfl_xor(ss, 32);
                if (fq == 0) ssq[row * 8 + u.pn * 4 + wc] = ss; }
    }
};
struct EpiOut {
    static constexpr int MODE = 0, MIDK = 8;
    const float* x; float* out; bf16_t* x1b; float* ssq2;
    __device__ __forceinline__ void midk(f32x4 (&acc)[2][2][4][2], int wr, int fr, PG8_LAS unsigned char* lds) const {
        const PG8_LAS f32x2* tab = (const PG8_LAS f32x2*)(lds + ROWTAB_OFF);
#pragma unroll
        for (int ai = 0; ai < 2; ++ai)
#pragma unroll
            for (int m = 0; m < 4; ++m) { const float s = tab[ai * HALF + wr * 64 + m * 16 + fr].x;
#pragma unroll
                for (int bj = 0; bj < 2; ++bj)
#pragma unroll
                    for (int n = 0; n < 2; ++n) acc[ai][bj][m][n] *= s; }
    }
    __device__ __forceinline__ void operator()(const f32x4 (&acc)[2][2][4][2], const Unit& u, int wr, int wc, int fr, int fq, PG8_LAS unsigned char* lds) const {
        const PG8_LAS f32x2* tab = (const PG8_LAS f32x2*)(lds + ROWTAB_OFF);
        const int col0 = u.pn * BM + wc * 32 + 4 * fq;
#pragma unroll
        for (int ai = 0; ai < 2; ++ai)
#pragma unroll
            for (int m = 0; m < 4; ++m) { const int rl = ai * HALF + wr * 64 + m * 16 + fr; const float rs = tab[rl].y; const size_t off = (size_t)(u.pm * BM + rl) * D + col0; float ss = 0.f;
#pragma unroll
                for (int bj = 0; bj < 2; ++bj)
#pragma unroll
                    for (int n = 0; n < 2; ++n) { const f32x4 xv = *(const f32x4*)(x + off + bj * HALF + n * 16); const f32x4 o = xv + acc[ai][bj][m][n] * rs;
                        *(f32x4*)(out + off + bj * HALF + n * 16) = o; ss += (o[0] * o[0] + o[1] * o[1]) + (o[2] * o[2] + o[3] * o[3]);
                        u32x2 w; w.x = cvt_pk_bf16(o[0], o[1]); w.y = cvt_pk_bf16(o[2], o[3]); *(u32x2*)(x1b + off + bj * HALF + n * 16) = w; }
                ss += __shfl_xor(ss, 16); ss += __shfl_xor(ss, 32);
                if (fq == 0) ssq2[(u.pm * BM + rl) * 16 + u.pn * 4 + wc] = ss; }
    }
};
struct EpiUp {
    static constexpr int MODE = 1, MIDK = 0;
    bf16_t* H;
    __device__ __forceinline__ void operator()(const f32x4 (&acc)[2][2][4][2], const Unit& u, int wr, int wc, int fr, int fq, PG8_LAS unsigned char* lds) const {
        const PG8_LAS f32x2* tab = (const PG8_LAS f32x2*)(lds + ROWTAB_OFF);
        const int col0 = u.pn * BM + wc * 32 + 8 * fq;
#pragma unroll
        for (int ai = 0; ai < 2; ++ai)
#pragma unroll
            for (int m = 0; m < 4; ++m) { const int rl = ai * HALF + wr * 64 + m * 16 + fr; const float r2 = tab[rl].x; bf16_t* rowp = H + (size_t)(u.pm * BM + rl) * FF + col0;
#pragma unroll
                for (int bj = 0; bj < 2; ++bj) { f32x4 v0 = acc[ai][bj][m][0] * r2, v1 = acc[ai][bj][m][1] * r2;
#pragma unroll
                    for (int e = 0; e < 4; ++e) { const float a = fmaxf(v0[e], 0.f), b = fmaxf(v1[e], 0.f); v0[e] = a * a; v1[e] = b * b; }
                    u32x4 w; w.x = cvt_pk_bf16(v0[0], v0[1]); w.y = cvt_pk_bf16(v0[2], v0[3]); w.z = cvt_pk_bf16(v1[0], v1[1]); w.w = cvt_pk_bf16(v1[2], v1[3]);
                    *(u32x4*)(rowp + bj * HALF) = w; } }
    }
};
struct EpiDown {
    static constexpr int MODE = 0, MIDK = 0;
    float* out;
    __device__ __forceinline__ void operator()(const f32x4 (&acc)[2][2][4][2], const Unit& u, int wr, int wc, int fr, int fq, PG8_LAS unsigned char*) const {
        const int col0 = u.pn * BM + wc * 32 + 4 * fq;
#pragma unroll
        for (int ai = 0; ai < 2; ++ai)
#pragma unroll
            for (int m = 0; m < 4; ++m) { const size_t off = (size_t)(u.pm * BM + ai * HALF + wr * 64 + m * 16 + fr) * D + col0;
#pragma unroll
                for (int bj = 0; bj < 2; ++bj)
#pragma unroll
                    for (int n = 0; n < 2; ++n) { float* p = out + off + bj * HALF + n * 16; *(f32x4*)p = *(const f32x4*)p + acc[ai][bj][m][n]; } }
    }
};
}


namespace att {
typedef short bf16x8 __attribute__((ext_vector_type(8)));
typedef short s16x4 __attribute__((ext_vector_type(4)));
typedef float f32x16 __attribute__((ext_vector_type(16)));
typedef __attribute__((address_space(3))) unsigned char* ldsp;
typedef short v4i16_t __attribute__((ext_vector_type(4)));
constexpr int LBUF_OFF = 131072 + 3072;
__device__ __forceinline__ int crow(int r, int hi) { return (r & 3) + 8 * (r >> 2) + 4 * hi; }
__device__ __forceinline__ unsigned cvtpk(float lo, float hi) { unsigned r; asm volatile("v_cvt_pk_bf16_f32 %0, %1, %2" : "=v"(r) : "v"(lo), "v"(hi)); return r; }
__device__ __forceinline__ s16x4 vtr(ldsp p) { return __builtin_bit_cast(s16x4, __builtin_amdgcn_ds_read_tr16_b64_v4i16((__attribute__((address_space(3))) v4i16_t*)p)); }

struct TileRegs { v4u k[4], v[4]; };
__device__ __forceinline__ void load_tile_regs(const bf16* Kg, const bf16* Vg, int tok0, int d, int lane, TileRegs& t) {
#pragma unroll
    for (int i = 0; i < 4; ++i) { int tk = tok0 + d * (8 * i + (lane >> 3)); tk = tk < 0 ? 0 : tk; const size_t off = (size_t)tk * AW + (lane & 7) * 8;
        t.k[i] = *(const v4u*)(Kg + off); t.v[i] = *(const v4u*)(Vg + off); }
}
__device__ __forceinline__ void store_tile_lds(ldsp buf, int lane, const TileRegs& t) {
    const int ch = lane & 7;
#pragma unroll
    for (int i = 0; i < 4; ++i) { const int key = 8 * i + (lane >> 3);
        *(__attribute__((address_space(3))) v4u*)(buf + key * 128 + ((ch ^ ((key >> 1) & 7)) << 4)) = t.k[i];
        *(__attribute__((address_space(3))) v4u*)(buf + 4096 + ((ch >> 2) * 2 + (key >> 4)) * 1024 + (key & 15) * 64 + (ch & 3) * 16) = t.v[i]; }
}

template <int NBLK>
__device__ __forceinline__ void window(const bf16* Qg, const bf16* Kg, const bf16* Vg, int tb, int d, ldsp wbuf, f32x16 (&o)[NBLK][2], float (&l)[NBLK], float nshift, int lane_in) {
    const int lane = lane_in, r32 = lane & 31, hi = lane >> 5;
    constexpr int NT = NBLK + 4;
    TileRegs tr; load_tile_regs(Kg, Vg, tb - 128 * d, d, lane, tr);
    bf16x8 q[NBLK][4];
#pragma unroll
    for (int b = 0; b < NBLK; ++b)
#pragma unroll
        for (int d0 = 0; d0 < 4; ++d0) q[b][d0] = *(const bf16x8*)(Qg + (size_t)(tb + d * (32 * b + r32)) * AW + d0 * 16 + hi * 8);
#pragma unroll
    for (int b = 0; b < NBLK; ++b)
#pragma unroll
        for (int d0 = 0; d0 < 4; ++d0) asm volatile("" : "+v"(q[b][d0]));
    f32x16 zero16;
#pragma unroll
    for (int r = 0; r < 16; ++r) zero16[r] = 0.f;
    store_tile_lds(wbuf, lane, tr);
#pragma unroll 1
    for (int TT = 0; TT < NT * ATT_TILE_REP; ++TT) {
        const int T = TT / ATT_TILE_REP; const float pscale = (TT % ATT_TILE_REP) ? 0.f : 1.f; const int tok0 = tb - 128 * d + 32 * d * T;
        int ln = lane_in; asm volatile("" : "+v"(ln));
        const int lane = ln, r32 = lane & 31, hi = lane >> 5, lbase = r32 - 4 * hi;
        const ldsp cb = wbuf + (TT & 1) * 8192;
        if (TT + 1 < NT * ATT_TILE_REP) load_tile_regs(Kg, Vg, tb - 128 * d + 32 * d * ((TT + 1) / ATT_TILE_REP), d, lane, tr);
        bf16x8 kf[4];
#pragma unroll
        for (int d0 = 0; d0 < 4; ++d0) kf[d0] = *(const __attribute__((address_space(3))) bf16x8*)(cb + r32 * 128 + (((2 * d0 + hi) ^ ((r32 >> 1) & 7)) << 4));
        bf16x8 vf[2][2];
        { const ldsp vp = cb + 4096 + ((lane >> 4) & 1) * 32 + (lane & 3) * 8 + (4 * hi + ((lane & 15) >> 2)) * 64;
#pragma unroll
          for (int s = 0; s < 2; ++s)
#pragma unroll
            for (int dh = 0; dh < 2; ++dh) { const s16x4 lo = vtr(vp + dh * 2048 + s * 1024), hh = vtr(vp + dh * 2048 + s * 1024 + 512);
                vf[s][dh] = (bf16x8){lo[0], lo[1], lo[2], lo[3], hh[0], hh[1], hh[2], hh[3]}; } }
        const int kmin = tok0 < 0 ? (-tok0 + d - 1) / d : 0;
#pragma unroll
        for (int b = 0; b < NBLK; ++b) {
            const int tb_ = T - b;
            if (tb_ < 0 || tb_ > 4) continue;
            f32x16 S = __builtin_amdgcn_mfma_f32_32x32x16_bf16(kf[0], q[b][0], zero16, 0, 0, 0);
            S = __builtin_amdgcn_mfma_f32_32x32x16_bf16(kf[1], q[b][1], S, 0, 0, 0);
            S = __builtin_amdgcn_mfma_f32_32x32x16_bf16(kf[2], q[b][2], S, 0, 0, 0);
            S = __builtin_amdgcn_mfma_f32_32x32x16_bf16(kf[3], q[b][3], S, 0, 0, 0);
            const int dl = 128 - 32 * tb_;
            float p[16]; float ls = 0.f;
            if (kmin == 0) {
                if (tb_ >= 1 && tb_ <= 3) {
#pragma unroll
                    for (int r = 0; r < 16; ++r) { p[r] = __builtin_amdgcn_exp2f(S[r] + nshift); ls += p[r]; }
                } else if (tb_ == 0) {
#pragma unroll
                    for (int r = 0; r < 16; ++r) { const int cr = (r & 3) + 8 * (r >> 2); p[r] = (cr >= lbase) ? __builtin_amdgcn_exp2f(S[r] + nshift) : 0.f; ls += p[r]; }
                } else {
#pragma unroll
                    for (int r = 0; r < 16; ++r) { const int cr = (r & 3) + 8 * (r >> 2); p[r] = (cr <= lbase) ? __builtin_amdgcn_exp2f(S[r] + nshift) : 0.f; ls += p[r]; }
                }
            } else {
                const int x = lbase + dl;
#pragma unroll
                for (int r = 0; r < 16; ++r) { const int cr = (r & 3) + 8 * (r >> 2); const bool ok = ((unsigned)(x - cr) <= 128u) && (cr + 4 * hi >= kmin);
                    p[r] = ok ? __builtin_amdgcn_exp2f(S[r] + nshift) : 0.f; ls += p[r]; }
            }
            if (ATT_TILE_REP > 1) {
#pragma unroll
                for (int r = 0; r < 16; ++r) p[r] *= pscale;
                ls *= pscale; }
            l[b] += ls;
            bf16x8 pa[2];
#pragma unroll
            for (int s = 0; s < 2; ++s) { typedef unsigned u4 __attribute__((ext_vector_type(4)));
                u4 w; w.x = cvtpk(p[8 * s + 0], p[8 * s + 1]); w.y = cvtpk(p[8 * s + 2], p[8 * s + 3]); w.z = cvtpk(p[8 * s + 4], p[8 * s + 5]); w.w = cvtpk(p[8 * s + 6], p[8 * s + 7]);
                pa[s] = __builtin_bit_cast(bf16x8, w); }
#pragma unroll
            for (int dh = 0; dh < 2; ++dh) { o[b][dh] = __builtin_amdgcn_mfma_f32_32x32x16_bf16(pa[0], vf[0][dh], o[b][dh], 0, 0, 0);
                                             o[b][dh] = __builtin_amdgcn_mfma_f32_32x32x16_bf16(pa[1], vf[1][dh], o[b][dh], 0, 0, 0); }
        }
        if (TT + 1 < NT * ATT_TILE_REP) store_tile_lds(wbuf + ((TT + 1) & 1) * 8192, lane, tr);
    }
}

template <int MODE>
__device__ __forceinline__ void exchange1(const f32x16 (&o)[1][2], float l, int tl0, int d, int j, f32x16 (&oc)[2][2], float (&lc)[2], ldsp lds, int w, int lane) {
    const int r32 = lane & 31, hi = lane >> 5;
    __attribute__((address_space(3))) float* buf = (__attribute__((address_space(3))) float*)lds;
    __attribute__((address_space(3))) float* lbuf = (__attribute__((address_space(3))) float*)(lds + LBUF_OFF);
    __syncthreads();
#pragma unroll
    for (int dh = 0; dh < 2; ++dh)
#pragma unroll
        for (int r = 0; r < 16; ++r) buf[(tl0 + d * crow(r, hi)) * 64 + dh * 32 + r32] = o[0][dh][r];
    { const float lt = l + __shfl_xor(l, 32); if (hi == 0) lbuf[tl0 + d * r32] = lt; }
    __syncthreads();
    if (MODE == 16 || ((w >> 1) & 1) == j) {
#pragma unroll
        for (int b = 0; b < 2; ++b) {
#pragma unroll
            for (int dh = 0; dh < 2; ++dh)
#pragma unroll
                for (int r = 0; r < 16; ++r) { if (MODE == 16 && (r & 1) != j) continue; oc[b][dh][r] += buf[(64 * w + 32 * b + crow(r, hi)) * 64 + dh * 32 + r32]; }
            const float lv = lbuf[64 * w + 32 * b + r32];
            lc[b] += (MODE == 16 && (r32 & 1) != j) ? 0.f : lv; }
    }
    __syncthreads();
}

__device__ __forceinline__ void unit(const bf16* Q, const bf16* K, const bf16* V, bf16* MIXo, float* SSQA, int h, int i0, float nshift, ldsp lds, int tid_in) {
    int tid = tid_in; asm volatile("" : "+v"(tid));
    const int lane = tid & 63, w = __builtin_amdgcn_readfirstlane(tid >> 6), r32 = lane & 31, hi = lane >> 5;
    const bf16* Qg = Q + h * 64; const bf16* Kg = K + h * 64; const bf16* Vg = V + h * 64;
    const ldsp wbuf = lds + w * 16384;
    f32x16 oc[2][2]; float lc[2] = {0.f, 0.f};
#pragma unroll
    for (int b = 0; b < 2; ++b)
#pragma unroll
        for (int dh = 0; dh < 2; ++dh)
#pragma unroll
            for (int r = 0; r < 16; ++r) oc[b][dh][r] = 0.f;
    window<2>(Qg, Kg, Vg, i0 + 64 * w, 1, wbuf, oc, lc, nshift, lane);
#if ATT_EXP & 1
    { f32x16 ox[2][2]; float lx[2] = {0.f, 0.f};
#pragma unroll
      for (int b = 0; b < 2; ++b)
#pragma unroll
        for (int dh = 0; dh < 2; ++dh)
#pragma unroll
            for (int r = 0; r < 16; ++r) ox[b][dh][r] = 0.f;
      window<2>(Qg, Kg, Vg, i0 + 64 * w, 1, wbuf, ox, lx, nshift, lane);
      asm volatile("" :: "v"(ox[0][0]), "v"(ox[0][1]), "v"(ox[1][0]), "v"(ox[1][1]), "v"(lx[0]), "v"(lx[1])); }
#endif
    lc[0] += __shfl_xor(lc[0], 32); lc[1] += __shfl_xor(lc[1], 32);
#pragma unroll 1
    for (int j = 0; j < 2; ++j) { f32x16 o1[1][2]; float l1[1] = {0.f};
#pragma unroll
        for (int dh = 0; dh < 2; ++dh)
#pragma unroll
            for (int r = 0; r < 16; ++r) o1[0][dh][r] = 0.f;
        const int tl0 = (w & 3) + 128 * (2 * (w >> 2) + j);
        window<1>(Qg, Kg, Vg, i0 + tl0, 4, wbuf, o1, l1, nshift, lane);
#if ATT_EXP & 2
        asm volatile("" : "+v"(o1[0][0]), "+v"(o1[0][1]), "+v"(l1[0]));
#pragma unroll
        for (int dh = 0; dh < 2; ++dh)
#pragma unroll
            for (int r = 0; r < 16; ++r) o1[0][dh][r] = 0.f;
        l1[0] = 0.f;
        window<1>(Qg, Kg, Vg, i0 + tl0, 4, wbuf, o1, l1, nshift, lane);
#endif
        exchange1<4>(o1, l1[0], tl0, 4, j, oc, lc, lds, w, lane); }
#pragma unroll 1
    for (int j = 0; j < 2; ++j) { f32x16 o1[1][2]; float l1[1] = {0.f};
#pragma unroll
        for (int dh = 0; dh < 2; ++dh)
#pragma unroll
            for (int r = 0; r < 16; ++r) o1[0][dh][r] = 0.f;
        const int tl0 = 2 * w + j;
        window<1>(Qg, Kg, Vg, i0 + tl0, 16, wbuf, o1, l1, nshift, lane);
#if ATT_EXP & 4
        asm volatile("" : "+v"(o1[0][0]), "+v"(o1[0][1]), "+v"(l1[0]));
#pragma unroll
        for (int dh = 0; dh < 2; ++dh)
#pragma unroll
            for (int r = 0; r < 16; ++r) o1[0][dh][r] = 0.f;
        l1[0] = 0.f;
        window<1>(Qg, Kg, Vg, i0 + tl0, 16, wbuf, o1, l1, nshift, lane);
#endif
        exchange1<16>(o1, l1[0], tl0, 16, j, oc, lc, lds, w, lane); }
    __attribute__((address_space(3))) float* buf = (__attribute__((address_space(3))) float*)lds;
    __attribute__((address_space(3))) float* lbuf = (__attribute__((address_space(3))) float*)(lds + LBUF_OFF);
#pragma unroll
    for (int b = 0; b < 2; ++b) {
#pragma unroll
        for (int dh = 0; dh < 2; ++dh)
#pragma unroll
            for (int r = 0; r < 16; ++r) buf[(64 * w + 32 * b + crow(r, hi)) * 64 + dh * 32 + r32] = oc[b][dh][r];
        if (hi == 0) lbuf[64 * w + 32 * b + r32] = lc[b]; }
    __syncthreads();
#pragma unroll
    for (int k = 0; k < 8; ++k) { const int item = tid + 512 * k, tok = item >> 3, ch = item & 7;
        const f32x4 a = *(const __attribute__((address_space(3))) f32x4*)(buf + tok * 64 + ch * 8), c = *(const __attribute__((address_space(3))) f32x4*)(buf + tok * 64 + ch * 8 + 4);
        const float inv = 1.f / lbuf[tok];
        const f32x4 x = a * inv, y = c * inv;
        float ss = (x[0] * x[0] + x[1] * x[1]) + (x[2] * x[2] + x[3] * x[3]) + (y[0] * y[0] + y[1] * y[1]) + (y[2] * y[2] + y[3] * y[3]);
        v4u wv; wv.x = cvtpk(x[0], x[1]); wv.y = cvtpk(x[2], x[3]); wv.z = cvtpk(y[0], y[1]); wv.w = cvtpk(y[2], y[3]);
        *(v4u*)(MIXo + (size_t)(i0 + tok) * D + h * 64 + ch * 8) = wv;
        ss += __shfl_xor(ss, 1); ss += __shfl_xor(ss, 2); ss += __shfl_xor(ss, 4);
        if (ch == 0) SSQA[(i0 + tok) * 8 + h] = ss; }
    __syncthreads();
}
}


namespace ssm {
typedef short bf16x8 __attribute__((ext_vector_type(8)));
typedef __attribute__((address_space(3))) unsigned char* ldsp;
__device__ __forceinline__ void load_u_frags(const bf16* U, int tile, int g, int lane, bf16x8 (&a)[8]) {
    const int chunk = lane & 15, kq = lane >> 4;
    const bf16* p = U + (size_t)(tile * TILE + 16 * chunk + (kq >> 1)) * SW + 16 * g + 8 * (kq & 1);
#pragma unroll
    for (int ks = 0; ks < 8; ++ks) a[ks] = *(const bf16x8*)(p + (size_t)(2 * ks) * SW);
}
__device__ __forceinline__ void stage_table(const bf16* W, int rows, int cpr_log2, ldsp lds, int tid) {
    const int n = rows << cpr_log2;
    for (int id = tid; id < n; id += NTHREADS) { const int row = id >> cpr_log2, ch = id & ((1 << cpr_log2) - 1);
        const v4u v = *(const v4u*)(W + ((size_t)id << 3));
        *(__attribute__((address_space(3))) v4u*)(lds + (row << (cpr_log2 + 4)) + ((ch ^ (row & 15)) << 4)) = v; }
}
__device__ __forceinline__ void phaseA(const unsigned char* ws_, int tile, int g, ldsp lds, ldsp scr, int lane) {
    unsigned char* ws = const_cast<unsigned char*>(ws_);
    bf16x8 a[8]; load_u_frags((const bf16*)(ws + WS_U), tile, g, lane, a);
    const int n = lane & 15, kq = lane >> 4;
    __attribute__((address_space(3))) float* s = (__attribute__((address_space(3))) float*)scr;
#pragma unroll
    for (int nt = 0; nt < 8; ++nt) { f32x4 acc = {0.f, 0.f, 0.f, 0.f};
#pragma unroll
        for (int ks = 0; ks < 8; ++ks) { const bf16x8 b = *(const __attribute__((address_space(3))) bf16x8*)(lds + (16 * nt + n) * 512 + (((4 * ks + kq) ^ n) << 4));
            acc = __builtin_amdgcn_mfma_f32_16x16x32_bf16(a[ks], b, acc, 0, 0, 0); }
#pragma unroll
        for (int e = 0; e < 4; ++e) s[(4 * kq + e) * 128 + 16 * nt + n] = acc[e]; }
    asm volatile("s_waitcnt lgkmcnt(0)" ::: "memory");
    const int p = lane;
    const f32x2 al = ((const f32x2*)(ws + WS_ALP))[(g * 16 + 1) * 64 + p];
    float* XLOC = (float*)(ws + WS_XLOC) + ((size_t)(tile * NG + g) * 16) * 128;
    float xr = 0.f, xi = 0.f;
#pragma unroll
    for (int j = 0; j < NCH; ++j) { XLOC[j * 128 + p] = xr; XLOC[j * 128 + 64 + p] = xi;
        const float sr = s[j * 128 + p], si = s[j * 128 + 64 + p];
        const float nr = al.x * xr - al.y * xi + sr, ni = al.x * xi + al.y * xr + si; xr = nr; xi = ni; }
    float* ST = (float*)(ws + WS_STILE) + (size_t)(tile * NG + g) * 128; ST[p] = xr; ST[64 + p] = xi;
    asm volatile("s_waitcnt lgkmcnt(0)" ::: "memory");
}
__device__ __forceinline__ void phaseB(const unsigned char* ws_, int tile, int g, ldsp lds, ldsp scr, int lane) {
    unsigned char* ws = const_cast<unsigned char*>(ws_);
    { const int p = lane; float tr = 0.f, ti = 0.f;
      const f32x2* ATP = (const f32x2*)(ws + WS_ATP) + (size_t)g * 64 * 64 + p; const float* ST = (const float*)(ws + WS_STILE) + (size_t)g * 128 + p;
      for (int j0 = 0; j0 < tile; j0 += 8) {
          f32x2 a[8]; float sr[8], si[8];
#pragma unroll
          for (int jj = 0; jj < 8; ++jj) { const int j = j0 + jj; const int jc = j < tile ? j : tile - 1;
              a[jj] = ATP[(tile - 1 - jc) * 64]; sr[jj] = ST[(size_t)jc * NG * 128]; si[jj] = ST[(size_t)jc * NG * 128 + 64];
              if (j >= tile) a[jj] = (f32x2){0.f, 0.f}; }
#pragma unroll
          for (int jj = 0; jj < 8; ++jj) { tr += a[jj].x * sr[jj] - a[jj].y * si[jj]; ti += a[jj].x * si[jj] + a[jj].y * sr[jj]; } }
      const float* XLOC = (const float*)(ws + WS_XLOC) + ((size_t)(tile * NG + g) * 16) * 128;
      const f32x2* ALP = (const f32x2*)(ws + WS_ALP) + (size_t)g * 16 * 64;
      __attribute__((address_space(3))) bf16* xp = (__attribute__((address_space(3))) bf16*)scr;
#pragma unroll
      for (int j = 0; j < NCH; ++j) { const f32x2 a = ALP[j * 64 + p];
          xp[j * 128 + p] = (bf16)f2bf(XLOC[j * 128 + p] + a.x * tr - a.y * ti); xp[j * 128 + 64 + p] = (bf16)f2bf(XLOC[j * 128 + 64 + p] + a.x * ti + a.y * tr); } }
    asm volatile("s_waitcnt lgkmcnt(0)" ::: "memory");
    const int c = lane & 15, kq = lane >> 4;
    bf16x8 ax[4];
#pragma unroll
    for (int ks = 0; ks < 4; ++ks) ax[ks] = *(const __attribute__((address_space(3))) bf16x8*)(scr + c * 256 + (32 * ks + 8 * kq) * 2);
    asm volatile("s_waitcnt lgkmcnt(0)" ::: "memory");
    bf16x8 au[8]; load_u_frags((const bf16*)(ws + WS_U), tile, g, lane, au);
    const bf16* TMg = (const bf16*)(ws + WS_TM) + (size_t)g * 17 * 256 + c * 16 + 8 * (kq & 1);
    __attribute__((address_space(3))) bf16* zt = (__attribute__((address_space(3))) bf16*)scr;
#pragma unroll
    for (int t = 0; t < 16; ++t) { f32x4 acc = {0.f, 0.f, 0.f, 0.f};
#pragma unroll
        for (int ks = 0; ks < 4; ++ks) { const bf16x8 b = *(const __attribute__((address_space(3))) bf16x8*)(lds + (16 * t + c) * 256 + (((4 * ks + kq) ^ c) << 4));
            acc = __builtin_amdgcn_mfma_f32_16x16x32_bf16(ax[ks], b, acc, 0, 0, 0); }
#pragma unroll
        for (int ks = 0; ks <= t / 2; ++ks) { const int li = t - 2 * ks - (kq >> 1) + 1;
            const bf16x8 b = *(const bf16x8*)(TMg + (li < 0 ? 0 : li) * 256); acc = __builtin_amdgcn_mfma_f32_16x16x32_bf16(au[ks], b, acc, 0, 0, 0); }
#pragma unroll
        for (int e = 0; e < 4; ++e) { const float y = acc[e]; const float u2 = 1.5957691216057308f * (y + 0.044715f * y * y * y);
            const float z = y * __builtin_amdgcn_rcpf(1.f + __builtin_amdgcn_exp2f(-1.4426950408889634f * u2));
            zt[(16 * (4 * kq + e) + t) * 16 + c] = (bf16)f2bf(z); }
        asm volatile("" ::: "memory"); }
    asm volatile("s_waitcnt lgkmcnt(0)" ::: "memory");
    bf16* Z = (bf16*)(ws + WS_Z) + (size_t)tile * TILE * SW + 16 * g;
#pragma unroll
    for (int k = 0; k < 8; ++k) { const int item = lane + 64 * k, tok = item >> 1, hf = item & 1;
        const v4u v = *(const __attribute__((address_space(3))) v4u*)(scr + tok * 32 + hf * 16);
        *(v4u*)(Z + (size_t)tok * SW + 8 * hf) = v; }
    asm volatile("s_waitcnt lgkmcnt(0)" ::: "memory");
}
}

struct Args { const float* in[21]; float* out; unsigned char* ws; int ph_lo, ph_hi; };
struct Frame {
    LAS unsigned char* lds;
    int tid, lane, wave, G, bid;
    const float* in[21]; float* out; unsigned char* ws;
};
#define P_X 0
#define P_G1 1
#define P_WIN 2
#define P_GQ 3
#define P_GK 4
#define P_ARE 5
#define P_AIM 6
#define P_LDT 7
#define P_BRE 8
#define P_BIM 9
#define P_CRE 10
#define P_CIM 11
#define P_DSK 12
#define P_GLUW 13
#define P_GLUB 14
#define P_GA 15
#define P_GS 16
#define P_WOUT 17
#define P_G2 18
#define P_WUP 19
#define P_WDOWN 20

__device__ __forceinline__ void p0_transpose_item(const float* W, int K, int N, bf16* WT, const float* g_lo, const float* g_hi, int split, LAS float* scr, int item, int lane) {
    const int nblk = N / 32, kb = item / nblk, nb = item % nblk, k0 = 64 * kb, n0 = 32 * nb;
    f32x4 v[8];
#pragma unroll
    for (int i = 0; i < 8; ++i) v[i] = *(const GAS f32x4*)(W + (size_t)(k0 + 8 * i + (lane >> 3)) * N + n0 + 4 * (lane & 7));
#pragma unroll
    for (int i = 0; i < 8; ++i) { const int kk = 8 * i + (lane >> 3), k = k0 + kk;
        const float g = g_lo ? (k < split ? g_lo[k] : g_hi[k - split]) : 1.f;
        LAS float* d = scr + kk * 33 + 4 * (lane & 7);
        d[0] = v[i][0] * g; d[1] = v[i][1] * g; d[2] = v[i][2] * g; d[3] = v[i][3] * g; }
    asm volatile("s_waitcnt lgkmcnt(0)" ::: "memory");
    const int c = lane & 7;
#pragma unroll
    for (int j = 0; j < 4; ++j) { const int n = (lane >> 3) + 8 * j; const LAS float* s = scr + (8 * c) * 33 + n;
        v4u o; o.x = pk2(s[0 * 33], s[1 * 33]); o.y = pk2(s[2 * 33], s[3 * 33]); o.z = pk2(s[4 * 33], s[5 * 33]); o.w = pk2(s[6 * 33], s[7 * 33]);
        *(GAS v4u*)(WT + (size_t)(n0 + n) * K + k0 + 8 * c) = o; }
    asm volatile("s_waitcnt lgkmcnt(0)" ::: "memory");
}
__device__ __forceinline__ void rms_row_to_bf16(const float* xrow, bf16* orow, int lane) {
    const GAS f32x4* xr = (const GAS f32x4*)xrow + lane;
    f32x4 v[4]; float s = 0.f;
#pragma unroll
    for (int j = 0; j < 4; ++j) { v[j] = xr[64 * j]; s += (v[j].x * v[j].x + v[j].y * v[j].y) + (v[j].z * v[j].z + v[j].w * v[j].w); }
    const float rstd = 1.f / sqrtf(wave_sum(s) * (1.f / D) + EPS);
    GAS unsigned long long* o8 = (GAS unsigned long long*)orow + lane;
#pragma unroll
    for (int j = 0; j < 4; ++j) o8[64 * j] = (unsigned long long)pk2(v[j].x * rstd, v[j].y * rstd) | ((unsigned long long)pk2(v[j].z * rstd, v[j].w * rstd) << 32);
}
struct cd { double re, im; };
__device__ __forceinline__ cd cmul(cd a, cd b) { return cd{a.re * b.re - a.im * b.im, a.re * b.im + a.im * b.re}; }
constexpr int NPART = 8;
__device__ __forceinline__ void p0_ssm_tables(Frame& F, int g, int part) {
    cd* apow = (cd*)(__attribute__((address_space(3))) cd*)(F.lds);
    cd* bbar = apow + 17 * 64;
    cd* cc = bbar + 64 * 16;
    cd* coef = cc + 16 * 64;
    const float* a_re = F.in[P_ARE] + g * 64; const float* a_im = F.in[P_AIM] + g * 64;
    const double dt = exp((double)F.in[P_LDT][g]);
    const int tid = F.tid;
    for (int i = tid; i < 17 * 64; i += NTHREADS) { const int j = i >> 6, p = i & 63; const double lr = a_re[p], li = a_im[p];
        const double mag = exp(j * lr * dt), ang = j * li * dt; double sn, cs; sincos(ang, &sn, &cs); apow[i] = cd{mag * cs, mag * sn}; }
    for (int i = tid; i < 16 * 64; i += NTHREADS) cc[i] = cd{(double)F.in[P_CRE][g * 1024 + i], (double)F.in[P_CIM][g * 1024 + i]};
    __syncthreads();
    if (tid < 64) { const int p = tid; const double lr = a_re[p], li = a_im[p]; const cd ab = apow[64 + p];
        const double den = lr * lr + li * li, nr = ab.re - 1.0, ni = ab.im; coef[p] = cd{(nr * lr + ni * li) / den, (ni * lr - nr * li) / den}; }
    __syncthreads();
    for (int i = tid; i < 64 * 16; i += NTHREADS) { const int p = i >> 4, c = i & 15;
        const double br = F.in[P_BRE][(g * 64 + p) * 16 + c], bi = F.in[P_BIM][(g * 64 + p) * 16 + c]; bbar[i] = cmul(coef[p], cd{br, bi}); }
    __syncthreads();
    bf16* TM = (bf16*)(F.ws + WS_TM) + (size_t)g * 17 * 256;
    bf16* WST = (bf16*)(F.ws + WS_WST) + (size_t)g * 128 * 256;
    bf16* WCR = (bf16*)(F.ws + WS_WCR) + (size_t)g * 256 * 128;
    f32x2* ALP = (f32x2*)(F.ws + WS_ALP) + (size_t)g * 16 * 64;
    f32x2* ATP = (f32x2*)(F.ws + WS_ATP) + (size_t)g * 64 * 64;
    const int t0 = tid + NTHREADS * part, tstride = NTHREADS * NPART;
    for (int i = t0; i < 17 * 256; i += tstride) { const int l1 = i >> 8, c = (i >> 4) & 15, c2 = i & 15; double s = 0.0;
        if (l1 > 0) { const int lag = l1 - 1;
            for (int p = 0; p < 64; ++p) { const cd t = cmul(cmul(cc[c * 64 + p], apow[lag * 64 + p]), bbar[p * 16 + c2]); s += t.re; }
            if (lag == 0 && c == c2) s += (double)F.in[P_DSK][g * 16 + c]; }
        TM[i] = (bf16)f2bf((float)s); }
    for (int i = t0; i < 128 * 256; i += tstride) { const int q = i >> 8, k = i & 255, s = k >> 4, c2 = k & 15, p = q & 63;
        const cd w = cmul(apow[(15 - s) * 64 + p], bbar[p * 16 + c2]); WST[i] = (bf16)f2bf((float)(q < 64 ? w.re : w.im)); }
    for (int i = t0; i < 256 * 128; i += tstride) { const int n = i >> 7, q = i & 127, t = n >> 4, c = n & 15, p = q & 63;
        const cd w = cmul(cc[c * 64 + p], apow[(t + 1) * 64 + p]); WCR[i] = (bf16)f2bf((float)(q < 64 ? w.re : -w.im)); }
    for (int i = t0; i < 16 * 64; i += tstride) { const int j = i >> 6, p = i & 63; const double lr = a_re[p], li = a_im[p];
        const double n = 16.0 * j; const double mag = exp(n * lr * dt), ang = n * li * dt; double sn, cs; sincos(ang, &sn, &cs); ALP[i] = (f32x2){(float)(mag * cs), (float)(mag * sn)}; }
    for (int i = t0; i < 64 * 64; i += tstride) { const int m = i >> 6, p = i & 63; const double lr = a_re[p], li = a_im[p];
        const double n = 256.0 * m; const double mag = exp(n * lr * dt), ang = n * li * dt; double sn, cs; sincos(ang, &sn, &cs); ATP[i] = (f32x2){(float)(mag * cs), (float)(mag * sn)}; }
    __syncthreads();
}
__device__ __forceinline__ void p0_prologue(Frame& F) {
    for (int gp = F.bid; gp < NG * NPART; gp += F.G) p0_ssm_tables(F, gp & 31, gp >> 5);
    LAS float* scr = (LAS float*)(F.lds + F.wave * 16384);
    const int gw = F.bid * NWAVES + F.wave, NGW = F.G * NWAVES;
    constexpr int I_IN = (D / 64) * (PW / 32), I_GLU = (SW / 64) * (SW / 32);
    constexpr int NITEMS = I_IN + I_GLU;
    for (int it = gw; it < NITEMS; it += NGW) {
        int r = it;
        if (r < I_IN) { p0_transpose_item(F.in[P_WIN], D, PW, (bf16*)(F.ws + WS_WIN), F.in[P_G1], F.in[P_G1], D, scr, r, F.lane); continue; } r -= I_IN;
        p0_transpose_item(F.in[P_GLUW], SW, SW, (bf16*)(F.ws + WS_WGLU), nullptr, nullptr, 0, scr, r, F.lane);
    }
    for (int m = gw; m < M; m += 2 * NGW) {
        const int m2 = m + NGW; const bool two = m2 < M; const int mb = two ? m2 : m;
        const GAS f32x4* xa = (const GAS f32x4*)(F.in[P_X] + (size_t)m * D) + F.lane; const GAS f32x4* xb = (const GAS f32x4*)(F.in[P_X] + (size_t)mb * D) + F.lane;
        f32x4 va[4], vb[4]; float sa = 0.f, sb = 0.f;
#pragma unroll
        for (int j = 0; j < 4; ++j) { va[j] = xa[64 * j]; vb[j] = xb[64 * j]; }
#pragma unroll
        for (int j = 0; j < 4; ++j) { sa += (va[j].x * va[j].x + va[j].y * va[j].y) + (va[j].z * va[j].z + va[j].w * va[j].w); sb += (vb[j].x * vb[j].x + vb[j].y * vb[j].y) + (vb[j].z * vb[j].z + vb[j].w * vb[j].w); }
        const float ra = 1.f / sqrtf(wave_sum(sa) * (1.f / D) + EPS), rb = 1.f / sqrtf(wave_sum(sb) * (1.f / D) + EPS);
        GAS unsigned long long* oa = (GAS unsigned long long*)((bf16*)(F.ws + WS_XN) + (size_t)m * D) + F.lane; GAS unsigned long long* ob = (GAS unsigned long long*)((bf16*)(F.ws + WS_XN) + (size_t)mb * D) + F.lane;
#pragma unroll
        for (int j = 0; j < 4; ++j) { oa[64 * j] = (unsigned long long)pk2(va[j].x * ra, va[j].y * ra) | ((unsigned long long)pk2(va[j].z * ra, va[j].w * ra) << 32);
            if (two) ob[64 * j] = (unsigned long long)pk2(vb[j].x * rb, vb[j].y * rb) | ((unsigned long long)pk2(vb[j].z * rb, vb[j].w * rb) << 32); }
    }
}

__device__ __forceinline__ void p4_late_weights(Frame& F, int gw, int ngw) {
    LAS float* scr = (LAS float*)(F.lds + F.wave * 16384);
    constexpr int I_OUT = (D / 64) * (D / 32), I_UP = (D / 64) * (FF / 32), I_DOWN = (FF / 64) * (D / 32);
    for (int it = gw; it < I_OUT + I_UP + I_DOWN; it += ngw) {
        int r = it;
        if (r < I_OUT) { p0_transpose_item(F.in[P_WOUT], D, D, (bf16*)(F.ws + WS_WOUT), F.in[P_GA], F.in[P_GS], AW, scr, r, F.lane); continue; } r -= I_OUT;
        if (r < I_UP) { p0_transpose_item(F.in[P_WUP], D, FF, (bf16*)(F.ws + WS_WUP), F.in[P_G2], F.in[P_G2], D, scr, r, F.lane); continue; } r -= I_UP;
        p0_transpose_item(F.in[P_WDOWN], FF, D, (bf16*)(F.ws + WS_WDOWN), nullptr, nullptr, 0, scr, r, F.lane);
    }
}

__device__ __forceinline__ float att_shift(Frame& F) {
    float mq = 0.f, mk = 0.f;
    for (int i = 0; i < 64; ++i) { mq = fmaxf(mq, fabsf(F.in[P_GQ][i])); mk = fmaxf(mk, fabsf(F.in[P_GK][i])); }
    return 64.f * mq * mk * C2 * 1.0001f;
}
__device__ __forceinline__ void p1_naive(Frame& F) {
    const bf16* XN = (const bf16*)(F.ws + WS_XN); const bf16* W = (const bf16*)(F.ws + WS_WIN);
    const size_t total = (size_t)M * PW, nthr = (size_t)F.G * NTHREADS;
    for (size_t idx = (size_t)F.bid * NTHREADS + F.tid; idx < total; idx += nthr) {
        const int m = (int)(idx / PW), n = (int)(idx % PW);
        const float acc = dot_bf16(XN + (size_t)m * D, W + (size_t)n * D, D);
        const int seg = n >> 9, c = n & 511;
        float v = acc;
        if (seg < 2) { const float ss = wave_sum(acc * acc); const float r = 1.f / sqrtf(ss * (1.f / 64.f) + EPS);
            v = acc * r * (seg == 0 ? F.in[P_GQ][c & 63] * C2 : F.in[P_GK][c & 63]); }
        bf16* dst = (bf16*)(F.ws + (seg == 0 ? WS_Q : seg == 1 ? WS_K : seg == 2 ? WS_V : WS_U));
        dst[(size_t)m * AW + c] = (bf16)f2bf(v);
    }
}
__device__ __forceinline__ void p2_attn_naive(Frame& F) {
    const bf16* Q = (const bf16*)(F.ws + WS_Q); const bf16* K = (const bf16*)(F.ws + WS_K); const bf16* V = (const bf16*)(F.ws + WS_V);
    bf16* ATT = (bf16*)(F.ws + WS_MIX); float* SSQA = (float*)(F.ws + WS_SSQA);
    const float shift = att_shift(F);
    const int gw = F.bid * NWAVES + F.wave, NGW = F.G * NWAVES;
    for (int it = gw; it < M * NH; it += NGW) {
        const int m = it >> 3, h = it & 7; const int col = h * 64 + F.lane;
        const float q = bf2f(Q[(size_t)m * AW + col]);
        float o = 0.f, l = 0.f;
        for (int di = 0; di < 3; ++di) { const int d = di == 0 ? 1 : di == 1 ? 4 : 16;
            for (int mm = 0; mm <= 128; ++mm) { const int j = m - d * mm; if (j < 0) break;
                const float s = wave_sum(q * bf2f(K[(size_t)j * AW + col]));
                const float p = exp2f(s - shift);
                l += p; o += p * bf2f(V[(size_t)j * AW + col]); } }
        const float r = o / l;
        ATT[(size_t)m * D + col] = (bf16)f2bf(r);
        const float ss = wave_sum(r * r);
        if (F.lane == 0) SSQA[m * 8 + h] = ss;
    }
}
__device__ __forceinline__ void p2_ssmA_naive(Frame& F) {
    const bf16* U = (const bf16*)(F.ws + WS_U);
    const size_t nthr = (size_t)F.G * NTHREADS;
    for (size_t idx = (size_t)F.bid * NTHREADS + F.tid; idx < (size_t)NTILE * NG * 64; idx += nthr) {
        const int p = (int)(idx & 63), g = (int)((idx >> 6) & 31), tile = (int)(idx >> 11);
        const bf16* Wr = (const bf16*)(F.ws + WS_WST) + ((size_t)g * 128 + p) * 256; const bf16* Wi = Wr + 64 * 256;
        const f32x2 al = ((const f32x2*)(F.ws + WS_ALP))[(g * 16 + 1) * 64 + p];
        float* XLOC = (float*)(F.ws + WS_XLOC) + ((size_t)(tile * NG + g) * 16) * 128;
        float xr = 0.f, xi = 0.f;
        for (int j = 0; j < NCH; ++j) {
            XLOC[j * 128 + p] = xr; XLOC[j * 128 + 64 + p] = xi;
            float sr = 0.f, si = 0.f;
            for (int k = 0; k < 256; ++k) { const float u = bf2f(U[(size_t)(tile * TILE + j * LCH + (k >> 4)) * SW + g * 16 + (k & 15)]); sr += u * bf2f(Wr[k]); si += u * bf2f(Wi[k]); }
            const float nr = al.x * xr - al.y * xi + sr, ni = al.x * xi + al.y * xr + si; xr = nr; xi = ni;
        }
        float* ST = (float*)(F.ws + WS_STILE) + (size_t)(tile * NG + g) * 128; ST[p] = xr; ST[64 + p] = xi;
    }
}
__device__ __forceinline__ float gelu_tanh(float y) { const float t = tanhf(0.7978845608028654f * (y + 0.044715f * y * y * y)); return 0.5f * y * (1.f + t); }
__device__ __forceinline__ void p3_ssmB_naive(Frame& F) {
    const bf16* U = (const bf16*)(F.ws + WS_U); bf16* Z = (bf16*)(F.ws + WS_Z);
    LAS float* xp = (LAS float*)F.lds;
    for (int pair = F.bid; pair < NTILE * NG; pair += F.G) {
        const int tile = pair >> 5, g = pair & 31;
        if (F.tid < 64) { const int p = F.tid; float tr = 0.f, ti = 0.f;
            const f32x2* ATP = (const f32x2*)(F.ws + WS_ATP) + (size_t)g * 64 * 64;
            for (int j = 0; j < tile; ++j) { const f32x2 a = ATP[(tile - 1 - j) * 64 + p]; const float* ST = (const float*)(F.ws + WS_STILE) + (size_t)(j * NG + g) * 128;
                const float sr = ST[p], si = ST[64 + p]; tr += a.x * sr - a.y * si; ti += a.x * si + a.y * sr; }
            const float* XLOC = (const float*)(F.ws + WS_XLOC) + ((size_t)(tile * NG + g) * 16) * 128;
            const f32x2* ALP = (const f32x2*)(F.ws + WS_ALP) + (size_t)g * 16 * 64;
            for (int j = 0; j < NCH; ++j) { const f32x2 a = ALP[j * 64 + p];
                xp[j * 128 + p] = XLOC[j * 128 + p] + a.x * tr - a.y * ti; xp[j * 128 + 64 + p] = XLOC[j * 128 + 64 + p] + a.x * ti + a.y * tr; } }
        __syncthreads();
        const bf16* TM = (const bf16*)(F.ws + WS_TM) + (size_t)g * 17 * 256; const bf16* WCR = (const bf16*)(F.ws + WS_WCR) + (size_t)g * 256 * 128;
        for (int o = F.tid; o < TILE * 16; o += NTHREADS) { const int tl = o >> 4, c = o & 15, j = tl >> 4, t = tl & 15; float y = 0.f;
            for (int s = 0; s <= t; ++s) { const bf16* tm = TM + ((t - s + 1) * 16 + c) * 16; const bf16* u = U + (size_t)(tile * TILE + j * LCH + s) * SW + g * 16;
                for (int c2 = 0; c2 < 16; ++c2) y += bf2f(tm[c2]) * bf2f(u[c2]); }
            const bf16* wc = WCR + (size_t)(t * 16 + c) * 128;
            for (int q = 0; q < 128; ++q) y += xp[j * 128 + q] * bf2f(wc[q]);
            Z[(size_t)(tile * TILE + tl) * SW + g * 16 + c] = (bf16)f2bf(gelu_tanh(y)); }
        __syncthreads();
    }
}
__device__ __forceinline__ void p4_glu_naive(Frame& F) {
    const bf16* Z = (const bf16*)(F.ws + WS_Z); const bf16* W = (const bf16*)(F.ws + WS_WGLU); bf16* O = (bf16*)(F.ws + WS_MIX) + AW; float* SSQS = (float*)(F.ws + WS_SSQS);
    const size_t total = (size_t)M * SW, nthr = (size_t)F.G * NTHREADS;
    for (size_t idx = (size_t)F.bid * NTHREADS + F.tid; idx < total; idx += nthr) {
        const int m = (int)(idx >> 9), n = (int)(idx & 511);
        const float acc = dot_bf16(Z + (size_t)m * SW, W + (size_t)n * SW, SW) + F.in[P_GLUB][n];
        const float z = bf2f(Z[(size_t)m * SW + n]); const float o = z / (1.f + expf(-acc));
        O[(size_t)m * D + n] = (bf16)f2bf(o);
        const float ss = wave_sum(o * o); if (F.lane == 0) SSQS[m * 8 + (n >> 6)] = ss;
    }
}
__device__ __forceinline__ void p5_out_naive(Frame& F) {
    const bf16* A = (const bf16*)(F.ws + WS_MIX); const bf16* S = (const bf16*)(F.ws + WS_MIX) + AW; const bf16* W = (const bf16*)(F.ws + WS_WOUT);
    const float* SSQA = (const float*)(F.ws + WS_SSQA); const float* SSQS = (const float*)(F.ws + WS_SSQS); float* SSQ2 = (float*)(F.ws + WS_SSQ2); bf16* X1B = (bf16*)(F.ws + WS_XN);
    const size_t total = (size_t)M * D, nthr = (size_t)F.G * NTHREADS;
    for (size_t idx = (size_t)F.bid * NTHREADS + F.tid; idx < total; idx += nthr) {
        const int m = (int)(idx >> 10), n = (int)(idx & 1023);
        float sa = 0.f, ss = 0.f;
        for (int i = 0; i < 8; ++i) { sa += SSQA[m * 8 + i]; ss += SSQS[m * 8 + i]; }
        const float ra = 1.f / sqrtf(sa * (1.f / 512.f) + EPS), rs = 1.f / sqrtf(ss * (1.f / 512.f) + EPS);
        const float accA = dot_bf16(A + (size_t)m * D, W + (size_t)n * D, AW), accS = dot_bf16(S + (size_t)m * D, W + (size_t)n * D + AW, SW);
        const float x1 = F.in[P_X][(size_t)m * D + n] + ra * accA + rs * accS;
        F.out[(size_t)m * D + n] = x1; X1B[(size_t)m * D + n] = (bf16)f2bf(x1);
        const float q = wave_sum(x1 * x1); if (F.lane == 0) SSQ2[m * 16 + (n >> 6)] = q;
    }
}
__device__ __forceinline__ void p6_up_naive(Frame& F) {
    const bf16* A = (const bf16*)(F.ws + WS_XN); const bf16* W = (const bf16*)(F.ws + WS_WUP); const float* SSQ2 = (const float*)(F.ws + WS_SSQ2); bf16* H = (bf16*)(F.ws + WS_H);
    const size_t total = (size_t)M * FF, nthr = (size_t)F.G * NTHREADS;
    for (size_t idx = (size_t)F.bid * NTHREADS + F.tid; idx < total; idx += nthr) {
        const int m = (int)(idx >> 12), n = (int)(idx & 4095);
        float s2 = 0.f; for (int i = 0; i < 16; ++i) s2 += SSQ2[m * 16 + i];
        const float r2 = 1.f / sqrtf(s2 * (1.f / 1024.f) + EPS);
        const float a = fmaxf(r2 * dot_bf16(A + (size_t)m * D, W + (size_t)n * D, D), 0.f);
        H[(size_t)m * FF + n] = (bf16)f2bf(a * a);
    }
}
__device__ __forceinline__ void p7_down_naive(Frame& F) {
    const bf16* H = (const bf16*)(F.ws + WS_H); const bf16* W = (const bf16*)(F.ws + WS_WDOWN);
    const size_t total = (size_t)M * D, nthr = (size_t)F.G * NTHREADS;
    for (size_t idx = (size_t)F.bid * NTHREADS + F.tid; idx < total; idx += nthr) {
        const int m = (int)(idx >> 10), n = (int)(idx & 1023);
        F.out[(size_t)m * D + n] += dot_bf16(H + (size_t)m * FF, W + (size_t)n * FF, FF);
    }
}


__device__ __forceinline__ int wg_pm(int c) { return 8 * (c & 7) + ((c >> 3) & 7); }
__device__ __forceinline__ void p1_fast(Frame& F) {
    pg8::Gemm g{(const bf16*)(F.ws + WS_XN), (const bf16*)(F.ws + WS_WIN), M, PW, D}; pg8::StaticOrder S; S.init(M, PW, F.G, F.bid);
    pg8::EpiInProj E{(bf16*)(F.ws + WS_Q), (bf16*)(F.ws + WS_K), (bf16*)(F.ws + WS_V), (bf16*)(F.ws + WS_U), F.in[P_GQ], F.in[P_GK]};
    pg8::gemm_phase<pg8::EpiInProj, pg8::StaticOrder, true>(F.lds, g, S, E);
}
__device__ __forceinline__ void p4_fast(Frame& F) {
    constexpr int GLU_UNITS = (M / 256) * (SW / 256);
    if (F.G > GLU_UNITS) { if (F.bid >= GLU_UNITS) { p4_late_weights(F, (F.bid - GLU_UNITS) * NWAVES + F.wave, (F.G - GLU_UNITS) * NWAVES); return; } }
    else p4_late_weights(F, F.bid * NWAVES + F.wave, F.G * NWAVES);
    pg8::Gemm g{(const bf16*)(F.ws + WS_Z), (const bf16*)(F.ws + WS_WGLU), M, SW, SW}; pg8::StaticOrder S; S.init(M, SW, F.G, F.bid);
    pg8::EpiGlu E{(const bf16*)(F.ws + WS_Z), (bf16*)(F.ws + WS_MIX) + AW, F.in[P_GLUB], (float*)(F.ws + WS_SSQS)};
    pg8::gemm_phase<pg8::EpiGlu, pg8::StaticOrder, true>(F.lds, g, S, E);
}
__device__ __forceinline__ void p5_fast(Frame& F) {
    LAS f32x2* tab = (LAS f32x2*)(F.lds + ROWTAB_OFF);
    if (F.tid < 256) { const int row = wg_pm(F.bid) * 256 + F.tid; const f32x4* a = (const f32x4*)((const float*)(F.ws + WS_SSQA) + row * 8); const f32x4* s = (const f32x4*)((const float*)(F.ws + WS_SSQS) + row * 8);
        const f32x4 a0 = a[0], a1 = a[1], s0 = s[0], s1 = s[1];
        const float sa = ((a0[0] + a0[1]) + (a0[2] + a0[3])) + ((a1[0] + a1[1]) + (a1[2] + a1[3])), ss = ((s0[0] + s0[1]) + (s0[2] + s0[3])) + ((s1[0] + s1[1]) + (s1[2] + s1[3]));
        const float ra = 1.f / sqrtf(sa * (1.f / 512.f) + EPS), rs = 1.f / sqrtf(ss * (1.f / 512.f) + EPS);
        tab[F.tid] = (f32x2){ra / rs, rs}; }
    __syncthreads();
    pg8::Gemm g{(const bf16*)(F.ws + WS_MIX), (const bf16*)(F.ws + WS_WOUT), M, D, D}; pg8::StaticOrder S; S.init(M, D, F.G, F.bid);
    pg8::EpiOut E{F.in[P_X], F.out, (bf16*)(F.ws + WS_XN), (float*)(F.ws + WS_SSQ2)};
    pg8::gemm_phase<pg8::EpiOut, pg8::StaticOrder, true>(F.lds, g, S, E);
}
__device__ __forceinline__ void p6_fast(Frame& F) {
    LAS f32x2* tab = (LAS f32x2*)(F.lds + ROWTAB_OFF);
    if (F.tid < 256) { const int row = wg_pm(F.bid) * 256 + F.tid; const f32x4* q = (const f32x4*)((const float*)(F.ws + WS_SSQ2) + row * 16); float s = 0.f;
#pragma unroll
        for (int i = 0; i < 4; ++i) { const f32x4 v = q[i]; s += (v[0] + v[1]) + (v[2] + v[3]); }
        tab[F.tid] = (f32x2){1.f / sqrtf(s * (1.f / 1024.f) + EPS), 0.f}; }
    __syncthreads();
    pg8::Gemm g{(const bf16*)(F.ws + WS_XN), (const bf16*)(F.ws + WS_WUP), M, FF, D}; pg8::StaticOrder S; S.init(M, FF, F.G, F.bid);
    pg8::EpiUp E{(bf16*)(F.ws + WS_H)};
    pg8::gemm_phase<pg8::EpiUp, pg8::StaticOrder, true>(F.lds, g, S, E);
}
__device__ __forceinline__ void p7_fast(Frame& F) {
    pg8::Gemm g{(const bf16*)(F.ws + WS_H), (const bf16*)(F.ws + WS_WDOWN), M, D, FF}; pg8::StaticOrder S; S.init(M, D, F.G, F.bid);
    pg8::EpiDown E{F.out};
    pg8::gemm_phase<pg8::EpiDown, pg8::StaticOrder, true>(F.lds, g, S, E);
}


__device__ __forceinline__ void p2_attn_fast(Frame& F) {
    float mq = fabsf(F.in[P_GQ][F.lane]), mk = fabsf(F.in[P_GK][F.lane]);
#pragma unroll
    for (int o = 1; o < 64; o <<= 1) { mq = fmaxf(mq, __shfl_xor(mq, o)); mk = fmaxf(mk, __shfl_xor(mk, o)); }
    const float nshift = -(64.f * mq * mk * C2 * 1.0001f);
    for (int u = F.bid; u < NH * (M / 512); u += F.G)
        att::unit((const bf16*)(F.ws + WS_Q), (const bf16*)(F.ws + WS_K), (const bf16*)(F.ws + WS_V), (bf16*)(F.ws + WS_MIX), (float*)(F.ws + WS_SSQA), u & 7, (u >> 3) * 512, nshift, F.lds, F.tid);
}


__device__ __forceinline__ void p2_ssmA_fast(Frame& F) {
    for (int batch = F.bid; batch < NTILE * NG / NWAVES; batch += F.G) { const int g = batch & 31, tile = (batch >> 5) * 8 + F.wave;
        __syncthreads();
        ssm::stage_table((const bf16*)(F.ws + WS_WST) + (size_t)g * 128 * 256, 128, 5, F.lds, F.tid);
        __syncthreads();
        ssm::phaseA(F.ws, tile, g, F.lds, F.lds + 65536 + F.wave * 8192, F.lane); }
    __syncthreads();
}
__device__ __forceinline__ void p3_ssmB_fast(Frame& F) {
    for (int batch = F.bid; batch < NTILE * NG / NWAVES; batch += F.G) { const int g = batch & 31, tile = (batch >> 5) * 8 + F.wave;
        __syncthreads();
        ssm::stage_table((const bf16*)(F.ws + WS_WCR) + (size_t)g * 256 * 128, 256, 4, F.lds, F.tid);
        __syncthreads();
        ssm::phaseB(F.ws, tile, g, F.lds, F.lds + 65536 + F.wave * 8192, F.lane); }
    __syncthreads();
}

constexpr int N_PHASES = 8;
__global__ void __launch_bounds__(NTHREADS, 2) mk_fwd(Args args) {
    extern __shared__ __attribute__((aligned(16))) unsigned char lds_raw[];
    Frame F;
    F.lds = (LAS unsigned char*)lds_raw;
    F.tid = threadIdx.x; F.lane = F.tid & 63; F.wave = __builtin_amdgcn_readfirstlane(F.tid >> 6);
    F.G = gridDim.x; F.bid = blockIdx.x;
#pragma unroll
    for (int i = 0; i < 21; ++i) F.in[i] = args.in[i];
    F.out = args.out; F.ws = args.ws;
    volatile LAS unsigned* MISC = (volatile LAS unsigned*)(F.lds + MISC_OFF);
    for (int u = F.tid; u < 64; u += NTHREADS) MISC[u] = 0u;
    __syncthreads();
    unsigned* ctl = (unsigned*)(F.ws + WS_CTL);
    XcdBarrier bar; bar.bar = ctl + CW_BAR; bar.x = 0; bar.st = nullptr;
    if (!MK_SPLIT) bar = xcd_barrier_post(ctl + CW_BAR, MISC + 8);
    const int lo = args.ph_lo, hi = args.ph_hi;
#define IN(k) (lo <= (k) && (k) < hi)
#define SEAM(k) do { if (IN(k) && IN((k) + 1)) xcd_barrier(bar); } while (0)
#define REPS(bit) (((REP_MASK >> (bit)) & 1) ? REP_N : 1)
#define RUN(bit, body) do { _Pragma("unroll 1") for (int rep_ = 0; rep_ < REPS(bit); ++rep_) { if (rep_) xcd_barrier(bar); body; } } while (0)
    if (IN(0)) { RUN(0, p0_prologue(F)); } SEAM(0);
    if (IN(1)) { RUN(1, if (FAST_MASK & 2) p1_fast(F); else p1_naive(F)); } SEAM(1);
    if (IN(2)) { RUN(8, if (FAST_MASK & 1) p2_ssmA_fast(F); else p2_ssmA_naive(F)); RUN(2, if (FAST_MASK & 4) p2_attn_fast(F); else p2_attn_naive(F)); } SEAM(2);
    if (IN(3)) { RUN(3, if (FAST_MASK & 8) p3_ssmB_fast(F); else p3_ssmB_naive(F)); } SEAM(3);
    if (IN(4)) { RUN(4, if (FAST_MASK & 16) p4_fast(F); else p4_glu_naive(F)); } SEAM(4);
    if (IN(5)) { RUN(5, if (FAST_MASK & 32) p5_fast(F); else p5_out_naive(F)); } SEAM(5);
    if (IN(6)) { RUN(6, if (FAST_MASK & 64) p6_fast(F); else p6_up_naive(F)); } SEAM(6);
    if (IN(7)) { if (FAST_MASK & 128) p7_fast(F); else p7_down_naive(F); }
#undef RUN
#undef REPS
#undef IN
#undef SEAM
}

extern "C" void kernel_launch(void* const* d_in, const int* in_sizes, int n_in, void* d_out, int out_size, void* d_ws, size_t ws_size, hipStream_t stream) {
    static int grid = 0;
    if (grid == 0) {
        if (n_in != 21 || in_sizes[0] != M * D || out_size != M * D || ws_size < WS_END) { fprintf(stderr, "kernel_launch: unexpected shapes (n_in %d, in0 %d, out %d, ws %zu)\n", n_in, n_in > 0 ? in_sizes[0] : -1, out_size, ws_size); grid = -1; return; }
        int dev = 0, cus = 0;
        if (hipGetDevice(&dev) != hipSuccess || hipDeviceGetAttribute(&cus, hipDeviceAttributeMultiprocessorCount, dev) != hipSuccess) { grid = -1; return; }
        if (hipFuncSetAttribute((const void*)mk_fwd, hipFuncAttributeMaxDynamicSharedMemorySize, LDS_BYTES) != hipSuccess) { fprintf(stderr, "kernel_launch: hipFuncSetAttribute failed\n"); grid = -1; return; }
        int per_cu = 0;
        if (hipOccupancyMaxActiveBlocksPerMultiprocessor(&per_cu, (const void*)mk_fwd, NTHREADS, LDS_BYTES) != hipSuccess || per_cu < 1) fprintf(stderr, "kernel_launch: occupancy query says %d\n", per_cu);
        (void)hipGetLastError();
        grid = cus;
    }
    if (grid < 0) return;
    (void)hipMemsetAsync((char*)d_ws + WS_CTL, 0, CTL_ZERO_BYTES, stream);
    Args a{};
    for (int i = 0; i < 21; ++i) a.in[i] = (const float*)d_in[i];
    a.out = (float*)d_out; a.ws = (unsigned char*)d_ws;
    if (MK_SPLIT) {
        for (int p = 0; p < N_PHASES; ++p) { a.ph_lo = p; a.ph_hi = p + 1; hipLaunchKernelGGL(mk_fwd, dim3(grid), dim3(NTHREADS), LDS_BYTES, stream, a); }
    } else {
        a.ph_lo = 0; a.ph_hi = N_PHASES; hipLaunchKernelGGL(mk_fwd, dim3(grid), dim3(NTHREADS), LDS_BYTES, stream, a);
    }
}
```

```cpp
#include <hip/hip_runtime.h>
#include <cstdio>
#include <cstdint>

#ifndef FAST_MASK
#define FAST_MASK 0xFF
#endif
#ifndef REP_MASK
#define REP_MASK 0
#endif
#ifndef REP_N
#define REP_N 3
#endif
#ifndef PROBE_PHASE
#define PROBE_PHASE -1
#endif
#ifndef WT_STORES
#define WT_STORES 1
#endif
#ifndef WT_STORES_8
#define WT_STORES_8 0
#endif
#ifndef WT_STORES_GLU
#define WT_STORES_GLU 0
#endif
#ifndef EPI_REP_TEST
#define EPI_REP_TEST 0
#endif
#ifndef SSM_FUSED
#define SSM_FUSED 1
#endif
#ifndef USE_GLOBAL_BAR
#define USE_GLOBAL_BAR 0
#endif
#ifndef PROBE_SUB
#define PROBE_SUB -1
#endif
#ifndef SSMB_TMG
#define SSMB_TMG 0
#endif
#ifndef ATT_TILE_REP
#define ATT_TILE_REP 1
#endif
#ifndef ATT_EXP
#define ATT_EXP 0
#endif
#ifndef MK_SPLIT
#define MK_SPLIT 0
#endif

constexpr int M = 16384, D = 1024, AW = 512, HD = 64, NH = 8, SW = 512, SG = 16, NG = 32, SP = 64, FF = 4096, PW = 2048;
constexpr float EPS = 1e-6f;
constexpr float C2 = 0.125f * 1.4426950408889634f;
constexpr int TILE = 256, LCH = 16, NCH = TILE / LCH, NTILE = M / TILE;
constexpr int NWAVES = 8, NTHREADS = 512;

constexpr size_t MiB = 1u << 20;
constexpr size_t WS_CTL = 0, CTL_ZERO_BYTES = 32768;
constexpr size_t WS_TM = 1 * MiB;
constexpr size_t WS_WST = 2 * MiB;
constexpr size_t WS_WCR = 4 * MiB;
constexpr size_t WS_ALP = 6 * MiB;
constexpr size_t WS_ATP = 7 * MiB;
constexpr size_t WS_WIN = 8 * MiB, WS_WGLU = 12 * MiB, WS_WOUT = 13 * MiB, WS_WUP = 15 * MiB, WS_WDOWN = 23 * MiB;
constexpr size_t WS_SSQA = 31 * MiB, WS_SSQS = 31 * MiB + 512 * 1024, WS_SSQ2 = 32 * MiB;
constexpr size_t WS_STILE = 34 * MiB;
constexpr size_t WS_XLOC = 35 * MiB;
constexpr size_t WS_RN1 = 33 * MiB + 512 * 1024;
constexpr size_t WS_AGG = 33 * MiB;
constexpr size_t WS_XN = 52 * MiB;
constexpr size_t WS_H = 84 * MiB;
constexpr size_t WS_Q = 84 * MiB, WS_K = 100 * MiB, WS_V = 116 * MiB, WS_U = 132 * MiB, WS_MIX = 148 * MiB  , WS_Z = 180 * MiB;
constexpr size_t WS_END = 212 * MiB;
constexpr int CW_BAR = 4096;

constexpr int LDS_BYTES = 147456;
constexpr int MISC_OFF = 131072 + 320, ROWTAB_OFF = 131072 + 1024;

#define GAS __attribute__((address_space(1)))
#define LAS __attribute__((address_space(3)))
typedef unsigned short bf16;
typedef unsigned v4u __attribute__((ext_vector_type(4)));
typedef float f32x4 __attribute__((ext_vector_type(4)));
typedef float f32x2 __attribute__((ext_vector_type(2)));

__device__ __forceinline__ unsigned f2bf(float f) { unsigned u = __builtin_bit_cast(unsigned, f); return (u + 0x7fffu + ((u >> 16) & 1u)) >> 16; }
__device__ __forceinline__ unsigned pk2(float lo, float hi) { return f2bf(lo) | (f2bf(hi) << 16); }
__device__ __forceinline__ float bf2f(bf16 h) { return __builtin_bit_cast(float, (unsigned)h << 16); }
__device__ __forceinline__ float bflo(unsigned w) { return __builtin_bit_cast(float, w << 16); }
__device__ __forceinline__ float bfhi(unsigned w) { return __builtin_bit_cast(float, w & 0xffff0000u); }
__device__ __forceinline__ float wave_sum(float v) {
#pragma unroll
    for (int o = 1; o < 64; o <<= 1) v += __shfl_xor(v, o);
    return v;
}
__device__ __forceinline__ float dot8(v4u a, v4u b) {
    return bflo(a.x) * bflo(b.x) + bfhi(a.x) * bfhi(b.x) + bflo(a.y) * bflo(b.y) + bfhi(a.y) * bfhi(b.y)
         + bflo(a.z) * bflo(b.z) + bfhi(a.z) * bfhi(b.z) + bflo(a.w) * bflo(b.w) + bfhi(a.w) * bfhi(b.w);
}
__device__ __forceinline__ float dot_bf16(const bf16* a, const bf16* b, int K) {
    float acc = 0.f;
    for (int k = 0; k < K; k += 8) acc += dot8(*(const v4u*)(a + k), *(const v4u*)(b + k));
    return acc;
}

#define XB_TMO      128
#define XB_XCNT(j)  (256  + 64 * (j))
#define XB_XSUB(j)  (1280 + 64 * (j))
#define XB_XGEN(j)  (2304 + 64 * (j))
#define XB_TOP      3328
#define XB_TOPGEN   3392
#define XCD_BAR_WORDS 3456
#define XB_SPIN_CAP (1u << 18)
__device__ __forceinline__ unsigned xb_ld(unsigned* p)              { return __hip_atomic_load(p, __ATOMIC_RELAXED, __HIP_MEMORY_SCOPE_AGENT); }
__device__ __forceinline__ unsigned xb_add(unsigned* p, unsigned v) { return __hip_atomic_fetch_add(p, v, __ATOMIC_RELAXED, __HIP_MEMORY_SCOPE_AGENT); }
__device__ __forceinline__ unsigned xb_xcc_id() { return (unsigned)__builtin_amdgcn_s_getreg((3 << 11) | 20) & 0xFu; }
#define XB_SPIN(cond, bar) do { unsigned _sp = 0; while (cond) { __builtin_amdgcn_s_sleep(1); \
    if ((++_sp & 255u) == 0u) { if (xb_ld(&(bar)[XB_TMO])) break; if (_sp > XB_SPIN_CAP) { atomicAdd(&(bar)[XB_TMO], 1u); break; } } } } while (0)
struct XcdBarrier { unsigned* bar; unsigned x; volatile LAS unsigned* st; };
#define XB_EXIT 3456
__device__ unsigned g_barrier_words[XCD_BAR_WORDS + 64];
__device__ __forceinline__ XcdBarrier xcd_barrier_post(unsigned* bar, volatile LAS unsigned* st) {
    XcdBarrier b; b.bar = bar; b.x = xb_xcc_id(); b.st = st;
    if (threadIdx.x == 0) (void)xb_add(&bar[XB_XCNT(b.x)], 1u);
    return b;
}
__device__ __forceinline__ void xcd_barrier_complete(unsigned* bar, unsigned x, unsigned& nloc, unsigned& nx) {
    const unsigned G = gridDim.x * gridDim.y * gridDim.z;
    unsigned sum, cnt, mine, sp = 0u;
    for (;;) {
        sum = 0u; cnt = 0u; mine = 0u;
#pragma unroll
        for (unsigned j = 0; j < 16; ++j) { const unsigned c = xb_ld(&bar[XB_XCNT(j)]); sum += c; cnt += (c > 0u) ? 1u : 0u; mine = (j == x) ? c : mine; }
        if (sum == G) break;
        __builtin_amdgcn_s_sleep(1);
        if ((++sp & 255u) == 0u) { if (xb_ld(&bar[XB_TMO])) break; if (sp > XB_SPIN_CAP) { atomicAdd(&bar[XB_TMO], 1u); break; } }
    }
    nloc = mine > 0u ? mine : 1u; nx = cnt > 0u ? cnt : 1u;
}
__device__ __forceinline__ void xcd_barrier(const XcdBarrier& b) {
    asm volatile("s_waitcnt vmcnt(0)" ::: "memory");
    __syncthreads();
    if (threadIdx.x == 0) {
        unsigned* bar = b.bar;
        __builtin_amdgcn_s_waitcnt(0);
        unsigned nloc = b.st[0], nx = b.st[1];
        if (nloc == 0u) { xcd_barrier_complete(bar, b.x, nloc, nx); b.st[0] = nloc; b.st[1] = nx; }
        const unsigned old = xb_add(&bar[XB_XSUB(b.x)], 1u);
        const unsigned gen = old / nloc;
        if (old + 1u == (gen + 1u) * nloc) {
            __builtin_amdgcn_fence(__ATOMIC_RELEASE, "agent");
            asm volatile("s_waitcnt vmcnt(0)" ::: "memory");
            const unsigned og = xb_add(&bar[XB_TOP], 1u);
            const unsigned tg = og / nx;
            if (og + 1u == (tg + 1u) * nx) xb_add(&bar[XB_TOPGEN], 1u);
            else XB_SPIN(xb_ld(&bar[XB_TOPGEN]) == tg, bar);
            __builtin_amdgcn_fence(__ATOMIC_ACQUIRE, "agent");
            xb_add(&bar[XB_XGEN(b.x)], 1u);
            asm volatile("s_waitcnt vmcnt(0)" ::: "memory");
        } else {
            XB_SPIN(xb_ld(&bar[XB_XGEN(b.x)]) == gen, bar);
            __builtin_amdgcn_fence(__ATOMIC_ACQUIRE, "agent");
            asm volatile("s_waitcnt vmcnt(0)" ::: "memory");
        }
    }
    __syncthreads();
}


namespace pg8 {
#define PG8_LAS __attribute__((address_space(3)))
typedef unsigned short bf16_t;
typedef short bf16x8 __attribute__((ext_vector_type(8)));
typedef float f32x4 __attribute__((ext_vector_type(4)));
typedef unsigned u32x4 __attribute__((ext_vector_type(4)));
typedef unsigned u32x2 __attribute__((ext_vector_type(2)));
constexpr int BM = 256, BK = 64, HALF = 128, HTB = HALF * BK * 2, STAGE_BYTES = 8 * HTB, NXCD = 8, WGM = 8;
__host__ __device__ __forceinline__ int lds_byte(int r, int c) { const int st = (r >> 4) * 2 + (c >> 5), rr = r & 15, cc = c & 31, ob = rr * 64 + cc * 2; return st * 1024 + (ob ^ (((ob >> 9) & 1) << 5)); }
__host__ __device__ __forceinline__ void stage_rc(int b, int& R, int& C) { const int st = b / 1024, sb = b % 1024, swz = sb ^ (((sb >> 9) & 1) << 5); R = (st >> 1) * 16 + swz / 64; C = (st & 1) * 32 + (swz % 64) / 2; }
__host__ __device__ __forceinline__ int perm32(int rho) { const int n = rho >> 4, i = rho & 15; return 8 * (i >> 2) + 4 * n + (i & 3); }
struct Unit { int pm, pn; };
struct Gemm { const bf16_t* A; const bf16_t* Bt; int M, N, K; };
struct StaticOrder {
    int nM, nN, nwg, G, c;
    __host__ __device__ void init(int M, int N, int G_, int c_) { nM = M / BM; nN = N / BM; nwg = nM * nN; G = G_; c = c_; }
    __host__ __device__ bool next(int i, Unit& u) const {
        const long L = (long)i * G + c; if (L >= nwg) return false;
        int wgid = (int)L; { const int q = nwg / NXCD, r = nwg % NXCD, xcd = wgid % NXCD, off = wgid / NXCD; wgid = (xcd < r ? xcd * (q + 1) : r * (q + 1) + (xcd - r) * q) + off; }
        const int nig = WGM * nN, gid = wgid / nig, fm = gid * WGM, gsz = (nM - fm) < WGM ? (nM - fm) : WGM;
        u.pm = fm + ((wgid % nig) % gsz); u.pn = (wgid % nig) / gsz; return true;
    }
    __device__ __forceinline__ void a_ready(const Unit&) const {}
    __device__ __forceinline__ void done(const Unit&) const {}
};
__device__ __forceinline__ unsigned cvt_pk_bf16(float lo, float hi) { unsigned r; asm volatile("v_cvt_pk_bf16_f32 %0, %1, %2" : "=v"(r) : "v"(lo), "v"(hi)); return r; }

template <int MODE> struct BMap {
    static constexpr int BHALF_ROWS = (MODE == 2) ? 32 : 128;
    __host__ __device__ static __forceinline__ int brow(int R) { return MODE == 0 ? R : MODE == 1 ? ((R & ~31) + perm32(R & 31)) : (64 * (R >> 5) + perm32(R & 31)); }
};

template <class Epi, class Sched, bool ALIGN_EPI = true>
__device__ __forceinline__ void gemm_phase(PG8_LAS unsigned char* lds, const Gemm g, const Sched& S, const Epi& E) {
    const int tid = threadIdx.x, wid = __builtin_amdgcn_readfirstlane(tid >> 6), lane = tid & 63, wr = wid >> 2, wc = wid & 3, fr = lane & 15, fq = lane >> 4;
    const int K = g.K, nt = K / BK;
    unsigned voffA[2], voffB[2];
#pragma unroll
    for (int i = 0; i < 2; ++i) { int R, C; stage_rc(tid * 16 + i * 8192, R, C); const int Rb = BMap<Epi::MODE>::brow(R);
        voffA[i] = (unsigned)(R * K + C) * 2u; voffB[i] = (unsigned)(Rb * K + C) * 2u; }
    const size_t kstep = (size_t)(BK * 2);
    const size_t hstepA = (size_t)HALF * K * 2, hstepB = (size_t)BMap<Epi::MODE>::BHALF_ROWS * K * 2;
    const size_t tstep = (size_t)BM * K * 2;
    const unsigned ldsw = (unsigned)wid * 1024u;
    const int aoff = lds_byte(wr * 64 + fr, fq * 8), boff = lds_byte(wc * 32 + fr, fq * 8);
#define PG8_SA(b, h) (((b) * 2 + (h)) * HTB)
#define PG8_SB(b, h) ((4 + (b) * 2 + (h)) * HTB)
#define PG8_STAGE(bufoff, gbase, voff) do { _Pragma("unroll") for (int _i = 0; _i < 2; ++_i) \
        __builtin_amdgcn_global_load_lds((const unsigned*)((const char*)(gbase) + (voff)[_i]), (PG8_LAS unsigned*)(lds + (bufoff) + ldsw + _i * 8192), 16, 0, 0); } while (0)
#define PG8_LDA(dst, b, h) do { _Pragma("unroll") for (int m = 0; m < 4; ++m) _Pragma("unroll") for (int k = 0; k < 2; ++k) dst[m][k] = *(const PG8_LAS bf16x8*)(lds + PG8_SA(b, h) + aoff + m * 2048 + k * 1024); } while (0)
#define PG8_LDB(dst, b, h) do { _Pragma("unroll") for (int n = 0; n < 2; ++n) _Pragma("unroll") for (int k = 0; k < 2; ++k) dst[n][k] = *(const PG8_LAS bf16x8*)(lds + PG8_SB(b, h) + boff + n * 2048 + k * 1024); } while (0)
#define PG8_MMA(ai, bj, At, Bt) do { __builtin_amdgcn_s_setprio(1); _Pragma("unroll") for (int m = 0; m < 4; ++m) _Pragma("unroll") for (int n = 0; n < 2; ++n) _Pragma("unroll") for (int k = 0; k < 2; ++k) \
        acc[ai][bj][m][n] = __builtin_amdgcn_mfma_f32_16x16x32_bf16(Bt[n][k], At[m][k], acc[ai][bj][m][n], 0, 0, 0); __builtin_amdgcn_s_setprio(0); } while (0)
#define PG8_WAIT_V(n) asm volatile("s_waitcnt vmcnt(" #n ")" ::: "memory")
#define PG8_WAIT_L(n) asm volatile("s_waitcnt lgkmcnt(" #n ")" ::: "memory")
#define PG8_BAR __builtin_amdgcn_s_barrier()
#define PG8_SCHED __builtin_amdgcn_sched_barrier(0)
    Unit cur, nxt; int ui = 0;
    if (!S.next(0, cur)) return;
    f32x4 acc[2][2][4][2];
#pragma unroll
    for (int a = 0; a < 2; ++a)
#pragma unroll
        for (int b = 0; b < 2; ++b)
#pragma unroll
            for (int m = 0; m < 4; ++m)
#pragma unroll
                for (int n = 0; n < 2; ++n) acc[a][b][m][n] = (f32x4){0.f, 0.f, 0.f, 0.f};
    bf16x8 At[4][2], B0[2][2], B1[2][2];
    const char* cA = (const char*)g.A + (size_t)cur.pm * tstep; const char* cB = (const char*)g.Bt + (size_t)cur.pn * tstep;
    S.a_ready(cur);
    PG8_STAGE(PG8_SB(0, 0), cB, voffB); PG8_STAGE(PG8_SB(0, 1), cB + hstepB, voffB); PG8_STAGE(PG8_SA(0, 0), cA, voffA); PG8_STAGE(PG8_SA(0, 1), cA + hstepA, voffA);
    if constexpr (Epi::PRE) E.pre(lds, tid, cur);
    if (wr == 1) PG8_BAR;
    PG8_WAIT_V(2); PG8_BAR;
    PG8_STAGE(PG8_SB(1, 0), cB + kstep, voffB); PG8_STAGE(PG8_SA(1, 0), cA + kstep, voffA); PG8_STAGE(PG8_SB(1, 1), cB + hstepB + kstep, voffB);
    PG8_WAIT_V(6); PG8_BAR;
    for (;;) {
        const bool has_next = S.next(ui + 1, nxt);
        const char* nA = has_next ? (const char*)g.A + (size_t)nxt.pm * tstep : cA; const char* nB = has_next ? (const char*)g.Bt + (size_t)nxt.pn * tstep : cB;
        for (int t = 0; t < nt; t += 2) {
            const bool last = (t == nt - 2);
            const char* a1 = cA + (size_t)(t + 1) * kstep;
            const char* a2 = last ? nA : cA + (size_t)(t + 2) * kstep; const char* b2 = last ? nB : cB + (size_t)(t + 2) * kstep;
            const char* a3 = a2 + kstep; const char* b3 = b2 + kstep;
            if (last && has_next) S.a_ready(nxt);
            if constexpr (Epi::MIDK > 0) { if (t == Epi::MIDK) E.midk(acc, wr, fr, lds); }
            PG8_LDB(B0, 0, 0); PG8_LDB(B1, 0, 1); PG8_SCHED; PG8_LDA(At, 0, 0); PG8_STAGE(PG8_SA(1, 1), a1 + hstepA, voffA);
            PG8_WAIT_V(8); PG8_WAIT_L(0); PG8_BAR; PG8_MMA(0, 0, At, B0); PG8_MMA(0, 1, At, B1); PG8_BAR; PG8_SCHED;
            PG8_LDA(At, 0, 1); PG8_STAGE(PG8_SB(0, 0), b2, voffB); PG8_STAGE(PG8_SB(0, 1), b2 + hstepB, voffB); PG8_STAGE(PG8_SA(0, 0), a2, voffA);
            PG8_WAIT_V(8); PG8_WAIT_L(0); PG8_BAR; PG8_MMA(1, 0, At, B0); PG8_MMA(1, 1, At, B1); PG8_BAR; PG8_SCHED;
            PG8_LDB(B0, 1, 0); PG8_LDB(B1, 1, 1); PG8_SCHED; PG8_LDA(At, 1, 0); PG8_STAGE(PG8_SA(0, 1), a2 + hstepA, voffA);
            PG8_WAIT_V(8); PG8_WAIT_L(0); PG8_BAR; PG8_MMA(0, 0, At, B0); PG8_MMA(0, 1, At, B1); PG8_BAR; PG8_SCHED;
            PG8_LDA(At, 1, 1); PG8_STAGE(PG8_SB(1, 0), b3, voffB); PG8_STAGE(PG8_SB(1, 1), b3 + hstepB, voffB); PG8_STAGE(PG8_SA(1, 0), a3, voffA);
            PG8_WAIT_V(8); PG8_WAIT_L(0); PG8_BAR; PG8_MMA(1, 0, At, B0); PG8_MMA(1, 1, At, B1); PG8_BAR; PG8_SCHED;
        }
        if constexpr (ALIGN_EPI) { if (wr == 0) PG8_BAR; }
        E(acc, cur, wr, wc, fr, fq, lds); S.done(cur);
        if constexpr (Epi::REP_TEST) { if (EPI_REP_TEST) E(acc, cur, wr, wc, fr, fq, lds); }
        if (!has_next) break;
#pragma unroll
        for (int a = 0; a < 2; ++a)
#pragma unroll
            for (int b = 0; b < 2; ++b)
#pragma unroll
                for (int m = 0; m < 4; ++m)
#pragma unroll
                    for (int n = 0; n < 2; ++n) acc[a][b][m][n] = (f32x4){0.f, 0.f, 0.f, 0.f};
        cur = nxt; cA = nA; cB = nB; ++ui;
        if constexpr (ALIGN_EPI) { if (wr == 1) PG8_BAR; }
    }
    PG8_WAIT_V(0);
    if constexpr (!ALIGN_EPI) { if (wr == 0) PG8_BAR; }
    PG8_BAR;
#undef PG8_SA
#undef PG8_SB
#undef PG8_STAGE
#undef PG8_LDA
#undef PG8_LDB
#undef PG8_MMA
#undef PG8_WAIT_V
#undef PG8_WAIT_L
#undef PG8_BAR
#undef PG8_SCHED
}

struct EpiInProj {
    static constexpr bool REP_TEST = false, PRE = false;
    static constexpr int MODE = 2, MIDK = 0;
    bf16_t *Qb, *Kb, *Vb, *Ub; const float *gq, *gk;
    __device__ __forceinline__ void operator()(const f32x4 (&acc)[2][2][4][2], const Unit& u, int wr, int wc, int fr, int fq, PG8_LAS unsigned char*) const {
        const int seg = u.pn >> 1; bf16_t* base = seg == 0 ? Qb : seg == 1 ? Kb : seg == 2 ? Vb : Ub;
        const int col0 = (u.pn & 1) * 256 + wc * 64 + 8 * fq, row0 = u.pm * BM + wr * 64 + fr;
#if WT_STORES
        const __amdgpu_buffer_rsrc_t br = __builtin_amdgcn_make_buffer_rsrc((void*)base, (short)0, M * AW * 2, 0x00020000);
#endif
        f32x4 gv[2][2];
#pragma unroll
        for (int bj = 0; bj < 2; ++bj)
#pragma unroll
            for (int n = 0; n < 2; ++n) { gv[bj][n] = (f32x4){1.f, 1.f, 1.f, 1.f};
                if (seg == 0) gv[bj][n] = *(const f32x4*)(gq + 32 * bj + 8 * fq + 4 * n) * C2; else if (seg == 1) gv[bj][n] = *(const f32x4*)(gk + 32 * bj + 8 * fq + 4 * n); }
#pragma unroll
        for (int ai = 0; ai < 2; ++ai)
#pragma unroll
            for (int m = 0; m < 4; ++m) {
                float r = 1.f;
                if (seg < 2) { float ss = 0.f;
#pragma unroll
                    for (int bj = 0; bj < 2; ++bj)
#pragma unroll
                        for (int n = 0; n < 2; ++n) { const f32x4 x = acc[ai][bj][m][n]; ss += (x[0] * x[0] + x[1] * x[1]) + (x[2] * x[2] + x[3] * x[3]); }
                    ss += __shfl_xor(ss, 16); ss += __shfl_xor(ss, 32); r = 1.f / sqrtf(ss * (1.f / 64.f) + EPS); }
                const size_t eoff = (size_t)(row0 + ai * HALF + m * 16) * AW + col0; bf16_t* rowp = base + eoff;
#pragma unroll
                for (int bj = 0; bj < 2; ++bj) { const f32x4 v0 = acc[ai][bj][m][0] * (gv[bj][0] * r), v1 = acc[ai][bj][m][1] * (gv[bj][1] * r);
                    u32x4 w; w.x = cvt_pk_bf16(v0[0], v0[1]); w.y = cvt_pk_bf16(v0[2], v0[3]); w.z = cvt_pk_bf16(v1[0], v1[1]); w.w = cvt_pk_bf16(v1[2], v1[3]);
#if WT_STORES
                    __builtin_amdgcn_raw_buffer_store_b128(w, br, (unsigned)((eoff + bj * 32) * 2), 0, 16); (void)rowp;
#else
                    *(u32x4*)(rowp + bj * 32) = w;
#endif
                } }
    }
};
struct EpiGlu {
    static constexpr bool REP_TEST = false, PRE = false;
    static constexpr int MODE = 1, MIDK = 0;
    const bf16_t* Z; bf16_t* O; const float* bias; float* ssq;
    __device__ __forceinline__ void operator()(const f32x4 (&acc)[2][2][4][2], const Unit& u, int wr, int wc, int fr, int fq, PG8_LAS unsigned char*) const {
        const int col0 = u.pn * BM + wc * 32 + 8 * fq, row0 = u.pm * BM + wr * 64 + fr;
#if WT_STORES_GLU
        const __amdgpu_buffer_rsrc_t orr = __builtin_amdgcn_make_buffer_rsrc((void*)O, (short)0, M * D * 2 - AW * 2, 0x00020000);
#endif
        f32x4 bv[2][2];
#pragma unroll
        for (int bj = 0; bj < 2; ++bj)
#pragma unroll
            for (int n = 0; n < 2; ++n) bv[bj][n] = *(const f32x4*)(bias + col0 + bj * HALF + 4 * n);
#pragma unroll
        for (int ai = 0; ai < 2; ++ai)
#pragma unroll
            for (int m = 0; m < 4; ++m) { const int row = row0 + ai * HALF + m * 16; float ss = 0.f;
#pragma unroll
                for (int bj = 0; bj < 2; ++bj) { const u32x4 zr = *(const u32x4*)(Z + (size_t)row * SW + col0 + bj * HALF);
                    const float zf[8] = {bflo(zr.x), bfhi(zr.x), bflo(zr.y), bfhi(zr.y), bflo(zr.z), bfhi(zr.z), bflo(zr.w), bfhi(zr.w)};
                    float o[8];
#pragma unroll
                    for (int e = 0; e < 8; ++e) { const float a = acc[ai][bj][m][e >> 2][e & 3] + bv[bj][e >> 2][e & 3];
                        o[e] = zf[e] * __builtin_amdgcn_rcpf(1.f + __builtin_amdgcn_exp2f(-1.4426950408889634f * a)); ss += o[e] * o[e]; }
                    u32x4 w; w.x = cvt_pk_bf16(o[0], o[1]); w.y = cvt_pk_bf16(o[2], o[3]); w.z = cvt_pk_bf16(o[4], o[5]); w.w = cvt_pk_bf16(o[6], o[7]);
#if WT_STORES_GLU
                    __builtin_amdgcn_raw_buffer_store_b128(w, orr, (unsigned)(((size_t)row * D + col0 + bj * HALF) * 2), 0, 16);
#else
                    *(u32x4*)(O + (size_t)row * D + col0 + bj * HALF) = w;
#endif
                }
                ss += __shfl_xor(ss, 16); ss += __shfl_xor(ss, 32);
                if (fq == 0) ssq[row * 8 + u.pn * 4 + wc] = ss; }
    }
};
struct EpiOut {
    static constexpr bool REP_TEST = false, PRE = true;
    static constexpr int MODE = 0, MIDK = 8;
    const float* x; float* out; bf16_t* x1b; float* ssq2; const float *ssqa, *ssqs, *rn1;
    __device__ __forceinline__ void pre(PG8_LAS unsigned char* lds, int tid, const Unit& u) const {
        if (tid < 256) { const int row = u.pm * BM + tid; const f32x4* a = (const f32x4*)(ssqa + row * 8); const f32x4* s = (const f32x4*)(ssqs + row * 8);
            const f32x4 a0 = a[0], a1 = a[1], s0 = s[0], s1 = s[1];
            const float sa = ((a0[0] + a0[1]) + (a0[2] + a0[3])) + ((a1[0] + a1[1]) + (a1[2] + a1[3])), ss = ((s0[0] + s0[1]) + (s0[2] + s0[3])) + ((s1[0] + s1[1]) + (s1[2] + s1[3]));
            const float ra = 1.f / sqrtf(sa * (1.f / 512.f) + EPS), rs = 1.f / sqrtf(ss * (1.f / 512.f) + EPS);
            ((PG8_LAS f32x2*)(lds + ROWTAB_OFF))[tid] = (f32x2){ra / rs, rs}; ((PG8_LAS float*)(lds + ROWTAB_OFF + 2048))[tid] = rn1[row]; }
        __syncthreads();
    }
    __device__ __forceinline__ void midk(f32x4 (&acc)[2][2][4][2], int wr, int fr, PG8_LAS unsigned char* lds) const {
        const PG8_LAS f32x2* tab = (const PG8_LAS f32x2*)(lds + ROWTAB_OFF);
#pragma unroll
        for (int ai = 0; ai < 2; ++ai)
#pragma unroll
            for (int m = 0; m < 4; ++m) { const float s = tab[ai * HALF + wr * 64 + m * 16 + fr].x;
#pragma unroll
                for (int bj = 0; bj < 2; ++bj)
#pragma unroll
                    for (int n = 0; n < 2; ++n) acc[ai][bj][m][n] *= s; }
    }
    __device__ __forceinline__ void operator()(const f32x4 (&acc)[2][2][4][2], const Unit& u, int wr, int wc, int fr, int fq, PG8_LAS unsigned char* lds) const {
        const PG8_LAS f32x2* tab = (const PG8_LAS f32x2*)(lds + ROWTAB_OFF); const PG8_LAS float* tab2 = (const PG8_LAS float*)(lds + ROWTAB_OFF + 2048);
        const int col0 = u.pn * BM + wc * 32 + 4 * fq;
#pragma unroll
        for (int ai = 0; ai < 2; ++ai) {
            u32x2 xv[4][2][2];
#pragma unroll
            for (int m = 0; m < 4; ++m) { const size_t off = (size_t)(u.pm * BM + ai * HALF + wr * 64 + m * 16 + fr) * D + col0;
#pragma unroll
                for (int bj = 0; bj < 2; ++bj)
#pragma unroll
                    for (int n = 0; n < 2; ++n) xv[m][bj][n] = *(const u32x2*)(x1b + off + bj * HALF + n * 16); }
#pragma unroll
            for (int m = 0; m < 4; ++m) { const int rl = ai * HALF + wr * 64 + m * 16 + fr; const float rs = tab[rl].y, rn = tab2[rl]; const size_t off = (size_t)(u.pm * BM + rl) * D + col0; float ss = 0.f;
#pragma unroll
                for (int bj = 0; bj < 2; ++bj)
#pragma unroll
                    for (int n = 0; n < 2; ++n) { const u32x2 xw = xv[m][bj][n]; const f32x4 xf = {bflo(xw.x), bfhi(xw.x), bflo(xw.y), bfhi(xw.y)}; const f32x4 o = xf * rn + acc[ai][bj][m][n] * rs;
                        ss += (o[0] * o[0] + o[1] * o[1]) + (o[2] * o[2] + o[3] * o[3]);
                        u32x2 w; w.x = cvt_pk_bf16(o[0], o[1]); w.y = cvt_pk_bf16(o[2], o[3]);
#if WT_STORES_8
                        __hip_atomic_store((unsigned long long*)(x1b + off + bj * HALF + n * 16), ((unsigned long long)w.y << 32) | w.x, __ATOMIC_RELAXED, __HIP_MEMORY_SCOPE_AGENT);
#else
                        *(u32x2*)(x1b + off + bj * HALF + n * 16) = w;
#endif
                    }
                ss += __shfl_xor(ss, 16); ss += __shfl_xor(ss, 32);
                if (fq == 0) ssq2[(u.pm * BM + rl) * 16 + u.pn * 4 + wc] = ss; }
        }
    }
};
struct EpiUp {
    static constexpr bool REP_TEST = true, PRE = true;
    static constexpr int MODE = 1, MIDK = 0;
    bf16_t* H; const float* ssq2;
    __device__ __forceinline__ void pre(PG8_LAS unsigned char* lds, int tid, const Unit& u) const {
        if (tid < 256) { const int row = u.pm * BM + tid; const f32x4* q = (const f32x4*)(ssq2 + row * 16); float s = 0.f;
#pragma unroll
            for (int i = 0; i < 4; ++i) { const f32x4 v = q[i]; s += (v[0] + v[1]) + (v[2] + v[3]); }
            ((PG8_LAS f32x2*)(lds + ROWTAB_OFF))[tid] = (f32x2){1.f / sqrtf(s * (1.f / 1024.f) + EPS), 0.f}; }
        __syncthreads();
    }
    __device__ __forceinline__ void operator()(const f32x4 (&acc)[2][2][4][2], const Unit& u, int wr, int wc, int fr, int fq, PG8_LAS unsigned char* lds) const {
        const PG8_LAS f32x2* tab = (const PG8_LAS f32x2*)(lds + ROWTAB_OFF);
        const int col0 = u.pn * BM + wc * 32 + 8 * fq;
#if WT_STORES
        const __amdgpu_buffer_rsrc_t hr = __builtin_amdgcn_make_buffer_rsrc((void*)H, (short)0, M * FF * 2, 0x00020000);
#endif
#pragma unroll
        for (int ai = 0; ai < 2; ++ai)
#pragma unroll
            for (int m = 0; m < 4; ++m) { const int rl = ai * HALF + wr * 64 + m * 16 + fr; const float r2 = tab[rl].x; const size_t eoff = (size_t)(u.pm * BM + rl) * FF + col0; bf16_t* rowp = H + eoff;
#pragma unroll
                for (int bj = 0; bj < 2; ++bj) { f32x4 v0 = acc[ai][bj][m][0] * r2, v1 = acc[ai][bj][m][1] * r2;
#pragma unroll
                    for (int e = 0; e < 4; ++e) { const float a = fmaxf(v0[e], 0.f), b = fmaxf(v1[e], 0.f); v0[e] = a * a; v1[e] = b * b; }
                    u32x4 w; w.x = cvt_pk_bf16(v0[0], v0[1]); w.y = cvt_pk_bf16(v0[2], v0[3]); w.z = cvt_pk_bf16(v1[0], v1[1]); w.w = cvt_pk_bf16(v1[2], v1[3]);
#if WT_STORES
                    __builtin_amdgcn_raw_buffer_store_b128(w, hr, (unsigned)((eoff + bj * HALF) * 2), 0, 16); (void)rowp;
#else
                    *(u32x4*)(rowp + bj * HALF) = w;
#endif
                } }
    }
};
struct EpiDown {
    static constexpr bool REP_TEST = false, PRE = false;
    static constexpr int MODE = 0, MIDK = 0;
    float* out; const bf16_t* x1b;
    __device__ __forceinline__ void operator()(const f32x4 (&acc)[2][2][4][2], const Unit& u, int wr, int wc, int fr, int fq, PG8_LAS unsigned char*) const {
        const int col0 = u.pn * BM + wc * 32 + 4 * fq;
#pragma unroll
        for (int ai = 0; ai < 2; ++ai) {
            u32x2 xv[4][2][2];
#pragma unroll
            for (int m = 0; m < 4; ++m) { const size_t off = (size_t)(u.pm * BM + ai * HALF + wr * 64 + m * 16 + fr) * D + col0;
#pragma unroll
                for (int bj = 0; bj < 2; ++bj)
#pragma unroll
                    for (int n = 0; n < 2; ++n) xv[m][bj][n] = *(const u32x2*)(x1b + off + bj * HALF + n * 16); }
#pragma unroll
            for (int m = 0; m < 4; ++m) { const size_t off = (size_t)(u.pm * BM + ai * HALF + wr * 64 + m * 16 + fr) * D + col0;
#pragma unroll
                for (int bj = 0; bj < 2; ++bj)
#pragma unroll
                    for (int n = 0; n < 2; ++n) { const u32x2 w = xv[m][bj][n]; const f32x4 x1 = {bflo(w.x), bfhi(w.x), bflo(w.y), bfhi(w.y)};
                        *(f32x4*)(out + off + bj * HALF + n * 16) = x1 + acc[ai][bj][m][n]; } }
        }
    }
};
}


namespace att {
typedef short bf16x8 __attribute__((ext_vector_type(8)));
typedef short s16x4 __attribute__((ext_vector_type(4)));
typedef float f32x16 __attribute__((ext_vector_type(16)));
typedef __attribute__((address_space(3))) unsigned char* ldsp;
typedef short v4i16_t __attribute__((ext_vector_type(4)));
constexpr int LBUF_OFF = 131072 + 3072;
__device__ __forceinline__ int crow(int r, int hi) { return (r & 3) + 8 * (r >> 2) + 4 * hi; }
__device__ __forceinline__ unsigned cvtpk(float lo, float hi) { unsigned r; asm volatile("v_cvt_pk_bf16_f32 %0, %1, %2" : "=v"(r) : "v"(lo), "v"(hi)); return r; }
__device__ __forceinline__ s16x4 vtr(ldsp p) { return __builtin_bit_cast(s16x4, __builtin_amdgcn_ds_read_tr16_b64_v4i16((__attribute__((address_space(3))) v4i16_t*)p)); }

struct TileRegs { v4u k[4], v[4]; };
struct TileAddr { unsigned loff, kw_e, kw_o, vw, kr0, vr; int lbase; };
__device__ __forceinline__ TileAddr make_tile_addr(int lane, int d) {
    const int r = lane >> 3, ch = lane & 7, r32 = lane & 31, hi = lane >> 5; TileAddr a;
    a.loff = (unsigned)((d * r * AW + ch * 8) * 2);
    a.kw_e = (unsigned)(r * 128 + ((ch ^ (r >> 1)) << 4)); a.kw_o = a.kw_e ^ 64u;
    a.vw = (unsigned)((ch >> 2) * 2048 + r * 64 + (ch & 3) * 16);
    a.kr0 = (unsigned)(r32 * 128 + ((hi ^ ((r32 >> 1) & 7)) << 4));
    a.vr = (unsigned)(4096 + ((lane >> 4) & 1) * 32 + (lane & 3) * 8 + (4 * hi + ((lane & 15) >> 2)) * 64);
    a.lbase = r32 - 4 * hi; return a;
}
__device__ __forceinline__ void load_tile_regs(const bf16* Kg, const bf16* Vg, int tok0, int d, int lane, const TileAddr& a, TileRegs& t) {
    if (tok0 >= 0) {
        const char* kb = (const char*)(Kg + (size_t)tok0 * AW); const char* vb = (const char*)(Vg + (size_t)tok0 * AW); const size_t step = (size_t)8 * d * AW * 2;
#pragma unroll
        for (int i = 0; i < 4; ++i) { t.k[i] = *(const v4u*)(kb + i * step + a.loff); t.v[i] = *(const v4u*)(vb + i * step + a.loff); }
    } else {
#pragma unroll
        for (int i = 0; i < 4; ++i) { int tk = tok0 + d * (8 * i + (lane >> 3)); tk = tk < 0 ? 0 : tk; const size_t off = (size_t)tk * AW + (lane & 7) * 8;
            t.k[i] = *(const v4u*)(Kg + off); t.v[i] = *(const v4u*)(Vg + off); }
    }
}
__device__ __forceinline__ void store_tile_lds(ldsp buf, const TileAddr& a, const TileRegs& t) {
#pragma unroll
    for (int i = 0; i < 4; ++i) {
        *(__attribute__((address_space(3))) v4u*)(buf + i * 1024 + ((i & 1) ? a.kw_o : a.kw_e)) = t.k[i];
        *(__attribute__((address_space(3))) v4u*)(buf + 4096 + (i >> 1) * 1024 + (i & 1) * 512 + a.vw) = t.v[i]; }
}

__device__ __forceinline__ void store_tile_lds_early(ldsp buf, int lane, int d, const TileRegs& t) { const TileAddr a = make_tile_addr(lane, d); store_tile_lds(buf, a, t); }

template <int NBLK> struct WinPre { TileRegs tr; bf16x8 q[NBLK][4]; };
template <int NBLK>
__device__ __forceinline__ void window_begin(const bf16* Qg, const bf16* Kg, const bf16* Vg, int tb, int d, int lane, WinPre<NBLK>& pre) {
    const int r32 = lane & 31, hi = lane >> 5;
    load_tile_regs(Kg, Vg, tb - 128 * d, d, lane, make_tile_addr(lane, d), pre.tr);
#pragma unroll
    for (int b = 0; b < NBLK; ++b)
#pragma unroll
        for (int d0 = 0; d0 < 4; ++d0) pre.q[b][d0] = *(const bf16x8*)(Qg + (size_t)(tb + d * (32 * b + r32)) * AW + d0 * 16 + hi * 8);
}
template <int NBLK>
__device__ __forceinline__ void window(const bf16* Kg, const bf16* Vg, int tb, int d, ldsp wbuf, f32x16 (&o)[NBLK][2], float (&l)[NBLK], float nshift, int lane_in, WinPre<NBLK>& pre) {
    const int lane = lane_in;
    constexpr int NT = NBLK + 4;
    TileRegs& tr = pre.tr; bf16x8 (&q)[NBLK][4] = pre.q;
#pragma unroll
    for (int b = 0; b < NBLK; ++b)
#pragma unroll
        for (int d0 = 0; d0 < 4; ++d0) asm volatile("" : "+v"(q[b][d0]));
    f32x16 zero16;
#pragma unroll
    for (int r = 0; r < 16; ++r) zero16[r] = 0.f;
    store_tile_lds_early(wbuf, lane, d, tr);
#pragma unroll 1
    for (int TT = 0; TT < NT * ATT_TILE_REP; ++TT) {
        const int T = TT / ATT_TILE_REP; const float pscale = (TT % ATT_TILE_REP) ? 0.f : 1.f; const int tok0 = tb - 128 * d + 32 * d * T;
        int ln = lane_in; asm volatile("" : "+v"(ln));
        const TileAddr ta = make_tile_addr(ln, d); const int lane = ln, hi = lane >> 5, lbase = ta.lbase;
        const ldsp cb = wbuf + (TT & 1) * 8192;
        if (TT + 1 < NT * ATT_TILE_REP) load_tile_regs(Kg, Vg, tb - 128 * d + 32 * d * ((TT + 1) / ATT_TILE_REP), d, lane, ta, tr);
        bf16x8 kf[4];
#pragma unroll
        for (int d0 = 0; d0 < 4; ++d0) kf[d0] = *(const __attribute__((address_space(3))) bf16x8*)(cb + (ta.kr0 ^ (unsigned)(d0 << 5)));
        bf16x8 vf[2][2];
        { const ldsp vp = cb + ta.vr;
#pragma unroll
          for (int s = 0; s < 2; ++s)
#pragma unroll
            for (int dh = 0; dh < 2; ++dh) { const s16x4 lo = vtr(vp + dh * 2048 + s * 1024), hh = vtr(vp + dh * 2048 + s * 1024 + 512);
                vf[s][dh] = (bf16x8){lo[0], lo[1], lo[2], lo[3], hh[0], hh[1], hh[2], hh[3]}; } }
        const int kmin = tok0 < 0 ? (-tok0 + d - 1) / d : 0;
#pragma unroll
        for (int b = 0; b < NBLK; ++b) {
            const int tb_ = T - b;
            if (tb_ < 0 || tb_ > 4) continue;
            f32x16 S = __builtin_amdgcn_mfma_f32_32x32x16_bf16(kf[0], q[b][0], zero16, 0, 0, 0);
            S = __builtin_amdgcn_mfma_f32_32x32x16_bf16(kf[1], q[b][1], S, 0, 0, 0);
            S = __builtin_amdgcn_mfma_f32_32x32x16_bf16(kf[2], q[b][2], S, 0, 0, 0);
            S = __builtin_amdgcn_mfma_f32_32x32x16_bf16(kf[3], q[b][3], S, 0, 0, 0);
            const int dl = 128 - 32 * tb_;
            float p[16]; float ls = 0.f;
            if (kmin == 0) {
                if (tb_ >= 1 && tb_ <= 3) {
#pragma unroll
                    for (int r = 0; r < 16; ++r) { p[r] = __builtin_amdgcn_exp2f(S[r] + nshift); ls += p[r]; }
                } else if (tb_ == 0) {
#pragma unroll
                    for (int r = 0; r < 16; ++r) { const int cr = (r & 3) + 8 * (r >> 2); p[r] = (cr >= lbase) ? __builtin_amdgcn_exp2f(S[r] + nshift) : 0.f; ls += p[r]; }
                } else {
#pragma unroll
                    for (int r = 0; r < 16; ++r) { const int cr = (r & 3) + 8 * (r >> 2); p[r] = (cr <= lbase) ? __builtin_amdgcn_exp2f(S[r] + nshift) : 0.f; ls += p[r]; }
                }
            } else {
                const int x = lbase + dl;
#pragma unroll
                for (int r = 0; r < 16; ++r) { const int cr = (r & 3) + 8 * (r >> 2); const bool ok = ((unsigned)(x - cr) <= 128u) && (cr + 4 * hi >= kmin);
                    p[r] = ok ? __builtin_amdgcn_exp2f(S[r] + nshift) : 0.f; ls += p[r]; }
            }
            if (ATT_TILE_REP > 1) {
#pragma unroll
                for (int r = 0; r < 16; ++r) p[r] *= pscale;
                ls *= pscale; }
            l[b] += ls;
            bf16x8 pa[2];
#pragma unroll
            for (int s = 0; s < 2; ++s) { typedef unsigned u4 __attribute__((ext_vector_type(4)));
                u4 w; w.x = cvtpk(p[8 * s + 0], p[8 * s + 1]); w.y = cvtpk(p[8 * s + 2], p[8 * s + 3]); w.z = cvtpk(p[8 * s + 4], p[8 * s + 5]); w.w = cvtpk(p[8 * s + 6], p[8 * s + 7]);
                pa[s] = __builtin_bit_cast(bf16x8, w); }
#pragma unroll
            for (int dh = 0; dh < 2; ++dh) { o[b][dh] = __builtin_amdgcn_mfma_f32_32x32x16_bf16(pa[0], vf[0][dh], o[b][dh], 0, 0, 0);
                                             o[b][dh] = __builtin_amdgcn_mfma_f32_32x32x16_bf16(pa[1], vf[1][dh], o[b][dh], 0, 0, 0); }
        }
        if (TT + 1 < NT * ATT_TILE_REP) store_tile_lds(wbuf + ((TT + 1) & 1) * 8192, ta, tr);
    }
}

#define LDS_BARRIER() do { asm volatile("s_waitcnt lgkmcnt(0)" ::: "memory"); __builtin_amdgcn_s_barrier(); asm volatile("" ::: "memory"); } while (0)
template <int MODE>
__device__ __forceinline__ void exchange1(const f32x16 (&o)[1][2], float l, int tl0, int d, int j, f32x16 (&oc)[2][2], float (&lc)[2], ldsp lds, int w, int lane_in) {
    int lane = lane_in; asm volatile("" : "+v"(lane));
    const int r32 = lane & 31, hi = lane >> 5;
    __attribute__((address_space(3))) float* buf = (__attribute__((address_space(3))) float*)lds;
    __attribute__((address_space(3))) float* lbuf = (__attribute__((address_space(3))) float*)(lds + LBUF_OFF);
    LDS_BARRIER();
#pragma unroll
    for (int dh = 0; dh < 2; ++dh)
#pragma unroll
        for (int r = 0; r < 16; ++r) buf[(tl0 + d * crow(r, hi)) * 64 + dh * 32 + r32] = o[0][dh][r];
    { const float lt = l + __shfl_xor(l, 32); if (hi == 0) lbuf[tl0 + d * r32] = lt; }
    LDS_BARRIER();
    if (MODE == 16 || ((w >> 1) & 1) == j) {
#pragma unroll
        for (int b = 0; b < 2; ++b) {
#pragma unroll
            for (int dh = 0; dh < 2; ++dh)
#pragma unroll
                for (int r = 0; r < 16; ++r) { if (MODE == 16 && (r & 1) != j) continue; oc[b][dh][r] += buf[(64 * w + 32 * b + crow(r, hi)) * 64 + dh * 32 + r32]; }
            const float lv = lbuf[64 * w + 32 * b + r32];
            lc[b] += (MODE == 16 && (r32 & 1) != j) ? 0.f : lv; }
    }
    LDS_BARRIER();
}

__device__ __forceinline__ void unit(const bf16* Q, const bf16* K, const bf16* V, bf16* MIXo, float* SSQA, int h, int i0, float nshift, ldsp lds, int tid_in) {
    int tid = tid_in; asm volatile("" : "+v"(tid));
    const int lane = tid & 63, w = __builtin_amdgcn_readfirstlane(tid >> 6), r32 = lane & 31, hi = lane >> 5;
    const bf16* Qg = Q + h * 64; const bf16* Kg = K + h * 64; const bf16* Vg = V + h * 64;
    const ldsp wbuf = lds + w * 16384;
    f32x16 oc[2][2]; float lc[2];
    __attribute__((address_space(3))) float* xbuf = (__attribute__((address_space(3))) float*)lds;
    __attribute__((address_space(3))) float* xlbuf = (__attribute__((address_space(3))) float*)(lds + LBUF_OFF);
    WinPre<1> p1;
    { const int tlB = (w & 3) + 256 * (w >> 2);
      WinPre<2> pb; window_begin<2>(Qg, Kg, Vg, i0 + tlB, 4, lane, pb);
      float lb[2] = {0.f, 0.f};
#pragma unroll
      for (int b = 0; b < 2; ++b)
#pragma unroll
        for (int dh = 0; dh < 2; ++dh)
#pragma unroll
            for (int r = 0; r < 16; ++r) oc[b][dh][r] = 0.f;
      window<2>(Kg, Vg, i0 + tlB, 4, wbuf, oc, lb, nshift, lane, pb);
      window_begin<1>(Qg, Kg, Vg, i0 + 2 * w, 16, lane, p1);
      LDS_BARRIER();
      int lx = lane; asm volatile("" : "+v"(lx)); const int r32 = lx & 31, hi = lx >> 5;
#pragma unroll
      for (int b = 0; b < 2; ++b) {
#pragma unroll
        for (int dh = 0; dh < 2; ++dh)
#pragma unroll
            for (int r = 0; r < 16; ++r) xbuf[(tlB + 128 * b + 4 * crow(r, hi)) * 64 + dh * 32 + r32] = oc[b][dh][r];
        const float lt = lb[b] + __shfl_xor(lb[b], 32);
        if (hi == 0) xlbuf[tlB + 128 * b + 4 * r32] = lt; }
      LDS_BARRIER();
#pragma unroll
      for (int b = 0; b < 2; ++b) {
#pragma unroll
        for (int dh = 0; dh < 2; ++dh)
#pragma unroll
            for (int r = 0; r < 16; ++r) oc[b][dh][r] = xbuf[(2 * w + b + 16 * crow(r, hi)) * 64 + dh * 32 + r32];
        lc[b] = xlbuf[2 * w + b + 16 * r32]; }
      LDS_BARRIER(); }
#pragma unroll
    for (int b = 0; b < 2; ++b) { f32x16 oa[1][2] = {{oc[b][0], oc[b][1]}}; float la[1] = {0.f};
        if (b == 1) window_begin<1>(Qg, Kg, Vg, i0 + 2 * w + 1, 16, lane, p1);
        window<1>(Kg, Vg, i0 + 2 * w + b, 16, wbuf, oa, la, nshift, lane, p1);
        oc[b][0] = oa[0][0]; oc[b][1] = oa[0][1]; lc[b] += la[0] + __shfl_xor(la[0], 32); }
    WinPre<2> pc;
    window_begin<2>(Qg, Kg, Vg, i0 + 64 * w, 1, lane, pc);
    { LDS_BARRIER();
      int lx = lane; asm volatile("" : "+v"(lx)); const int r32 = lx & 31, hi = lx >> 5;
#pragma unroll
      for (int b = 0; b < 2; ++b) {
#pragma unroll
        for (int dh = 0; dh < 2; ++dh)
#pragma unroll
            for (int r = 0; r < 16; ++r) xbuf[(2 * w + b + 16 * crow(r, hi)) * 64 + dh * 32 + r32] = oc[b][dh][r];
        if (hi == 0) xlbuf[2 * w + b + 16 * r32] = lc[b]; }
      LDS_BARRIER();
#pragma unroll
      for (int b = 0; b < 2; ++b) {
#pragma unroll
        for (int dh = 0; dh < 2; ++dh)
#pragma unroll
            for (int r = 0; r < 16; ++r) oc[b][dh][r] = xbuf[(64 * w + 32 * b + crow(r, hi)) * 64 + dh * 32 + r32];
        lc[b] = xlbuf[64 * w + 32 * b + r32]; }
      LDS_BARRIER(); }
    { float lC[2] = {0.f, 0.f};
      window<2>(Kg, Vg, i0 + 64 * w, 1, wbuf, oc, lC, nshift, lane, pc);
      lc[0] += lC[0] + __shfl_xor(lC[0], 32); lc[1] += lC[1] + __shfl_xor(lC[1], 32); }
    __attribute__((address_space(3))) float* buf = (__attribute__((address_space(3))) float*)lds;
    __attribute__((address_space(3))) float* lbuf = (__attribute__((address_space(3))) float*)(lds + LBUF_OFF);
#pragma unroll
    for (int b = 0; b < 2; ++b) {
#pragma unroll
        for (int dh = 0; dh < 2; ++dh)
#pragma unroll
            for (int r = 0; r < 16; ++r) buf[(64 * w + 32 * b + crow(r, hi)) * 64 + dh * 32 + r32] = oc[b][dh][r];
        if (hi == 0) lbuf[64 * w + 32 * b + r32] = lc[b]; }
    __syncthreads();
    int tid2 = tid; asm volatile("" : "+v"(tid2));
#pragma unroll
    for (int k = 0; k < 8; ++k) { const int item = tid2 + 512 * k, tok = item >> 3, ch = item & 7;
        const f32x4 a = *(const __attribute__((address_space(3))) f32x4*)(buf + tok * 64 + ch * 8), c = *(const __attribute__((address_space(3))) f32x4*)(buf + tok * 64 + ch * 8 + 4);
        const float inv = 1.f / lbuf[tok];
        const f32x4 x = a * inv, y = c * inv;
        float ss = (x[0] * x[0] + x[1] * x[1]) + (x[2] * x[2] + x[3] * x[3]) + (y[0] * y[0] + y[1] * y[1]) + (y[2] * y[2] + y[3] * y[3]);
        v4u wv; wv.x = cvtpk(x[0], x[1]); wv.y = cvtpk(x[2], x[3]); wv.z = cvtpk(y[0], y[1]); wv.w = cvtpk(y[2], y[3]);
        *(v4u*)(MIXo + (size_t)(i0 + tok) * D + h * 64 + ch * 8) = wv;
        ss += __shfl_xor(ss, 1); ss += __shfl_xor(ss, 2); ss += __shfl_xor(ss, 4);
        if (ch == 0) SSQA[(i0 + tok) * 8 + h] = ss; }
    __syncthreads();
}
}


namespace ssm {
typedef short bf16x8 __attribute__((ext_vector_type(8)));
typedef __attribute__((address_space(3))) unsigned char* ldsp;
__device__ __forceinline__ void load_u_frags(const bf16* U, int tile, int g, int lane, bf16x8 (&a)[8]) {
    const int chunk = lane & 15, kq = lane >> 4;
    const bf16* p = U + (size_t)(tile * TILE + 16 * chunk + (kq >> 1)) * SW + 16 * g + 8 * (kq & 1);
#pragma unroll
    for (int ks = 0; ks < 8; ++ks) a[ks] = *(const bf16x8*)(p + (size_t)(2 * ks) * SW);
}
__device__ __forceinline__ void table_load(const bf16* W, int tid, v4u (&v)[8]) {
#pragma unroll
    for (int i = 0; i < 8; ++i) v[i] = *(const v4u*)(W + ((size_t)(tid + NTHREADS * i) << 3));
}
__device__ __forceinline__ void table_store(const v4u (&v)[8], int cpr_log2, ldsp lds, int tid) {
#pragma unroll
    for (int i = 0; i < 8; ++i) { const int id = tid + NTHREADS * i, row = id >> cpr_log2, ch = id & ((1 << cpr_log2) - 1);
        *(__attribute__((address_space(3))) v4u*)(lds + (row << (cpr_log2 + 4)) + ((ch ^ (row & 15)) << 4)) = v[i]; }
}
constexpr int TM_LDS = 131072 + 1024, PART_LDS = TM_LDS + 8704;
__device__ __forceinline__ void phaseA(const unsigned char* ws_, int tile, int g, ldsp lds, ldsp scr, int tid) {
    unsigned char* ws = const_cast<unsigned char*>(ws_);
    const int lane = tid & 63;
    v4u tv[8]; table_load((const bf16*)(ws + WS_WST) + (size_t)g * 128 * 256, tid, tv);
    bf16x8 a[8]; load_u_frags((const bf16*)(ws + WS_U), tile, g, lane, a);
    const f32x2 al = ((const f32x2*)(ws + WS_ALP))[(g * 16 + 1) * 64 + lane];
    table_store(tv, 5, lds, tid);
    __syncthreads();
    const int n = lane & 15, kq = lane >> 4;
    __attribute__((address_space(3))) float* s = (__attribute__((address_space(3))) float*)scr;
#pragma unroll
    for (int nt = 0; nt < 8; ++nt) { f32x4 acc = {0.f, 0.f, 0.f, 0.f};
#pragma unroll
        for (int ks = 0; ks < 8; ++ks) { const bf16x8 b = *(const __attribute__((address_space(3))) bf16x8*)(lds + (16 * nt + n) * 512 + (((4 * ks + kq) ^ n) << 4));
            acc = __builtin_amdgcn_mfma_f32_16x16x32_bf16(a[ks], b, acc, 0, 0, 0); }
#pragma unroll
        for (int e = 0; e < 4; ++e) s[(4 * kq + e) * 128 + 16 * nt + n] = acc[e]; }
    asm volatile("s_waitcnt lgkmcnt(0)" ::: "memory");
    const int p = lane;
    float* XLOC = (float*)(ws + WS_XLOC) + ((size_t)(tile * NG + g) * 16) * 128;
    float xr = 0.f, xi = 0.f;
#pragma unroll
    for (int j = 0; j < NCH; ++j) { XLOC[j * 128 + p] = xr; XLOC[j * 128 + 64 + p] = xi;
        const float sr = s[j * 128 + p], si = s[j * 128 + 64 + p];
        const float nr = al.x * xr - al.y * xi + sr, ni = al.x * xi + al.y * xr + si; xr = nr; xi = ni; }
    float* ST = (float*)(ws + WS_STILE) + (size_t)(tile * NG + g) * 128; ST[p] = xr; ST[64 + p] = xi;
    asm volatile("s_waitcnt lgkmcnt(0)" ::: "memory");
}
__device__ __forceinline__ void prefix_terms(const f32x2* ATP, const float* ST, int pw0, int pstep, int j0, int jstep, int cnt, float& tr, float& ti) {
    f32x2 a[8]; float sr[8], si[8];
#pragma unroll
    for (int i = 0; i < 8; ++i) { const int ic = i < cnt ? i : 0;
        const int pw = pw0 - ic * pstep; a[i] = ATP[(pw < 0 ? 0 : pw) * 64]; sr[i] = ST[(size_t)(j0 + ic * jstep) * NG * 128]; si[i] = ST[(size_t)(j0 + ic * jstep) * NG * 128 + 64];
        if (i >= cnt) a[i] = (f32x2){0.f, 0.f}; }
#pragma unroll
    for (int i = 0; i < 8; ++i) { tr += a[i].x * sr[i] - a[i].y * si[i]; ti += a[i].x * si[i] + a[i].y * sr[i]; }
}
#define SUBP(k) do { if (PROBE_SUB == (k)) ta = __builtin_amdgcn_s_memrealtime(); if (PROBE_SUB + 1 == (k)) tb = __builtin_amdgcn_s_memrealtime(); } while (0)
__device__ __forceinline__ void phaseB(const unsigned char* ws_, int base, int g, ldsp lds, ldsp scr, int tid, unsigned long long& ta, unsigned long long& tb) {
    SUBP(0);
    unsigned char* ws = const_cast<unsigned char*>(ws_);
    const int lane = tid & 63, w = __builtin_amdgcn_readfirstlane(tid >> 6), tile = base + w;
    v4u tv[8]; table_load((const bf16*)(ws + WS_WCR) + (size_t)g * 256 * 128, tid, tv);
    v4u tmv[2]; { const v4u* TMg = (const v4u*)((const bf16*)(ws + WS_TM) + (size_t)g * 17 * 256); tmv[0] = TMg[tid]; tmv[1] = TMg[tid < 32 ? 512 + tid : tid]; }
    bf16x8 au[8]; load_u_frags((const bf16*)(ws + WS_U), tile, g, lane, au);
    const int p = lane;
    const f32x2* ATP = (const f32x2*)(ws + WS_ATP) + (size_t)g * 64 * 64 + p; const float* ST = (const float*)(ws + WS_STILE) + (size_t)g * 128 + p;
    const float* XLOC = (const float*)(ws + WS_XLOC) + ((size_t)(tile * NG + g) * 16) * 128;
    float xlr[NCH], xli[NCH];
#pragma unroll
    for (int j = 0; j < NCH; ++j) { xlr[j] = XLOC[j * 128 + p]; xli[j] = XLOC[j * 128 + 64 + p]; }
    const f32x2 al1 = ((const f32x2*)(ws + WS_ALP))[(g * 16 + 1) * 64 + p];
    f32x2 oa[8]; float osr[8], osi[8];
#pragma unroll
    for (int i = 0; i < 8; ++i) { const int ic = i < w ? i : 0; const int pw = w - 1 - ic;
        oa[i] = ATP[(pw < 0 ? 0 : pw) * 64]; osr[i] = ST[(size_t)(base + ic) * NG * 128]; osi[i] = ST[(size_t)(base + ic) * NG * 128 + 64];
        if (i >= w) oa[i] = (f32x2){0.f, 0.f}; }
    const f32x2 aw = ATP[w * 64];
    { float pr = 0.f, pi = 0.f; const int cnt = base > w ? (base - w + 7) / 8 : 0;
      prefix_terms(ATP, ST, base - 1 - w, 8, w, 8, cnt, pr, pi);
      __attribute__((address_space(3))) float* part = (__attribute__((address_space(3))) float*)(lds + PART_LDS) + w * 128; part[p] = pr; part[64 + p] = pi; }
    SUBP(1);
    table_store(tv, 4, lds, tid);
    { __attribute__((address_space(3))) v4u* tml = (__attribute__((address_space(3))) v4u*)(lds + TM_LDS); tml[tid] = tmv[0]; if (tid < 32) tml[512 + tid] = tmv[1]; }
    __syncthreads();
    SUBP(2);
    { float br = 0.f, bi = 0.f;
      const __attribute__((address_space(3))) float* part = (const __attribute__((address_space(3))) float*)(lds + PART_LDS);
#pragma unroll
      for (int k = 0; k < 8; ++k) { br += part[k * 128 + p]; bi += part[k * 128 + 64 + p]; }
      float tr = aw.x * br - aw.y * bi, ti = aw.x * bi + aw.y * br;
#pragma unroll
      for (int i = 0; i < 8; ++i) { tr += oa[i].x * osr[i] - oa[i].y * osi[i]; ti += oa[i].x * osi[i] + oa[i].y * osr[i]; }
      __attribute__((address_space(3))) bf16* xp = (__attribute__((address_space(3))) bf16*)scr;
      float cr = tr, ci = ti;
#pragma unroll
      for (int j = 0; j < NCH; ++j) { xp[j * 128 + p] = (bf16)f2bf(xlr[j] + cr); xp[j * 128 + 64 + p] = (bf16)f2bf(xli[j] + ci);
          const float nr = al1.x * cr - al1.y * ci, ni = al1.x * ci + al1.y * cr; cr = nr; ci = ni; } }
    asm volatile("s_waitcnt lgkmcnt(0)" ::: "memory");
    const int c = lane & 15, kq = lane >> 4;
    bf16x8 ax[4];
#pragma unroll
    for (int ks = 0; ks < 4; ++ks) ax[ks] = *(const __attribute__((address_space(3))) bf16x8*)(scr + c * 256 + (32 * ks + 8 * kq) * 2);
    asm volatile("s_waitcnt lgkmcnt(0)" ::: "memory");
    SUBP(3);
    const ldsp TMl = lds + TM_LDS + c * 32 + 16 * (kq & 1);
    const bf16* TMgl = (const bf16*)(ws + WS_TM) + (size_t)g * 17 * 256 + c * 16 + 8 * (kq & 1); (void)TMgl; (void)TMl;
    __attribute__((address_space(3))) bf16* zt = (__attribute__((address_space(3))) bf16*)scr;
#pragma unroll
    for (int t = 0; t < 16; ++t) { f32x4 acc = {0.f, 0.f, 0.f, 0.f};
#pragma unroll
        for (int ks = 0; ks < 4; ++ks) { const bf16x8 b = *(const __attribute__((address_space(3))) bf16x8*)(lds + (16 * t + c) * 256 + (((4 * ks + kq) ^ c) << 4));
            acc = __builtin_amdgcn_mfma_f32_16x16x32_bf16(ax[ks], b, acc, 0, 0, 0); }
#pragma unroll
        for (int ks = 0; ks <= t / 2; ++ks) { const int li = t - 2 * ks - (kq >> 1) + 1;
#if SSMB_TMG
            const bf16x8 b = *(const bf16x8*)(TMgl + (li < 0 ? 0 : li) * 256);
#else
            const bf16x8 b = *(const __attribute__((address_space(3))) bf16x8*)(TMl + (li < 0 ? 0 : li) * 512);
#endif
            acc = __builtin_amdgcn_mfma_f32_16x16x32_bf16(au[ks], b, acc, 0, 0, 0); }
#pragma unroll
        for (int e = 0; e < 4; ++e) { const float y = acc[e]; const float u2 = 1.5957691216057308f * (y + 0.044715f * y * y * y);
            const float z = y * __builtin_amdgcn_rcpf(1.f + __builtin_amdgcn_exp2f(-1.4426950408889634f * u2));
            zt[(16 * (4 * kq + e) + t) * 16 + c] = (bf16)f2bf(z); } }
    asm volatile("s_waitcnt lgkmcnt(0)" ::: "memory");
    SUBP(4);
    bf16* Z = (bf16*)(ws + WS_Z) + (size_t)tile * TILE * SW + 16 * g;
#pragma unroll
    for (int k = 0; k < 8; ++k) { const int item = lane + 64 * k, tok = item >> 1, hf = item & 1;
        const v4u v = *(const __attribute__((address_space(3))) v4u*)(scr + tok * 32 + hf * 16);
        *(v4u*)(Z + (size_t)tok * SW + 8 * hf) = v; }
    asm volatile("s_waitcnt lgkmcnt(0)" ::: "memory");
    if (PROBE_SUB >= 0) asm volatile("s_waitcnt vmcnt(0)" ::: "memory");
    SUBP(5);
}

constexpr unsigned AGG_TAG = 1u;
constexpr int XB_LDS = PART_LDS + 4096;
__device__ __forceinline__ void fused(const unsigned char* ws_, int b, int g, ldsp lds, ldsp scr, int tid) {
    unsigned char* ws = const_cast<unsigned char*>(ws_);
    const int lane = tid & 63, w = __builtin_amdgcn_readfirstlane(tid >> 6), tile = 8 * b + w, p = lane;
    typedef __attribute__((address_space(1))) unsigned long long gu64;
    gu64* AGG = (gu64*)(ws + WS_AGG) + (size_t)g * 8 * 128;
    const f32x2* ATP = (const f32x2*)(ws + WS_ATP) + (size_t)g * 64 * 64 + p;
    v4u tv[8]; table_load((const bf16*)(ws + WS_WST) + (size_t)g * 128 * 256, tid, tv);
    v4u tv2[8]; table_load((const bf16*)(ws + WS_WCR) + (size_t)g * 256 * 128, tid, tv2);
    v4u tmv[2]; { const v4u* TMg = (const v4u*)((const bf16*)(ws + WS_TM) + (size_t)g * 17 * 256); tmv[0] = TMg[tid]; tmv[1] = TMg[tid < 32 ? 512 + tid : tid]; }
    bf16x8 au[8]; load_u_frags((const bf16*)(ws + WS_U), tile, g, lane, au);
    const f32x2 al1 = ((const f32x2*)(ws + WS_ALP))[(g * 16 + 1) * 64 + p];
    f32x2 atw[8];
#pragma unroll
    for (int i = 0; i < 8; ++i) atw[i] = ATP[i * 64];
    table_store(tv, 5, lds, tid);
    { __attribute__((address_space(3))) v4u* tml = (__attribute__((address_space(3))) v4u*)(lds + TM_LDS); tml[tid] = tmv[0]; if (tid < 32) tml[512 + tid] = tmv[1]; }
    __syncthreads();
    const int n = lane & 15, kq = lane >> 4;
    { __attribute__((address_space(3))) float* s = (__attribute__((address_space(3))) float*)scr;
#pragma unroll
      for (int nt = 0; nt < 8; ++nt) { f32x4 acc = {0.f, 0.f, 0.f, 0.f};
#pragma unroll
        for (int ks = 0; ks < 8; ++ks) { const bf16x8 bb = *(const __attribute__((address_space(3))) bf16x8*)(lds + (16 * nt + n) * 512 + (((4 * ks + kq) ^ n) << 4));
            acc = __builtin_amdgcn_mfma_f32_16x16x32_bf16(au[ks], bb, acc, 0, 0, 0); }
#pragma unroll
        for (int e = 0; e < 4; ++e) s[(4 * kq + e) * 128 + 16 * nt + n] = acc[e]; } }
    asm volatile("s_waitcnt lgkmcnt(0)" ::: "memory");
    float xlr[NCH], xli[NCH];
    { const __attribute__((address_space(3))) float* s = (const __attribute__((address_space(3))) float*)scr; float xr = 0.f, xi = 0.f;
#pragma unroll
      for (int j = 0; j < NCH; ++j) { xlr[j] = xr; xli[j] = xi; const float sr = s[j * 128 + p], si = s[j * 128 + 64 + p];
          const float nr = al1.x * xr - al1.y * xi + sr, ni = al1.x * xi + al1.y * xr + si; xr = nr; xi = ni; }
      __attribute__((address_space(3))) float* st = (__attribute__((address_space(3))) float*)(lds + PART_LDS) + w * 128; st[p] = xr; st[64 + p] = xi; }
    __syncthreads();
    const __attribute__((address_space(3))) float* stl = (const __attribute__((address_space(3))) float*)(lds + PART_LDS);
    table_store(tv2, 4, lds, tid);
    if (w == 0) {
        float er = 0.f, ei = 0.f;
#pragma unroll
        for (int i = 0; i < 8; ++i) { const float sr = stl[i * 128 + p], si = stl[i * 128 + 64 + p]; const f32x2 a = atw[7 - i]; er += a.x * sr - a.y * si; ei += a.x * si + a.y * sr; }
        __hip_atomic_store(AGG + b * 128 + p, ((unsigned long long)AGG_TAG << 32) | __builtin_bit_cast(unsigned, er), __ATOMIC_RELAXED, __HIP_MEMORY_SCOPE_AGENT);
        __hip_atomic_store(AGG + b * 128 + 64 + p, ((unsigned long long)AGG_TAG << 32) | __builtin_bit_cast(unsigned, ei), __ATOMIC_RELAXED, __HIP_MEMORY_SCOPE_AGENT);
        float br = 0.f, bi = 0.f;
        if (b > 0) {
            unsigned long long vr[8], vi[8];
            for (unsigned spins = 0;; ++spins) { bool ok = true;
#pragma unroll
                for (int k = 0; k < 7; ++k) { const int kc = k < b ? k : 0;
                    vr[k] = __hip_atomic_load(AGG + kc * 128 + p, __ATOMIC_RELAXED, __HIP_MEMORY_SCOPE_AGENT); vi[k] = __hip_atomic_load(AGG + kc * 128 + 64 + p, __ATOMIC_RELAXED, __HIP_MEMORY_SCOPE_AGENT);
                    ok &= ((unsigned)(vr[k] >> 32) == AGG_TAG) & ((unsigned)(vi[k] >> 32) == AGG_TAG); }
                if (__all(ok) || spins > (1u << 16)) break;
                __builtin_amdgcn_s_sleep(2); }
            const f32x2 a8 = ATP[8 * 64];
            float pr = 1.f, pi = 0.f;
#pragma unroll
            for (int k = 6; k >= 0; --k) { if (k < b) { const float sr = __builtin_bit_cast(float, (unsigned)vr[k]), si = __builtin_bit_cast(float, (unsigned)vi[k]);
                    br += pr * sr - pi * si; bi += pr * si + pi * sr; const float nr = pr * a8.x - pi * a8.y, ni = pr * a8.y + pi * a8.x; pr = nr; pi = ni; } }
        }
        __attribute__((address_space(3))) float* xb = (__attribute__((address_space(3))) float*)(lds + XB_LDS); xb[p] = br; xb[64 + p] = bi;
    }
    __syncthreads();
    { const __attribute__((address_space(3))) float* xb = (const __attribute__((address_space(3))) float*)(lds + XB_LDS);
      const float br = xb[p], bi = xb[64 + p];
      float tr = atw[w & 7].x * br - atw[w & 7].y * bi, ti = atw[w & 7].x * bi + atw[w & 7].y * br;
#pragma unroll
      for (int i = 0; i < 7; ++i) { if (i < w) { const float sr = stl[i * 128 + p], si = stl[i * 128 + 64 + p]; const f32x2 a = atw[(w - 1 - i) & 7]; tr += a.x * sr - a.y * si; ti += a.x * si + a.y * sr; } }
      __attribute__((address_space(3))) bf16* xp = (__attribute__((address_space(3))) bf16*)scr;
      float cr = tr, ci = ti;
#pragma unroll
      for (int j = 0; j < NCH; ++j) { xp[j * 128 + p] = (bf16)f2bf(xlr[j] + cr); xp[j * 128 + 64 + p] = (bf16)f2bf(xli[j] + ci);
          const float nr = al1.x * cr - al1.y * ci, ni = al1.x * ci + al1.y * cr; cr = nr; ci = ni; } }
    asm volatile("s_waitcnt lgkmcnt(0)" ::: "memory");
    const int c = lane & 15;
    bf16x8 ax[4];
#pragma unroll
    for (int ks = 0; ks < 4; ++ks) ax[ks] = *(const __attribute__((address_space(3))) bf16x8*)(scr + c * 256 + (32 * ks + 8 * kq) * 2);
    asm volatile("s_waitcnt lgkmcnt(0)" ::: "memory");
    const ldsp TMl = lds + TM_LDS + c * 32 + 16 * (kq & 1);
    __attribute__((address_space(3))) bf16* zt = (__attribute__((address_space(3))) bf16*)scr;
#pragma unroll
    for (int t = 0; t < 16; ++t) { f32x4 acc = {0.f, 0.f, 0.f, 0.f};
#pragma unroll
        for (int ks = 0; ks < 4; ++ks) { const bf16x8 bb = *(const __attribute__((address_space(3))) bf16x8*)(lds + (16 * t + c) * 256 + (((4 * ks + kq) ^ c) << 4));
            acc = __builtin_amdgcn_mfma_f32_16x16x32_bf16(ax[ks], bb, acc, 0, 0, 0); }
#pragma unroll
        for (int ks = 0; ks <= t / 2; ++ks) { const int li = t - 2 * ks - (kq >> 1) + 1;
            const bf16x8 bb = *(const __attribute__((address_space(3))) bf16x8*)(TMl + (li < 0 ? 0 : li) * 512);
            acc = __builtin_amdgcn_mfma_f32_16x16x32_bf16(au[ks], bb, acc, 0, 0, 0); }
#pragma unroll
        for (int e = 0; e < 4; ++e) { const float y = acc[e]; const float u2 = 1.5957691216057308f * (y + 0.044715f * y * y * y);
            const float z = y * __builtin_amdgcn_rcpf(1.f + __builtin_amdgcn_exp2f(-1.4426950408889634f * u2));
            zt[(16 * (4 * kq + e) + t) * 16 + c] = (bf16)f2bf(z); } }
    asm volatile("s_waitcnt lgkmcnt(0)" ::: "memory");
    bf16* Z = (bf16*)(ws + WS_Z) + (size_t)tile * TILE * SW + 16 * g;
#pragma unroll
    for (int k = 0; k < 8; ++k) { const int item = lane + 64 * k, tok = item >> 1, hf = item & 1;
        const v4u v = *(const __attribute__((address_space(3))) v4u*)(scr + tok * 32 + hf * 16);
        *(v4u*)(Z + (size_t)tok * SW + 8 * hf) = v; }
    asm volatile("s_waitcnt lgkmcnt(0)" ::: "memory");
}
}

struct Args { const float* in[21]; float* out; unsigned char* ws; int ph_lo, ph_hi; };
struct Frame {
    LAS unsigned char* lds;
    int tid, lane, wave, G, bid;
    const float* in[21]; float* out; unsigned char* ws;
};
#define P_X 0
#define P_G1 1
#define P_WIN 2
#define P_GQ 3
#define P_GK 4
#define P_ARE 5
#define P_AIM 6
#define P_LDT 7
#define P_BRE 8
#define P_BIM 9
#define P_CRE 10
#define P_CIM 11
#define P_DSK 12
#define P_GLUW 13
#define P_GLUB 14
#define P_GA 15
#define P_GS 16
#define P_WOUT 17
#define P_G2 18
#define P_WUP 19
#define P_WDOWN 20

__device__ __forceinline__ void p0_transpose_item(const float* W, int K, int N, bf16* WT, const float* g_lo, const float* g_hi, int split, LAS float* scr, int item, int lane) {
    const int nblk = N / 32, kb = item / nblk, nb = item % nblk, k0 = 64 * kb, n0 = 32 * nb;
    f32x4 v[8];
#pragma unroll
    for (int i = 0; i < 8; ++i) v[i] = *(const GAS f32x4*)(W + (size_t)(k0 + 8 * i + (lane >> 3)) * N + n0 + 4 * (lane & 7));
#pragma unroll
    for (int i = 0; i < 8; ++i) { const int kk = 8 * i + (lane >> 3), k = k0 + kk;
        const float g = g_lo ? (k < split ? g_lo[k] : g_hi[k - split]) : 1.f;
        LAS float* d = scr + kk * 33 + 4 * (lane & 7);
        d[0] = v[i][0] * g; d[1] = v[i][1] * g; d[2] = v[i][2] * g; d[3] = v[i][3] * g; }
    asm volatile("s_waitcnt lgkmcnt(0)" ::: "memory");
    const int c = lane & 7;
#pragma unroll
    for (int j = 0; j < 4; ++j) { const int n = (lane >> 3) + 8 * j; const LAS float* s = scr + (8 * c) * 33 + n;
        v4u o; o.x = pk2(s[0 * 33], s[1 * 33]); o.y = pk2(s[2 * 33], s[3 * 33]); o.z = pk2(s[4 * 33], s[5 * 33]); o.w = pk2(s[6 * 33], s[7 * 33]);
        *(GAS v4u*)(WT + (size_t)(n0 + n) * K + k0 + 8 * c) = o; }
    asm volatile("s_waitcnt lgkmcnt(0)" ::: "memory");
}
__device__ __forceinline__ void rms_row_to_bf16(const float* xrow, bf16* orow, int lane) {
    const GAS f32x4* xr = (const GAS f32x4*)xrow + lane;
    f32x4 v[4]; float s = 0.f;
#pragma unroll
    for (int j = 0; j < 4; ++j) { v[j] = xr[64 * j]; s += (v[j].x * v[j].x + v[j].y * v[j].y) + (v[j].z * v[j].z + v[j].w * v[j].w); }
    const float rstd = 1.f / sqrtf(wave_sum(s) * (1.f / D) + EPS);
    GAS unsigned long long* o8 = (GAS unsigned long long*)orow + lane;
#pragma unroll
    for (int j = 0; j < 4; ++j) o8[64 * j] = (unsigned long long)pk2(v[j].x * rstd, v[j].y * rstd) | ((unsigned long long)pk2(v[j].z * rstd, v[j].w * rstd) << 32);
}
struct cd { double re, im; };
__device__ __forceinline__ cd cmul(cd a, cd b) { return cd{a.re * b.re - a.im * b.im, a.re * b.im + a.im * b.re}; }
struct cf { float re, im; };
__device__ __forceinline__ cf cmulf(cf a, cf b) { return cf{a.re * b.re - a.im * b.im, a.re * b.im + a.im * b.re}; }
__device__ __forceinline__ cf cpow_n(double lr, double li, double dt, double n) {
    const double ex = n * lr * dt; double rev = n * li * dt * 0.15915494309189535; rev -= rint(rev);
    float sn, cs; sincosf((float)(rev * 6.283185307179586), &sn, &cs); const float mag = expf((float)ex);
    return cf{mag * cs, mag * sn};
}
constexpr int NPART = 8;
__device__ __forceinline__ void p0_ssm_tables(Frame& F, int g, int part) {
    cf* apow = (cf*)(__attribute__((address_space(3))) cf*)(F.lds);
    cf* bbar = apow + 17 * 64;
    cf* cc = bbar + 64 * 16;
    cf* coef = cc + 16 * 64;
    const float* a_re = F.in[P_ARE] + g * 64; const float* a_im = F.in[P_AIM] + g * 64;
    const double dt = exp((double)F.in[P_LDT][g]);
    const int tid = F.tid;
    for (int i = tid; i < 17 * 64; i += NTHREADS) { const int j = i >> 6, p = i & 63; apow[i] = cpow_n(a_re[p], a_im[p], dt, (double)j); }
    for (int i = tid; i < 16 * 64; i += NTHREADS) cc[i] = cf{F.in[P_CRE][g * 1024 + i], F.in[P_CIM][g * 1024 + i]};
    if (tid < 64) { const int p = tid; const double lr = a_re[p], li = a_im[p];
        const double mag = exp(lr * dt); double sn, cs; sincos(li * dt, &sn, &cs); const double abr = mag * cs, abi = mag * sn;
        const double den = lr * lr + li * li, nr = abr - 1.0, ni = abi; coef[p] = cf{(float)((nr * lr + ni * li) / den), (float)((ni * lr - nr * li) / den)}; }
    __syncthreads();
    for (int i = tid; i < 64 * 16; i += NTHREADS) { const int p = i >> 4, c = i & 15;
        bbar[i] = cmulf(coef[p], cf{F.in[P_BRE][(g * 64 + p) * 16 + c], F.in[P_BIM][(g * 64 + p) * 16 + c]}); }
    __syncthreads();
    bf16* TM = (bf16*)(F.ws + WS_TM) + (size_t)g * 17 * 256;
    bf16* WST = (bf16*)(F.ws + WS_WST) + (size_t)g * 128 * 256;
    bf16* WCR = (bf16*)(F.ws + WS_WCR) + (size_t)g * 256 * 128;
    f32x2* ALP = (f32x2*)(F.ws + WS_ALP) + (size_t)g * 16 * 64;
    f32x2* ATP = (f32x2*)(F.ws + WS_ATP) + (size_t)g * 64 * 64;
    const int t0 = tid + NTHREADS * part, tstride = NTHREADS * NPART;
    for (int i = t0; i < 17 * 256; i += tstride) { const int l1 = i >> 8, c = (i >> 4) & 15, c2 = i & 15; float s = 0.f;
        if (l1 > 0) { const int lag = l1 - 1;
            for (int p = 0; p < 64; ++p) { const cf t = cmulf(cmulf(cc[c * 64 + p], apow[lag * 64 + p]), bbar[p * 16 + c2]); s += t.re; }
            if (lag == 0 && c == c2) s += F.in[P_DSK][g * 16 + c]; }
        TM[i] = (bf16)f2bf(s); }
    for (int i = t0; i < 128 * 256; i += tstride) { const int q = i >> 8, k = i & 255, s = k >> 4, c2 = k & 15, p = q & 63;
        const cf w = cmulf(apow[(15 - s) * 64 + p], bbar[p * 16 + c2]); WST[i] = (bf16)f2bf(q < 64 ? w.re : w.im); }
    for (int i = t0; i < 256 * 128; i += tstride) { const int n = i >> 7, q = i & 127, t = n >> 4, c = n & 15, p = q & 63;
        const cf w = cmulf(cc[c * 64 + p], apow[(t + 1) * 64 + p]); WCR[i] = (bf16)f2bf(q < 64 ? w.re : -w.im); }
    for (int i = t0; i < 16 * 64; i += tstride) { const int j = i >> 6, p = i & 63; const cf w = cpow_n(a_re[p], a_im[p], dt, 16.0 * j); ALP[i] = (f32x2){w.re, w.im}; }
    for (int i = t0; i < 64 * 64; i += tstride) { const int m = i >> 6, p = i & 63; const cf w = cpow_n(a_re[p], a_im[p], dt, 256.0 * m); ATP[i] = (f32x2){w.re, w.im}; }
    __syncthreads();
}
constexpr int XR = 8;
__device__ __forceinline__ void xn_load(Frame& F, int m0, int NGW, f32x4 (&v)[XR][4]) {
#pragma unroll
    for (int r = 0; r < XR; ++r) { const int m = (m0 + r * NGW) < M ? (m0 + r * NGW) : m0; const GAS f32x4* xr = (const GAS f32x4*)(F.in[P_X] + (size_t)m * D) + F.lane;
#pragma unroll
        for (int j = 0; j < 4; ++j) v[r][j] = xr[64 * j]; }
}
__device__ __forceinline__ void xn_finish(Frame& F, int m0, int NGW, const f32x4 (&v)[XR][4]) {
#pragma unroll
    for (int r = 0; r < XR; ++r) { float s = 0.f;
#pragma unroll
        for (int j = 0; j < 4; ++j) s += (v[r][j].x * v[r][j].x + v[r][j].y * v[r][j].y) + (v[r][j].z * v[r][j].z + v[r][j].w * v[r][j].w);
        const float ms = sqrtf(wave_sum(s) * (1.f / D) + EPS), q = 1.f / ms; const int m = m0 + r * NGW;
        if (m < M) { if (F.lane == 0) ((float*)(F.ws + WS_RN1))[m] = ms;
            GAS unsigned long long* o8 = (GAS unsigned long long*)((bf16*)(F.ws + WS_XN) + (size_t)m * D) + F.lane;
#pragma unroll
            for (int j = 0; j < 4; ++j) o8[64 * j] = (unsigned long long)pk2(v[r][j].x * q, v[r][j].y * q) | ((unsigned long long)pk2(v[r][j].z * q, v[r][j].w * q) << 32); } }
}
__device__ __forceinline__ void p0_prologue(Frame& F) {
    const int gw = F.bid * NWAVES + F.wave, NGW = F.G * NWAVES;
    f32x4 xv[XR][4]; xn_load(F, gw, NGW, xv);
    { typedef GAS unsigned long long gu64; gu64* AGG = (gu64*)(F.ws + WS_AGG);
      for (int i = F.bid * NTHREADS + F.tid; i < NG * 8 * 128; i += F.G * NTHREADS) __hip_atomic_store(AGG + i, 0ull, __ATOMIC_RELAXED, __HIP_MEMORY_SCOPE_AGENT); }
    for (int gp = F.bid; gp < NG * NPART; gp += F.G) p0_ssm_tables(F, gp & 31, gp >> 5);
    xn_finish(F, gw, NGW, xv);
    LAS float* scr = (LAS float*)(F.lds + F.wave * 16384);
    constexpr int I_IN = (D / 64) * (PW / 32), I_GLU = (SW / 64) * (SW / 32);
    constexpr int NITEMS = I_IN + I_GLU;
    for (int it = gw; it < NITEMS; it += NGW) {
        int r = it;
        if (r < I_IN) { p0_transpose_item(F.in[P_WIN], D, PW, (bf16*)(F.ws + WS_WIN), F.in[P_G1], F.in[P_G1], D, scr, r, F.lane); continue; } r -= I_IN;
        p0_transpose_item(F.in[P_GLUW], SW, SW, (bf16*)(F.ws + WS_WGLU), nullptr, nullptr, 0, scr, r, F.lane);
    }
    for (int m0 = gw + XR * NGW; m0 < M; m0 += XR * NGW) { xn_load(F, m0, NGW, xv); xn_finish(F, m0, NGW, xv); }
}

__device__ __forceinline__ void p4_late_weights(Frame& F, int gw, int ngw) {
    LAS float* scr = (LAS float*)(F.lds + F.wave * 16384);
    constexpr int I_OUT = (D / 64) * (D / 32), I_UP = (D / 64) * (FF / 32), I_DOWN = (FF / 64) * (D / 32);
    for (int it = gw; it < I_OUT + I_UP + I_DOWN; it += ngw) {
        int r = it;
        if (r < I_OUT) { p0_transpose_item(F.in[P_WOUT], D, D, (bf16*)(F.ws + WS_WOUT), F.in[P_GA], F.in[P_GS], AW, scr, r, F.lane); continue; } r -= I_OUT;
        if (r < I_UP) { p0_transpose_item(F.in[P_WUP], D, FF, (bf16*)(F.ws + WS_WUP), F.in[P_G2], F.in[P_G2], D, scr, r, F.lane); continue; } r -= I_UP;
        p0_transpose_item(F.in[P_WDOWN], FF, D, (bf16*)(F.ws + WS_WDOWN), nullptr, nullptr, 0, scr, r, F.lane);
    }
}

__device__ __forceinline__ float att_shift(Frame& F) {
    float mq = 0.f, mk = 0.f;
    for (int i = 0; i < 64; ++i) { mq = fmaxf(mq, fabsf(F.in[P_GQ][i])); mk = fmaxf(mk, fabsf(F.in[P_GK][i])); }
    return 64.f * mq * mk * C2 * 1.0001f;
}
__device__ __forceinline__ void p1_naive(Frame& F) {
    const bf16* XN = (const bf16*)(F.ws + WS_XN); const bf16* W = (const bf16*)(F.ws + WS_WIN);
    const size_t total = (size_t)M * PW, nthr = (size_t)F.G * NTHREADS;
    for (size_t idx = (size_t)F.bid * NTHREADS + F.tid; idx < total; idx += nthr) {
        const int m = (int)(idx / PW), n = (int)(idx % PW);
        const float acc = dot_bf16(XN + (size_t)m * D, W + (size_t)n * D, D);
        const int seg = n >> 9, c = n & 511;
        float v = acc;
        if (seg < 2) { const float ss = wave_sum(acc * acc); const float r = 1.f / sqrtf(ss * (1.f / 64.f) + EPS);
            v = acc * r * (seg == 0 ? F.in[P_GQ][c & 63] * C2 : F.in[P_GK][c & 63]); }
        bf16* dst = (bf16*)(F.ws + (seg == 0 ? WS_Q : seg == 1 ? WS_K : seg == 2 ? WS_V : WS_U));
        dst[(size_t)m * AW + c] = (bf16)f2bf(v);
    }
}
__device__ __forceinline__ void p2_attn_naive(Frame& F) {
    const bf16* Q = (const bf16*)(F.ws + WS_Q); const bf16* K = (const bf16*)(F.ws + WS_K); const bf16* V = (const bf16*)(F.ws + WS_V);
    bf16* ATT = (bf16*)(F.ws + WS_MIX); float* SSQA = (float*)(F.ws + WS_SSQA);
    const float shift = att_shift(F);
    const int gw = F.bid * NWAVES + F.wave, NGW = F.G * NWAVES;
    for (int it = gw; it < M * NH; it += NGW) {
        const int m = it >> 3, h = it & 7; const int col = h * 64 + F.lane;
        const float q = bf2f(Q[(size_t)m * AW + col]);
        float o = 0.f, l = 0.f;
        for (int di = 0; di < 3; ++di) { const int d = di == 0 ? 1 : di == 1 ? 4 : 16;
            for (int mm = 0; mm <= 128; ++mm) { const int j = m - d * mm; if (j < 0) break;
                const float s = wave_sum(q * bf2f(K[(size_t)j * AW + col]));
                const float p = exp2f(s - shift);
                l += p; o += p * bf2f(V[(size_t)j * AW + col]); } }
        const float r = o / l;
        ATT[(size_t)m * D + col] = (bf16)f2bf(r);
        const float ss = wave_sum(r * r);
        if (F.lane == 0) SSQA[m * 8 + h] = ss;
    }
}
__device__ __forceinline__ void p2_ssmA_naive(Frame& F) {
    const bf16* U = (const bf16*)(F.ws + WS_U);
    const size_t nthr = (size_t)F.G * NTHREADS;
    for (size_t idx = (size_t)F.bid * NTHREADS + F.tid; idx < (size_t)NTILE * NG * 64; idx += nthr) {
        const int p = (int)(idx & 63), g = (int)((idx >> 6) & 31), tile = (int)(idx >> 11);
        const bf16* Wr = (const bf16*)(F.ws + WS_WST) + ((size_t)g * 128 + p) * 256; const bf16* Wi = Wr + 64 * 256;
        const f32x2 al = ((const f32x2*)(F.ws + WS_ALP))[(g * 16 + 1) * 64 + p];
        float* XLOC = (float*)(F.ws + WS_XLOC) + ((size_t)(tile * NG + g) * 16) * 128;
        float xr = 0.f, xi = 0.f;
        for (int j = 0; j < NCH; ++j) {
            XLOC[j * 128 + p] = xr; XLOC[j * 128 + 64 + p] = xi;
            float sr = 0.f, si = 0.f;
            for (int k = 0; k < 256; ++k) { const float u = bf2f(U[(size_t)(tile * TILE + j * LCH + (k >> 4)) * SW + g * 16 + (k & 15)]); sr += u * bf2f(Wr[k]); si += u * bf2f(Wi[k]); }
            const float nr = al.x * xr - al.y * xi + sr, ni = al.x * xi + al.y * xr + si; xr = nr; xi = ni;
        }
        float* ST = (float*)(F.ws + WS_STILE) + (size_t)(tile * NG + g) * 128; ST[p] = xr; ST[64 + p] = xi;
    }
}
__device__ __forceinline__ float gelu_tanh(float y) { const float t = tanhf(0.7978845608028654f * (y + 0.044715f * y * y * y)); return 0.5f * y * (1.f + t); }
__device__ __forceinline__ void p3_ssmB_naive(Frame& F) {
    const bf16* U = (const bf16*)(F.ws + WS_U); bf16* Z = (bf16*)(F.ws + WS_Z);
    LAS float* xp = (LAS float*)F.lds;
    for (int pair = F.bid; pair < NTILE * NG; pair += F.G) {
        const int tile = pair >> 5, g = pair & 31;
        if (F.tid < 64) { const int p = F.tid; float tr = 0.f, ti = 0.f;
            const f32x2* ATP = (const f32x2*)(F.ws + WS_ATP) + (size_t)g * 64 * 64;
            for (int j = 0; j < tile; ++j) { const f32x2 a = ATP[(tile - 1 - j) * 64 + p]; const float* ST = (const float*)(F.ws + WS_STILE) + (size_t)(j * NG + g) * 128;
                const float sr = ST[p], si = ST[64 + p]; tr += a.x * sr - a.y * si; ti += a.x * si + a.y * sr; }
            const float* XLOC = (const float*)(F.ws + WS_XLOC) + ((size_t)(tile * NG + g) * 16) * 128;
            const f32x2* ALP = (const f32x2*)(F.ws + WS_ALP) + (size_t)g * 16 * 64;
            for (int j = 0; j < NCH; ++j) { const f32x2 a = ALP[j * 64 + p];
                xp[j * 128 + p] = XLOC[j * 128 + p] + a.x * tr - a.y * ti; xp[j * 128 + 64 + p] = XLOC[j * 128 + 64 + p] + a.x * ti + a.y * tr; } }
        __syncthreads();
        const bf16* TM = (const bf16*)(F.ws + WS_TM) + (size_t)g * 17 * 256; const bf16* WCR = (const bf16*)(F.ws + WS_WCR) + (size_t)g * 256 * 128;
        for (int o = F.tid; o < TILE * 16; o += NTHREADS) { const int tl = o >> 4, c = o & 15, j = tl >> 4, t = tl & 15; float y = 0.f;
            for (int s = 0; s <= t; ++s) { const bf16* tm = TM + ((t - s + 1) * 16 + c) * 16; const bf16* u = U + (size_t)(tile * TILE + j * LCH + s) * SW + g * 16;
                for (int c2 = 0; c2 < 16; ++c2) y += bf2f(tm[c2]) * bf2f(u[c2]); }
            const bf16* wc = WCR + (size_t)(t * 16 + c) * 128;
            for (int q = 0; q < 128; ++q) y += xp[j * 128 + q] * bf2f(wc[q]);
            Z[(size_t)(tile * TILE + tl) * SW + g * 16 + c] = (bf16)f2bf(gelu_tanh(y)); }
        __syncthreads();
    }
}
__device__ __forceinline__ void p4_glu_naive(Frame& F) {
    const bf16* Z = (const bf16*)(F.ws + WS_Z); const bf16* W = (const bf16*)(F.ws + WS_WGLU); bf16* O = (bf16*)(F.ws + WS_MIX) + AW; float* SSQS = (float*)(F.ws + WS_SSQS);
    const size_t total = (size_t)M * SW, nthr = (size_t)F.G * NTHREADS;
    for (size_t idx = (size_t)F.bid * NTHREADS + F.tid; idx < total; idx += nthr) {
        const int m = (int)(idx >> 9), n = (int)(idx & 511);
        const float acc = dot_bf16(Z + (size_t)m * SW, W + (size_t)n * SW, SW) + F.in[P_GLUB][n];
        const float z = bf2f(Z[(size_t)m * SW + n]); const float o = z / (1.f + expf(-acc));
        O[(size_t)m * D + n] = (bf16)f2bf(o);
        const float ss = wave_sum(o * o); if (F.lane == 0) SSQS[m * 8 + (n >> 6)] = ss;
    }
}
__device__ __forceinline__ void p5_out_naive(Frame& F) {
    const bf16* A = (const bf16*)(F.ws + WS_MIX); const bf16* S = (const bf16*)(F.ws + WS_MIX) + AW; const bf16* W = (const bf16*)(F.ws + WS_WOUT);
    const float* SSQA = (const float*)(F.ws + WS_SSQA); const float* SSQS = (const float*)(F.ws + WS_SSQS); float* SSQ2 = (float*)(F.ws + WS_SSQ2); bf16* X1B = (bf16*)(F.ws + WS_XN);
    const size_t total = (size_t)M * D, nthr = (size_t)F.G * NTHREADS;
    for (size_t idx = (size_t)F.bid * NTHREADS + F.tid; idx < total; idx += nthr) {
        const int m = (int)(idx >> 10), n = (int)(idx & 1023);
        float sa = 0.f, ss = 0.f;
        for (int i = 0; i < 8; ++i) { sa += SSQA[m * 8 + i]; ss += SSQS[m * 8 + i]; }
        const float ra = 1.f / sqrtf(sa * (1.f / 512.f) + EPS), rs = 1.f / sqrtf(ss * (1.f / 512.f) + EPS);
        const float accA = dot_bf16(A + (size_t)m * D, W + (size_t)n * D, AW), accS = dot_bf16(S + (size_t)m * D, W + (size_t)n * D + AW, SW);
        const float x1 = F.in[P_X][(size_t)m * D + n] + ra * accA + rs * accS;
        F.out[(size_t)m * D + n] = x1; X1B[(size_t)m * D + n] = (bf16)f2bf(x1);
        const float q = wave_sum(x1 * x1); if (F.lane == 0) SSQ2[m * 16 + (n >> 6)] = q;
    }
}
__device__ __forceinline__ void p6_up_naive(Frame& F) {
    const bf16* A = (const bf16*)(F.ws + WS_XN); const bf16* W = (const bf16*)(F.ws + WS_WUP); const float* SSQ2 = (const float*)(F.ws + WS_SSQ2); bf16* H = (bf16*)(F.ws + WS_H);
    const size_t total = (size_t)M * FF, nthr = (size_t)F.G * NTHREADS;
    for (size_t idx = (size_t)F.bid * NTHREADS + F.tid; idx < total; idx += nthr) {
        const int m = (int)(idx >> 12), n = (int)(idx & 4095);
        float s2 = 0.f; for (int i = 0; i < 16; ++i) s2 += SSQ2[m * 16 + i];
        const float r2 = 1.f / sqrtf(s2 * (1.f / 1024.f) + EPS);
        const float a = fmaxf(r2 * dot_bf16(A + (size_t)m * D, W + (size_t)n * D, D), 0.f);
        H[(size_t)m * FF + n] = (bf16)f2bf(a * a);
    }
}
__device__ __forceinline__ void p7_down_naive(Frame& F) {
    const bf16* H = (const bf16*)(F.ws + WS_H); const bf16* W = (const bf16*)(F.ws + WS_WDOWN);
    const size_t total = (size_t)M * D, nthr = (size_t)F.G * NTHREADS;
    for (size_t idx = (size_t)F.bid * NTHREADS + F.tid; idx < total; idx += nthr) {
        const int m = (int)(idx >> 10), n = (int)(idx & 1023);
        F.out[(size_t)m * D + n] += dot_bf16(H + (size_t)m * FF, W + (size_t)n * FF, FF);
    }
}


__device__ __forceinline__ int wg_pm(int c) { return 8 * (c & 7) + ((c >> 3) & 7); }
__device__ __forceinline__ void p1_fast(Frame& F) {
    pg8::Gemm g{(const bf16*)(F.ws + WS_XN), (const bf16*)(F.ws + WS_WIN), M, PW, D}; pg8::StaticOrder S; S.init(M, PW, F.G, F.bid);
    pg8::EpiInProj E{(bf16*)(F.ws + WS_Q), (bf16*)(F.ws + WS_K), (bf16*)(F.ws + WS_V), (bf16*)(F.ws + WS_U), F.in[P_GQ], F.in[P_GK]};
    pg8::gemm_phase<pg8::EpiInProj, pg8::StaticOrder, true>(F.lds, g, S, E);
}
__device__ __forceinline__ void p4_fast(Frame& F) {
    constexpr int GLU_UNITS = (M / 256) * (SW / 256);
    if (F.G > GLU_UNITS) { if (F.bid >= GLU_UNITS) { p4_late_weights(F, (F.bid - GLU_UNITS) * NWAVES + F.wave, (F.G - GLU_UNITS) * NWAVES); return; } }
    else p4_late_weights(F, F.bid * NWAVES + F.wave, F.G * NWAVES);
    pg8::Gemm g{(const bf16*)(F.ws + WS_Z), (const bf16*)(F.ws + WS_WGLU), M, SW, SW}; pg8::StaticOrder S; S.init(M, SW, F.G, F.bid);
    pg8::EpiGlu E{(const bf16*)(F.ws + WS_Z), (bf16*)(F.ws + WS_MIX) + AW, F.in[P_GLUB], (float*)(F.ws + WS_SSQS)};
    pg8::gemm_phase<pg8::EpiGlu, pg8::StaticOrder, true>(F.lds, g, S, E);
}
__device__ __forceinline__ void p5_fast(Frame& F) {
    pg8::Gemm g{(const bf16*)(F.ws + WS_MIX), (const bf16*)(F.ws + WS_WOUT), M, D, D}; pg8::StaticOrder S; S.init(M, D, F.G, F.bid);
    pg8::EpiOut E{F.in[P_X], F.out, (bf16*)(F.ws + WS_XN), (float*)(F.ws + WS_SSQ2), (const float*)(F.ws + WS_SSQA), (const float*)(F.ws + WS_SSQS), (const float*)(F.ws + WS_RN1)};
    pg8::gemm_phase<pg8::EpiOut, pg8::StaticOrder, true>(F.lds, g, S, E);
}
__device__ __forceinline__ void p6_fast(Frame& F) {
    pg8::Gemm g{(const bf16*)(F.ws + WS_XN), (const bf16*)(F.ws + WS_WUP), M, FF, D}; pg8::StaticOrder S; S.init(M, FF, F.G, F.bid);
    pg8::EpiUp E{(bf16*)(F.ws + WS_H), (const float*)(F.ws + WS_SSQ2)};
    pg8::gemm_phase<pg8::EpiUp, pg8::StaticOrder, true>(F.lds, g, S, E);
}
__device__ __forceinline__ void p7_fast(Frame& F) {
    pg8::Gemm g{(const bf16*)(F.ws + WS_H), (const bf16*)(F.ws + WS_WDOWN), M, D, FF}; pg8::StaticOrder S; S.init(M, D, F.G, F.bid);
    pg8::EpiDown E{F.out, (const bf16*)(F.ws + WS_XN)};
    pg8::gemm_phase<pg8::EpiDown, pg8::StaticOrder, true>(F.lds, g, S, E);
}


__device__ __forceinline__ void p2_attn_fast(Frame& F) {
    float mq = fabsf(F.in[P_GQ][F.lane]), mk = fabsf(F.in[P_GK][F.lane]);
#pragma unroll
    for (int o = 1; o < 64; o <<= 1) { mq = fmaxf(mq, __shfl_xor(mq, o)); mk = fmaxf(mk, __shfl_xor(mk, o)); }
    const float nshift = -(64.f * mq * mk * C2 * 1.0001f);
    for (int u = F.bid; u < NH * (M / 512); u += F.G)
        att::unit((const bf16*)(F.ws + WS_Q), (const bf16*)(F.ws + WS_K), (const bf16*)(F.ws + WS_V), (bf16*)(F.ws + WS_MIX), (float*)(F.ws + WS_SSQA), u & 7, (u >> 3) * 512, nshift, F.lds, F.tid);
}


__device__ __forceinline__ void p2_ssmA_fast(Frame& F) {
    for (int batch = F.bid; batch < NTILE * NG / NWAVES; batch += F.G) { const int g = batch & 31, tile = (batch >> 5) * 8 + F.wave;
        __syncthreads();
        ssm::phaseA(F.ws, tile, g, F.lds, F.lds + 65536 + F.wave * 8192, F.tid); }
    __syncthreads();
}
__device__ __forceinline__ void p3_ssmB_fast(Frame& F, unsigned long long& ta, unsigned long long& tb) {
    for (int batch = F.bid; batch < NTILE * NG / NWAVES; batch += F.G) { const int g = batch & 31, base = (batch >> 5) * 8;
        __syncthreads();
        ssm::phaseB(F.ws, base, g, F.lds, F.lds + 65536 + F.wave * 8192, F.tid, ta, tb); }
    __syncthreads();
}

__device__ __forceinline__ void p2_ssm_fused(Frame& F) {
    for (int batch = F.bid; batch < NTILE * NG / NWAVES; batch += F.G) { const int g = batch & 31, b = batch >> 5;
        __syncthreads();
        ssm::fused(F.ws, b, g, F.lds, F.lds + 65536 + F.wave * 8192, F.tid); }
    __syncthreads();
}

constexpr int N_PHASES = 8;
__global__ void __launch_bounds__(NTHREADS, 2) mk_fwd(Args args) {
    extern __shared__ __attribute__((aligned(16))) unsigned char lds_raw[];
    Frame F;
    F.lds = (LAS unsigned char*)lds_raw;
    F.tid = threadIdx.x; F.lane = F.tid & 63; F.wave = __builtin_amdgcn_readfirstlane(F.tid >> 6);
    F.G = gridDim.x; F.bid = blockIdx.x;
#pragma unroll
    for (int i = 0; i < 21; ++i) F.in[i] = args.in[i];
    F.out = args.out; F.ws = args.ws;
    volatile LAS unsigned* MISC = (volatile LAS unsigned*)(F.lds + MISC_OFF);
    for (int u = F.tid; u < 64; u += NTHREADS) MISC[u] = 0u;
    __syncthreads();
    unsigned* const barw = USE_GLOBAL_BAR ? g_barrier_words : (unsigned*)(F.ws + WS_CTL) + CW_BAR;
    XcdBarrier bar; bar.bar = barw; bar.x = 0; bar.st = nullptr;
    if (!MK_SPLIT) bar = xcd_barrier_post(barw, MISC + 8);
    const int lo = args.ph_lo, hi = args.ph_hi;
#define IN(k) (lo <= (k) && (k) < hi)
#define SEAM(k) do { if (IN(k) && IN((k) + 1)) xcd_barrier(bar); } while (0)
#define REPS(bit) (((REP_MASK >> (bit)) & 1) ? REP_N : 1)
#define RUN(bit, body) do { _Pragma("unroll 1") for (int rep_ = 0; rep_ < REPS(bit); ++rep_) { if (rep_) xcd_barrier(bar); body; } } while (0)
#define STAMP_A(k) do { if (PROBE_PHASE == (k)) t_a = __builtin_amdgcn_s_memrealtime(); if (PROBE_PHASE == 30 + (k)) { t_a = __builtin_amdgcn_s_memrealtime(); c_a = __builtin_amdgcn_s_memtime(); } } while (0)
#define STAMP_B(k) do { if (PROBE_PHASE == (k)) t_b = __builtin_amdgcn_s_memrealtime(); if (PROBE_PHASE == 30 + (k)) { t_b = __builtin_amdgcn_s_memrealtime(); c_b = __builtin_amdgcn_s_memtime(); } } while (0)
    unsigned long long t_a = 0, t_b = 0, c_a = 0, c_b = 0;
    if (PROBE_PHASE == 9) t_a = __builtin_amdgcn_s_memrealtime();
    STAMP_A(0); if (IN(0)) { RUN(0, p0_prologue(F)); } SEAM(0); STAMP_B(0);
    STAMP_A(1); if (IN(1)) { RUN(1, if (FAST_MASK & 2) p1_fast(F); else p1_naive(F)); } SEAM(1); STAMP_B(1);
    STAMP_A(2); if (IN(2)) { RUN(8, if (SSM_FUSED) p2_ssm_fused(F); else if (FAST_MASK & 1) p2_ssmA_fast(F); else p2_ssmA_naive(F)); STAMP_A(8); RUN(2, if (FAST_MASK & 4) p2_attn_fast(F); else p2_attn_naive(F)); } SEAM(2); STAMP_B(2); STAMP_B(8);
    if (!SSM_FUSED) { STAMP_A(3); if (IN(3)) { RUN(3, if (FAST_MASK & 8) p3_ssmB_fast(F, t_a, t_b); else p3_ssmB_naive(F)); } SEAM(3); STAMP_B(3); }
    STAMP_A(4); STAMP_A(14); if (IN(4)) { RUN(4, if (FAST_MASK & 16) p4_fast(F); else p4_glu_naive(F)); } if (PROBE_PHASE == 14) asm volatile("s_waitcnt vmcnt(0)" ::: "memory"); STAMP_B(14); SEAM(4); STAMP_B(4);
    STAMP_A(5); if (IN(5)) { RUN(5, if (FAST_MASK & 32) p5_fast(F); else p5_out_naive(F)); } SEAM(5); STAMP_B(5);
    STAMP_A(6); if (IN(6)) { RUN(6, if (FAST_MASK & 64) p6_fast(F); else p6_up_naive(F)); } SEAM(6); STAMP_B(6);
    STAMP_A(7); if (IN(7)) { if (FAST_MASK & 128) p7_fast(F); else p7_down_naive(F); }
    if (PROBE_PHASE >= 0 || PROBE_SUB >= 0) { asm volatile("s_waitcnt vmcnt(0)" ::: "memory"); if (PROBE_PHASE == 7 || PROBE_PHASE == 9) t_b = __builtin_amdgcn_s_memrealtime(); if (PROBE_PHASE == 37) { t_b = __builtin_amdgcn_s_memrealtime(); c_b = __builtin_amdgcn_s_memtime(); }
        if (PROBE_PHASE >= 30) { if (F.bid == 0 && F.tid == 0) F.out[0] += 5.f * floorf((float)(c_b - c_a) / (float)(t_b - t_a) * 2.f + 0.5f); }
        else if (F.bid == 0 && F.tid == 0) F.out[0] += (PROBE_SUB >= 0) ? 10.f * floorf((float)(t_b - t_a) * 0.005f + 0.5f) : (PROBE_PHASE == 9) ? floorf((float)(t_b - t_a) * 0.001f + 0.5f) : 2.f * floorf((float)(t_b - t_a) * 0.005f + 0.5f); }
#undef STAMP_A
#undef STAMP_B
    if (USE_GLOBAL_BAR && !MK_SPLIT) {
        __syncthreads();
        if (F.tid == 0) { const unsigned old = xb_add(&barw[XB_EXIT], 1u); MISC[16] = (old + 1u == (unsigned)F.G) ? 1u : 0u; }
        __syncthreads();
        if (MISC[16]) { for (int i = F.tid; i < XCD_BAR_WORDS + 64; i += NTHREADS) __hip_atomic_store(&barw[i], 0u, __ATOMIC_RELAXED, __HIP_MEMORY_SCOPE_AGENT); }
    }
#undef RUN
#undef REPS
#undef IN
#undef SEAM
}

extern "C" void kernel_launch(void* const* d_in, const int* in_sizes, int n_in, void* d_out, int out_size, void* d_ws, size_t ws_size, hipStream_t stream) {
    static int grid = 0;
    if (grid == 0) {
        if (n_in != 21 || in_sizes[0] != M * D || out_size != M * D || ws_size < WS_END) { fprintf(stderr, "kernel_launch: unexpected shapes (n_in %d, in0 %d, out %d, ws %zu)\n", n_in, n_in > 0 ? in_sizes[0] : -1, out_size, ws_size); grid = -1; return; }
        int dev = 0, cus = 0;
        if (hipGetDevice(&dev) != hipSuccess || hipDeviceGetAttribute(&cus, hipDeviceAttributeMultiprocessorCount, dev) != hipSuccess) { grid = -1; return; }
        if (hipFuncSetAttribute((const void*)mk_fwd, hipFuncAttributeMaxDynamicSharedMemorySize, LDS_BYTES) != hipSuccess) { fprintf(stderr, "kernel_launch: hipFuncSetAttribute failed\n"); grid = -1; return; }
        int per_cu = 0;
        if (hipOccupancyMaxActiveBlocksPerMultiprocessor(&per_cu, (const void*)mk_fwd, NTHREADS, LDS_BYTES) != hipSuccess || per_cu < 1) fprintf(stderr, "kernel_launch: occupancy query says %d\n", per_cu);
        (void)hipGetLastError();
        grid = cus;
    }
    if (grid < 0) return;
    if (!USE_GLOBAL_BAR) (void)hipMemsetAsync((char*)d_ws + WS_CTL, 0, CTL_ZERO_BYTES, stream);
    Args a{};
    for (int i = 0; i < 21; ++i) a.in[i] = (const float*)d_in[i];
    a.out = (float*)d_out; a.ws = (unsigned char*)d_ws;
    if (MK_SPLIT) {
        for (int p = 0; p < N_PHASES; ++p) { a.ph_lo = p; a.ph_hi = p + 1; hipLaunchKernelGGL(mk_fwd, dim3(grid), dim3(NTHREADS), LDS_BYTES, stream, a); }
    } else {
        a.ph_lo = 0; a.ph_hi = N_PHASES; hipLaunchKernelGGL(mk_fwd, dim3(grid), dim3(NTHREADS), LDS_BYTES, stream, a);
    }
}
```

```cpp
#include <hip/hip_runtime.h>
#include <cstdio>
#include <cstdint>

#ifndef FAST_MASK
#define FAST_MASK 0xFF
#endif
#ifndef REP_MASK
#define REP_MASK 0
#endif
#ifndef REP_N
#define REP_N 3
#endif
#ifndef PROBE_PHASE
#define PROBE_PHASE -1
#endif
#ifndef WT_STORES
#define WT_STORES 1
#endif
#ifndef WT_STORES_8
#define WT_STORES_8 0
#endif
#ifndef WT_STORES_GLU
#define WT_STORES_GLU 0
#endif
#ifndef EPI_REP_TEST
#define EPI_REP_TEST 0
#endif
#ifndef SSM_FUSED
#define SSM_FUSED 1
#endif
#ifndef USE_GLOBAL_BAR
#define USE_GLOBAL_BAR 1
#endif
#ifndef PROBE_SUB
#define PROBE_SUB -1
#endif
#ifndef SSMB_TMG
#define SSMB_TMG 0
#endif
#ifndef ATT_NOSHIFT
#define ATT_NOSHIFT 0
#endif
#ifndef ATT_UNROLL1
#define ATT_UNROLL1 1
#endif
#ifndef ATT_UNROLL2
#define ATT_UNROLL2 1
#endif
#ifndef ATT_TILE_REP
#define ATT_TILE_REP 1
#endif
#ifndef ATT_EXP
#define ATT_EXP 0
#endif
#ifndef MK_SPLIT
#define MK_SPLIT 0
#endif

constexpr int M = 16384, D = 1024, AW = 512, HD = 64, NH = 8, SW = 512, SG = 16, NG = 32, SP = 64, FF = 4096, PW = 2048;
constexpr float EPS = 1e-6f;
constexpr float C2 = 0.125f * 1.4426950408889634f;
constexpr int TILE = 256, LCH = 16, NCH = TILE / LCH, NTILE = M / TILE;
constexpr int NWAVES = 8, NTHREADS = 512;

constexpr size_t MiB = 1u << 20;
constexpr size_t WS_CTL = 0, CTL_ZERO_BYTES = 32768;
constexpr size_t WS_TM = 1 * MiB;
constexpr size_t WS_WST = 2 * MiB;
constexpr size_t WS_WCR = 4 * MiB;
constexpr size_t WS_ALP = 6 * MiB;
constexpr size_t WS_ATP = 7 * MiB;
constexpr size_t WS_WIN = 8 * MiB, WS_WGLU = 12 * MiB, WS_WOUT = 13 * MiB, WS_WUP = 15 * MiB, WS_WDOWN = 23 * MiB;
constexpr size_t WS_SSQA = 31 * MiB, WS_SSQS = 31 * MiB + 512 * 1024, WS_SSQ2 = 32 * MiB;
constexpr size_t WS_STILE = 34 * MiB;
constexpr size_t WS_XLOC = 35 * MiB;
constexpr size_t WS_RN1 = 33 * MiB + 512 * 1024;
constexpr size_t WS_AGG = 33 * MiB;
constexpr size_t WS_XN = 52 * MiB;
constexpr size_t WS_H = 84 * MiB;
constexpr size_t WS_Q = 84 * MiB, WS_K = 100 * MiB, WS_V = 116 * MiB, WS_U = 132 * MiB, WS_MIX = 148 * MiB  , WS_Z = 180 * MiB;
constexpr size_t WS_END = 212 * MiB;
constexpr int CW_BAR = 4096;

constexpr int LDS_BYTES = 147456;
constexpr int MISC_OFF = 131072 + 320, ROWTAB_OFF = 131072 + 1024;

#define GAS __attribute__((address_space(1)))
#define LAS __attribute__((address_space(3)))
typedef unsigned short bf16;
typedef unsigned v4u __attribute__((ext_vector_type(4)));
typedef float f32x4 __attribute__((ext_vector_type(4)));
typedef float f32x2 __attribute__((ext_vector_type(2)));

__device__ __forceinline__ unsigned f2bf(float f) { unsigned u = __builtin_bit_cast(unsigned, f); return (u + 0x7fffu + ((u >> 16) & 1u)) >> 16; }
__device__ __forceinline__ unsigned pk2(float lo, float hi) { return f2bf(lo) | (f2bf(hi) << 16); }
__device__ __forceinline__ float bf2f(bf16 h) { return __builtin_bit_cast(float, (unsigned)h << 16); }
__device__ __forceinline__ float bflo(unsigned w) { return __builtin_bit_cast(float, w << 16); }
__device__ __forceinline__ float bfhi(unsigned w) { return __builtin_bit_cast(float, w & 0xffff0000u); }
__device__ __forceinline__ float wave_sum(float v) {
#pragma unroll
    for (int o = 1; o < 64; o <<= 1) v += __shfl_xor(v, o);
    return v;
}
__device__ __forceinline__ float dot8(v4u a, v4u b) {
    return bflo(a.x) * bflo(b.x) + bfhi(a.x) * bfhi(b.x) + bflo(a.y) * bflo(b.y) + bfhi(a.y) * bfhi(b.y)
         + bflo(a.z) * bflo(b.z) + bfhi(a.z) * bfhi(b.z) + bflo(a.w) * bflo(b.w) + bfhi(a.w) * bfhi(b.w);
}
__device__ __forceinline__ float dot_bf16(const bf16* a, const bf16* b, int K) {
    float acc = 0.f;
    for (int k = 0; k < K; k += 8) acc += dot8(*(const v4u*)(a + k), *(const v4u*)(b + k));
    return acc;
}

#define XB_TMO      128
#define XB_XCNT(j)  (256  + 64 * (j))
#define XB_XSUB(j)  (1280 + 64 * (j))
#define XB_XGEN(j)  (2304 + 64 * (j))
#define XB_TOP      3328
#define XB_TOPGEN   3392
#define XCD_BAR_WORDS 3456
#define XB_SPIN_CAP (1u << 18)
__device__ __forceinline__ unsigned xb_ld(unsigned* p)              { return __hip_atomic_load(p, __ATOMIC_RELAXED, __HIP_MEMORY_SCOPE_AGENT); }
__device__ __forceinline__ unsigned xb_add(unsigned* p, unsigned v) { return __hip_atomic_fetch_add(p, v, __ATOMIC_RELAXED, __HIP_MEMORY_SCOPE_AGENT); }
__device__ __forceinline__ unsigned xb_xcc_id() { return (unsigned)__builtin_amdgcn_s_getreg((3 << 11) | 20) & 0xFu; }
#define XB_SPIN(cond, bar) do { unsigned _sp = 0; while (cond) { __builtin_amdgcn_s_sleep(1); \
    if ((++_sp & 255u) == 0u) { if (xb_ld(&(bar)[XB_TMO])) break; if (_sp > XB_SPIN_CAP) { atomicAdd(&(bar)[XB_TMO], 1u); break; } } } } while (0)
struct XcdBarrier { unsigned* bar; unsigned x; volatile LAS unsigned* st; };
#define XB_EXIT 3456
__device__ unsigned g_barrier_words[XCD_BAR_WORDS + 64];
__device__ __forceinline__ XcdBarrier xcd_barrier_post(unsigned* bar, volatile LAS unsigned* st) {
    XcdBarrier b; b.bar = bar; b.x = xb_xcc_id(); b.st = st;
    if (threadIdx.x == 0) (void)xb_add(&bar[XB_XCNT(b.x)], 1u);
    return b;
}
__device__ __forceinline__ void xcd_barrier_complete(unsigned* bar, unsigned x, unsigned& nloc, unsigned& nx) {
    const unsigned G = gridDim.x * gridDim.y * gridDim.z;
    unsigned sum, cnt, mine, sp = 0u;
    for (;;) {
        sum = 0u; cnt = 0u; mine = 0u;
#pragma unroll
        for (unsigned j = 0; j < 16; ++j) { const unsigned c = xb_ld(&bar[XB_XCNT(j)]); sum += c; cnt += (c > 0u) ? 1u : 0u; mine = (j == x) ? c : mine; }
        if (sum == G) break;
        __builtin_amdgcn_s_sleep(1);
        if ((++sp & 255u) == 0u) { if (xb_ld(&bar[XB_TMO])) break; if (sp > XB_SPIN_CAP) { atomicAdd(&bar[XB_TMO], 1u); break; } }
    }
    nloc = mine > 0u ? mine : 1u; nx = cnt > 0u ? cnt : 1u;
}
__device__ __forceinline__ void xcd_barrier(const XcdBarrier& b) {
    asm volatile("s_waitcnt vmcnt(0)" ::: "memory");
    __syncthreads();
    if (threadIdx.x == 0) {
        unsigned* bar = b.bar;
        __builtin_amdgcn_s_waitcnt(0);
        unsigned nloc = b.st[0], nx = b.st[1];
        if (nloc == 0u) { xcd_barrier_complete(bar, b.x, nloc, nx); b.st[0] = nloc; b.st[1] = nx; }
        const unsigned old = xb_add(&bar[XB_XSUB(b.x)], 1u);
        const unsigned gen = old / nloc;
        if (old + 1u == (gen + 1u) * nloc) {
            __builtin_amdgcn_fence(__ATOMIC_RELEASE, "agent");
            asm volatile("s_waitcnt vmcnt(0)" ::: "memory");
            const unsigned og = xb_add(&bar[XB_TOP], 1u);
            const unsigned tg = og / nx;
            if (og + 1u == (tg + 1u) * nx) xb_add(&bar[XB_TOPGEN], 1u);
            else XB_SPIN(xb_ld(&bar[XB_TOPGEN]) == tg, bar);
            __builtin_amdgcn_fence(__ATOMIC_ACQUIRE, "agent");
            xb_add(&bar[XB_XGEN(b.x)], 1u);
            asm volatile("s_waitcnt vmcnt(0)" ::: "memory");
        } else {
            XB_SPIN(xb_ld(&bar[XB_XGEN(b.x)]) == gen, bar);
            __builtin_amdgcn_fence(__ATOMIC_ACQUIRE, "agent");
            asm volatile("s_waitcnt vmcnt(0)" ::: "memory");
        }
    }
    __syncthreads();
}


namespace pg8 {
#define PG8_LAS __attribute__((address_space(3)))
typedef unsigned short bf16_t;
typedef short bf16x8 __attribute__((ext_vector_type(8)));
typedef float f32x4 __attribute__((ext_vector_type(4)));
typedef unsigned u32x4 __attribute__((ext_vector_type(4)));
typedef unsigned u32x2 __attribute__((ext_vector_type(2)));
constexpr int BM = 256, BK = 64, HALF = 128, HTB = HALF * BK * 2, STAGE_BYTES = 8 * HTB, NXCD = 8, WGM = 8;
__host__ __device__ __forceinline__ int lds_byte(int r, int c) { const int st = (r >> 4) * 2 + (c >> 5), rr = r & 15, cc = c & 31, ob = rr * 64 + cc * 2; return st * 1024 + (ob ^ (((ob >> 9) & 1) << 5)); }
__host__ __device__ __forceinline__ void stage_rc(int b, int& R, int& C) { const int st = b / 1024, sb = b % 1024, swz = sb ^ (((sb >> 9) & 1) << 5); R = (st >> 1) * 16 + swz / 64; C = (st & 1) * 32 + (swz % 64) / 2; }
__host__ __device__ __forceinline__ int perm32(int rho) { const int n = rho >> 4, i = rho & 15; return 8 * (i >> 2) + 4 * n + (i & 3); }
struct Unit { int pm, pn; };
struct Gemm { const bf16_t* A; const bf16_t* Bt; int M, N, K; };
struct StaticOrder {
    int nM, nN, nwg, G, c;
    __host__ __device__ void init(int M, int N, int G_, int c_) { nM = M / BM; nN = N / BM; nwg = nM * nN; G = G_; c = c_; }
    __host__ __device__ bool next(int i, Unit& u) const {
        const long L = (long)i * G + c; if (L >= nwg) return false;
        int wgid = (int)L; { const int q = nwg / NXCD, r = nwg % NXCD, xcd = wgid % NXCD, off = wgid / NXCD; wgid = (xcd < r ? xcd * (q + 1) : r * (q + 1) + (xcd - r) * q) + off; }
        const int nig = WGM * nN, gid = wgid / nig, fm = gid * WGM, gsz = (nM - fm) < WGM ? (nM - fm) : WGM;
        u.pm = fm + ((wgid % nig) % gsz); u.pn = (wgid % nig) / gsz; return true;
    }
    __device__ __forceinline__ void a_ready(const Unit&) const {}
    __device__ __forceinline__ void done(const Unit&) const {}
};
__device__ __forceinline__ unsigned cvt_pk_bf16(float lo, float hi) { unsigned r; asm volatile("v_cvt_pk_bf16_f32 %0, %1, %2" : "=v"(r) : "v"(lo), "v"(hi)); return r; }

template <int MODE> struct BMap {
    static constexpr int BHALF_ROWS = (MODE == 2) ? 32 : 128;
    __host__ __device__ static __forceinline__ int brow(int R) { return MODE == 0 ? R : MODE == 1 ? ((R & ~31) + perm32(R & 31)) : (64 * (R >> 5) + perm32(R & 31)); }
};

template <class Epi, class Sched, bool ALIGN_EPI = true>
__device__ __forceinline__ void gemm_phase(PG8_LAS unsigned char* lds, const Gemm g, const Sched& S, const Epi& E) {
    const int tid = threadIdx.x, wid = __builtin_amdgcn_readfirstlane(tid >> 6), lane = tid & 63, wr = wid >> 2, wc = wid & 3, fr = lane & 15, fq = lane >> 4;
    const int K = g.K, nt = K / BK;
    unsigned voffA[2], voffB[2];
#pragma unroll
    for (int i = 0; i < 2; ++i) { int R, C; stage_rc(tid * 16 + i * 8192, R, C); const int Rb = BMap<Epi::MODE>::brow(R);
        voffA[i] = (unsigned)(R * K + C) * 2u; voffB[i] = (unsigned)(Rb * K + C) * 2u; }
    const size_t kstep = (size_t)(BK * 2);
    const size_t hstepA = (size_t)HALF * K * 2, hstepB = (size_t)BMap<Epi::MODE>::BHALF_ROWS * K * 2;
    const size_t tstep = (size_t)BM * K * 2;
    const unsigned ldsw = (unsigned)wid * 1024u;
    const int aoff = lds_byte(wr * 64 + fr, fq * 8), boff = lds_byte(wc * 32 + fr, fq * 8);
#define PG8_SA(b, h) (((b) * 2 + (h)) * HTB)
#define PG8_SB(b, h) ((4 + (b) * 2 + (h)) * HTB)
#define PG8_STAGE(bufoff, gbase, voff) do { _Pragma("unroll") for (int _i = 0; _i < 2; ++_i) \
        __builtin_amdgcn_global_load_lds((const unsigned*)((const char*)(gbase) + (voff)[_i]), (PG8_LAS unsigned*)(lds + (bufoff) + ldsw + _i * 8192), 16, 0, 0); } while (0)
#define PG8_LDA(dst, b, h) do { _Pragma("unroll") for (int m = 0; m < 4; ++m) _Pragma("unroll") for (int k = 0; k < 2; ++k) dst[m][k] = *(const PG8_LAS bf16x8*)(lds + PG8_SA(b, h) + aoff + m * 2048 + k * 1024); } while (0)
#define PG8_LDB(dst, b, h) do { _Pragma("unroll") for (int n = 0; n < 2; ++n) _Pragma("unroll") for (int k = 0; k < 2; ++k) dst[n][k] = *(const PG8_LAS bf16x8*)(lds + PG8_SB(b, h) + boff + n * 2048 + k * 1024); } while (0)
#define PG8_MMA(ai, bj, At, Bt) do { __builtin_amdgcn_s_setprio(1); _Pragma("unroll") for (int m = 0; m < 4; ++m) _Pragma("unroll") for (int n = 0; n < 2; ++n) _Pragma("unroll") for (int k = 0; k < 2; ++k) \
        acc[ai][bj][m][n] = __builtin_amdgcn_mfma_f32_16x16x32_bf16(Bt[n][k], At[m][k], acc[ai][bj][m][n], 0, 0, 0); __builtin_amdgcn_s_setprio(0); } while (0)
#define PG8_WAIT_V(n) asm volatile("s_waitcnt vmcnt(" #n ")" ::: "memory")
#define PG8_WAIT_L(n) asm volatile("s_waitcnt lgkmcnt(" #n ")" ::: "memory")
#define PG8_BAR __builtin_amdgcn_s_barrier()
#define PG8_SCHED __builtin_amdgcn_sched_barrier(0)
    Unit cur, nxt; int ui = 0;
    if (!S.next(0, cur)) return;
    f32x4 acc[2][2][4][2];
#pragma unroll
    for (int a = 0; a < 2; ++a)
#pragma unroll
        for (int b = 0; b < 2; ++b)
#pragma unroll
            for (int m = 0; m < 4; ++m)
#pragma unroll
                for (int n = 0; n < 2; ++n) acc[a][b][m][n] = (f32x4){0.f, 0.f, 0.f, 0.f};
    bf16x8 At[4][2], B0[2][2], B1[2][2];
    const char* cA = (const char*)g.A + (size_t)cur.pm * tstep; const char* cB = (const char*)g.Bt + (size_t)cur.pn * tstep;
    S.a_ready(cur);
    PG8_STAGE(PG8_SB(0, 0), cB, voffB); PG8_STAGE(PG8_SB(0, 1), cB + hstepB, voffB); PG8_STAGE(PG8_SA(0, 0), cA, voffA); PG8_STAGE(PG8_SA(0, 1), cA + hstepA, voffA);
    if constexpr (Epi::PRE) E.pre(lds, tid, cur);
    if (wr == 1) PG8_BAR;
    PG8_WAIT_V(2); PG8_BAR;
    PG8_STAGE(PG8_SB(1, 0), cB + kstep, voffB); PG8_STAGE(PG8_SA(1, 0), cA + kstep, voffA); PG8_STAGE(PG8_SB(1, 1), cB + hstepB + kstep, voffB);
    PG8_WAIT_V(6); PG8_BAR;
    for (;;) {
        const bool has_next = S.next(ui + 1, nxt);
        const char* nA = has_next ? (const char*)g.A + (size_t)nxt.pm * tstep : cA; const char* nB = has_next ? (const char*)g.Bt + (size_t)nxt.pn * tstep : cB;
        for (int t = 0; t < nt; t += 2) {
            const bool last = (t == nt - 2);
            const char* a1 = cA + (size_t)(t + 1) * kstep;
            const char* a2 = last ? nA : cA + (size_t)(t + 2) * kstep; const char* b2 = last ? nB : cB + (size_t)(t + 2) * kstep;
            const char* a3 = a2 + kstep; const char* b3 = b2 + kstep;
            if (last && has_next) S.a_ready(nxt);
            if constexpr (Epi::MIDK > 0) { if (t == Epi::MIDK) E.midk(acc, wr, fr, lds); }
            PG8_LDB(B0, 0, 0); PG8_LDB(B1, 0, 1); PG8_SCHED; PG8_LDA(At, 0, 0); PG8_STAGE(PG8_SA(1, 1), a1 + hstepA, voffA);
            PG8_WAIT_V(8); PG8_WAIT_L(0); PG8_BAR; PG8_MMA(0, 0, At, B0); PG8_MMA(0, 1, At, B1); PG8_BAR; PG8_SCHED;
            PG8_LDA(At, 0, 1); PG8_STAGE(PG8_SB(0, 0), b2, voffB); PG8_STAGE(PG8_SB(0, 1), b2 + hstepB, voffB); PG8_STAGE(PG8_SA(0, 0), a2, voffA);
            PG8_WAIT_V(8); PG8_WAIT_L(0); PG8_BAR; PG8_MMA(1, 0, At, B0); PG8_MMA(1, 1, At, B1); PG8_BAR; PG8_SCHED;
            PG8_LDB(B0, 1, 0); PG8_LDB(B1, 1, 1); PG8_SCHED; PG8_LDA(At, 1, 0); PG8_STAGE(PG8_SA(0, 1), a2 + hstepA, voffA);
            PG8_WAIT_V(8); PG8_WAIT_L(0); PG8_BAR; PG8_MMA(0, 0, At, B0); PG8_MMA(0, 1, At, B1); PG8_BAR; PG8_SCHED;
            PG8_LDA(At, 1, 1); PG8_STAGE(PG8_SB(1, 0), b3, voffB); PG8_STAGE(PG8_SB(1, 1), b3 + hstepB, voffB); PG8_STAGE(PG8_SA(1, 0), a3, voffA);
            PG8_WAIT_V(8); PG8_WAIT_L(0); PG8_BAR; PG8_MMA(1, 0, At, B0); PG8_MMA(1, 1, At, B1); PG8_BAR; PG8_SCHED;
        }
        if constexpr (ALIGN_EPI) { if (wr == 0) PG8_BAR; }
        E(acc, cur, wr, wc, fr, fq, lds); S.done(cur);
        if constexpr (Epi::REP_TEST) { if (EPI_REP_TEST) E(acc, cur, wr, wc, fr, fq, lds); }
        if (!has_next) break;
#pragma unroll
        for (int a = 0; a < 2; ++a)
#pragma unroll
            for (int b = 0; b < 2; ++b)
#pragma unroll
                for (int m = 0; m < 4; ++m)
#pragma unroll
                    for (int n = 0; n < 2; ++n) acc[a][b][m][n] = (f32x4){0.f, 0.f, 0.f, 0.f};
        cur = nxt; cA = nA; cB = nB; ++ui;
        if constexpr (ALIGN_EPI) { if (wr == 1) PG8_BAR; }
    }
    PG8_WAIT_V(0);
    if constexpr (!ALIGN_EPI) { if (wr == 0) PG8_BAR; }
    PG8_BAR;
#undef PG8_SA
#undef PG8_SB
#undef PG8_STAGE
#undef PG8_LDA
#undef PG8_LDB
#undef PG8_MMA
#undef PG8_WAIT_V
#undef PG8_WAIT_L
#undef PG8_BAR
#undef PG8_SCHED
}

struct EpiInProj {
    static constexpr bool REP_TEST = false, PRE = false;
    static constexpr int MODE = 2, MIDK = 0;
    bf16_t *Qb, *Kb, *Vb, *Ub; const float *gq, *gk;
    __device__ __forceinline__ void operator()(const f32x4 (&acc)[2][2][4][2], const Unit& u, int wr, int wc, int fr, int fq, PG8_LAS unsigned char*) const {
        const int seg = u.pn >> 1; bf16_t* base = seg == 0 ? Qb : seg == 1 ? Kb : seg == 2 ? Vb : Ub;
        const int col0 = (u.pn & 1) * 256 + wc * 64 + 8 * fq, row0 = u.pm * BM + wr * 64 + fr;
#if WT_STORES
        const __amdgpu_buffer_rsrc_t br = __builtin_amdgcn_make_buffer_rsrc((void*)base, (short)0, M * AW * 2, 0x00020000);
#endif
        f32x4 gv[2][2];
#pragma unroll
        for (int bj = 0; bj < 2; ++bj)
#pragma unroll
            for (int n = 0; n < 2; ++n) { gv[bj][n] = (f32x4){1.f, 1.f, 1.f, 1.f};
                if (seg == 0) gv[bj][n] = *(const f32x4*)(gq + 32 * bj + 8 * fq + 4 * n) * C2; else if (seg == 1) gv[bj][n] = *(const f32x4*)(gk + 32 * bj + 8 * fq + 4 * n); }
#pragma unroll
        for (int ai = 0; ai < 2; ++ai)
#pragma unroll
            for (int m = 0; m < 4; ++m) {
                float r = 1.f;
                if (seg < 2) { float ss = 0.f;
#pragma unroll
                    for (int bj = 0; bj < 2; ++bj)
#pragma unroll
                        for (int n = 0; n < 2; ++n) { const f32x4 x = acc[ai][bj][m][n]; ss += (x[0] * x[0] + x[1] * x[1]) + (x[2] * x[2] + x[3] * x[3]); }
                    ss += __shfl_xor(ss, 16); ss += __shfl_xor(ss, 32); r = 1.f / sqrtf(ss * (1.f / 64.f) + EPS); }
                const size_t eoff = (size_t)(row0 + ai * HALF + m * 16) * AW + col0; bf16_t* rowp = base + eoff;
#pragma unroll
                for (int bj = 0; bj < 2; ++bj) { const f32x4 v0 = acc[ai][bj][m][0] * (gv[bj][0] * r), v1 = acc[ai][bj][m][1] * (gv[bj][1] * r);
                    u32x4 w; w.x = cvt_pk_bf16(v0[0], v0[1]); w.y = cvt_pk_bf16(v0[2], v0[3]); w.z = cvt_pk_bf16(v1[0], v1[1]); w.w = cvt_pk_bf16(v1[2], v1[3]);
#if WT_STORES
                    __builtin_amdgcn_raw_buffer_store_b128(w, br, (unsigned)((eoff + bj * 32) * 2), 0, 16); (void)rowp;
#else
                    *(u32x4*)(rowp + bj * 32) = w;
#endif
                } }
    }
};
struct EpiGlu {
    static constexpr bool REP_TEST = false, PRE = false;
    static constexpr int MODE = 1, MIDK = 0;
    const bf16_t* Z; bf16_t* O; const float* bias; float* ssq;
    __device__ __forceinline__ void operator()(const f32x4 (&acc)[2][2][4][2], const Unit& u, int wr, int wc, int fr, int fq, PG8_LAS unsigned char*) const {
        const int col0 = u.pn * BM + wc * 32 + 8 * fq, row0 = u.pm * BM + wr * 64 + fr;
#if WT_STORES_GLU
        const __amdgpu_buffer_rsrc_t orr = __builtin_amdgcn_make_buffer_rsrc((void*)O, (short)0, M * D * 2 - AW * 2, 0x00020000);
#endif
        f32x4 bv[2][2];
#pragma unroll
        for (int bj = 0; bj < 2; ++bj)
#pragma unroll
            for (int n = 0; n < 2; ++n) bv[bj][n] = *(const f32x4*)(bias + col0 + bj * HALF + 4 * n);
#pragma unroll
        for (int ai = 0; ai < 2; ++ai)
#pragma unroll
            for (int m = 0; m < 4; ++m) { const int row = row0 + ai * HALF + m * 16; float ss = 0.f;
#pragma unroll
                for (int bj = 0; bj < 2; ++bj) { const u32x4 zr = *(const u32x4*)(Z + (size_t)row * SW + col0 + bj * HALF);
                    const float zf[8] = {bflo(zr.x), bfhi(zr.x), bflo(zr.y), bfhi(zr.y), bflo(zr.z), bfhi(zr.z), bflo(zr.w), bfhi(zr.w)};
                    float o[8];
#pragma unroll
                    for (int e = 0; e < 8; ++e) { const float a = acc[ai][bj][m][e >> 2][e & 3] + bv[bj][e >> 2][e & 3];
                        o[e] = zf[e] * __builtin_amdgcn_rcpf(1.f + __builtin_amdgcn_exp2f(-1.4426950408889634f * a)); ss += o[e] * o[e]; }
                    u32x4 w; w.x = cvt_pk_bf16(o[0], o[1]); w.y = cvt_pk_bf16(o[2], o[3]); w.z = cvt_pk_bf16(o[4], o[5]); w.w = cvt_pk_bf16(o[6], o[7]);
#if WT_STORES_GLU
                    __builtin_amdgcn_raw_buffer_store_b128(w, orr, (unsigned)(((size_t)row * D + col0 + bj * HALF) * 2), 0, 16);
#else
                    *(u32x4*)(O + (size_t)row * D + col0 + bj * HALF) = w;
#endif
                }
                ss += __shfl_xor(ss, 16); ss += __shfl_xor(ss, 32);
                if (fq == 0) ssq[row * 8 + u.pn * 4 + wc] = ss; }
    }
};
struct EpiOut {
    static constexpr bool REP_TEST = false, PRE = true;
    static constexpr int MODE = 0, MIDK = 8;
    const float* x; float* out; bf16_t* x1b; float* ssq2; const float *ssqa, *ssqs, *rn1;
    __device__ __forceinline__ void pre(PG8_LAS unsigned char* lds, int tid, const Unit& u) const {
        if (tid < 256) { const int row = u.pm * BM + tid; const f32x4* a = (const f32x4*)(ssqa + row * 8); const f32x4* s = (const f32x4*)(ssqs + row * 8);
            const f32x4 a0 = a[0], a1 = a[1], s0 = s[0], s1 = s[1];
            const float sa = ((a0[0] + a0[1]) + (a0[2] + a0[3])) + ((a1[0] + a1[1]) + (a1[2] + a1[3])), ss = ((s0[0] + s0[1]) + (s0[2] + s0[3])) + ((s1[0] + s1[1]) + (s1[2] + s1[3]));
            const float ra = 1.f / sqrtf(sa * (1.f / 512.f) + EPS), rs = 1.f / sqrtf(ss * (1.f / 512.f) + EPS);
            ((PG8_LAS f32x2*)(lds + ROWTAB_OFF))[tid] = (f32x2){ra / rs, rs}; ((PG8_LAS float*)(lds + ROWTAB_OFF + 2048))[tid] = rn1[row]; }
        __syncthreads();
    }
    __device__ __forceinline__ void midk(f32x4 (&acc)[2][2][4][2], int wr, int fr, PG8_LAS unsigned char* lds) const {
        const PG8_LAS f32x2* tab = (const PG8_LAS f32x2*)(lds + ROWTAB_OFF);
#pragma unroll
        for (int ai = 0; ai < 2; ++ai)
#pragma unroll
            for (int m = 0; m < 4; ++m) { const float s = tab[ai * HALF + wr * 64 + m * 16 + fr].x;
#pragma unroll
                for (int bj = 0; bj < 2; ++bj)
#pragma unroll
                    for (int n = 0; n < 2; ++n) acc[ai][bj][m][n] *= s; }
    }
    __device__ __forceinline__ void operator()(const f32x4 (&acc)[2][2][4][2], const Unit& u, int wr, int wc, int fr, int fq, PG8_LAS unsigned char* lds) const {
        const PG8_LAS f32x2* tab = (const PG8_LAS f32x2*)(lds + ROWTAB_OFF); const PG8_LAS float* tab2 = (const PG8_LAS float*)(lds + ROWTAB_OFF + 2048);
        const int col0 = u.pn * BM + wc * 32 + 4 * fq;
#pragma unroll
        for (int ai = 0; ai < 2; ++ai) {
            u32x2 xv[4][2][2];
#pragma unroll
            for (int m = 0; m < 4; ++m) { const size_t off = (size_t)(u.pm * BM + ai * HALF + wr * 64 + m * 16 + fr) * D + col0;
#pragma unroll
                for (int bj = 0; bj < 2; ++bj)
#pragma unroll
                    for (int n = 0; n < 2; ++n) xv[m][bj][n] = *(const u32x2*)(x1b + off + bj * HALF + n * 16); }
#pragma unroll
            for (int m = 0; m < 4; ++m) { const int rl = ai * HALF + wr * 64 + m * 16 + fr; const float rs = tab[rl].y, rn = tab2[rl]; const size_t off = (size_t)(u.pm * BM + rl) * D + col0; float ss = 0.f;
#pragma unroll
                for (int bj = 0; bj < 2; ++bj)
#pragma unroll
                    for (int n = 0; n < 2; ++n) { const u32x2 xw = xv[m][bj][n]; const f32x4 xf = {bflo(xw.x), bfhi(xw.x), bflo(xw.y), bfhi(xw.y)}; const f32x4 o = xf * rn + acc[ai][bj][m][n] * rs;
                        ss += (o[0] * o[0] + o[1] * o[1]) + (o[2] * o[2] + o[3] * o[3]);
                        u32x2 w; w.x = cvt_pk_bf16(o[0], o[1]); w.y = cvt_pk_bf16(o[2], o[3]);
#if WT_STORES_8
                        __hip_atomic_store((unsigned long long*)(x1b + off + bj * HALF + n * 16), ((unsigned long long)w.y << 32) | w.x, __ATOMIC_RELAXED, __HIP_MEMORY_SCOPE_AGENT);
#else
                        *(u32x2*)(x1b + off + bj * HALF + n * 16) = w;
#endif
                    }
                ss += __shfl_xor(ss, 16); ss += __shfl_xor(ss, 32);
                if (fq == 0) ssq2[(u.pm * BM + rl) * 16 + u.pn * 4 + wc] = ss; }
        }
    }
};
struct EpiUp {
    static constexpr bool REP_TEST = true, PRE = true;
    static constexpr int MODE = 1, MIDK = 0;
    bf16_t* H; const float* ssq2;
    __device__ __forceinline__ void pre(PG8_LAS unsigned char* lds, int tid, const Unit& u) const {
        if (tid < 256) { const int row = u.pm * BM + tid; const f32x4* q = (const f32x4*)(ssq2 + row * 16); float s = 0.f;
#pragma unroll
            for (int i = 0; i < 4; ++i) { const f32x4 v = q[i]; s += (v[0] + v[1]) + (v[2] + v[3]); }
            ((PG8_LAS f32x2*)(lds + ROWTAB_OFF))[tid] = (f32x2){1.f / sqrtf(s * (1.f / 1024.f) + EPS), 0.f}; }
        __syncthreads();
    }
    __device__ __forceinline__ void operator()(const f32x4 (&acc)[2][2][4][2], const Unit& u, int wr, int wc, int fr, int fq, PG8_LAS unsigned char* lds) const {
        const PG8_LAS f32x2* tab = (const PG8_LAS f32x2*)(lds + ROWTAB_OFF);
        const int col0 = u.pn * BM + wc * 32 + 8 * fq;
#if WT_STORES
        const __amdgpu_buffer_rsrc_t hr = __builtin_amdgcn_make_buffer_rsrc((void*)H, (short)0, M * FF * 2, 0x00020000);
#endif
#pragma unroll
        for (int ai = 0; ai < 2; ++ai)
#pragma unroll
            for (int m = 0; m < 4; ++m) { const int rl = ai * HALF + wr * 64 + m * 16 + fr; const float r2 = tab[rl].x; const size_t eoff = (size_t)(u.pm * BM + rl) * FF + col0; bf16_t* rowp = H + eoff;
#pragma unroll
                for (int bj = 0; bj < 2; ++bj) { f32x4 v0 = acc[ai][bj][m][0] * r2, v1 = acc[ai][bj][m][1] * r2;
#pragma unroll
                    for (int e = 0; e < 4; ++e) { const float a = fmaxf(v0[e], 0.f), b = fmaxf(v1[e], 0.f); v0[e] = a * a; v1[e] = b * b; }
                    u32x4 w; w.x = cvt_pk_bf16(v0[0], v0[1]); w.y = cvt_pk_bf16(v0[2], v0[3]); w.z = cvt_pk_bf16(v1[0], v1[1]); w.w = cvt_pk_bf16(v1[2], v1[3]);
#if WT_STORES
                    __builtin_amdgcn_raw_buffer_store_b128(w, hr, (unsigned)((eoff + bj * HALF) * 2), 0, 16); (void)rowp;
#else
                    *(u32x4*)(rowp + bj * HALF) = w;
#endif
                } }
    }
};
struct EpiDown {
    static constexpr bool REP_TEST = false, PRE = false;
    static constexpr int MODE = 0, MIDK = 0;
    float* out; const bf16_t* x1b;
    __device__ __forceinline__ void operator()(const f32x4 (&acc)[2][2][4][2], const Unit& u, int wr, int wc, int fr, int fq, PG8_LAS unsigned char*) const {
        const int col0 = u.pn * BM + wc * 32 + 4 * fq;
#pragma unroll
        for (int ai = 0; ai < 2; ++ai) {
            u32x2 xv[4][2][2];
#pragma unroll
            for (int m = 0; m < 4; ++m) { const size_t off = (size_t)(u.pm * BM + ai * HALF + wr * 64 + m * 16 + fr) * D + col0;
#pragma unroll
                for (int bj = 0; bj < 2; ++bj)
#pragma unroll
                    for (int n = 0; n < 2; ++n) xv[m][bj][n] = *(const u32x2*)(x1b + off + bj * HALF + n * 16); }
#pragma unroll
            for (int m = 0; m < 4; ++m) { const size_t off = (size_t)(u.pm * BM + ai * HALF + wr * 64 + m * 16 + fr) * D + col0;
#pragma unroll
                for (int bj = 0; bj < 2; ++bj)
#pragma unroll
                    for (int n = 0; n < 2; ++n) { const u32x2 w = xv[m][bj][n]; const f32x4 x1 = {bflo(w.x), bfhi(w.x), bflo(w.y), bfhi(w.y)};
                        *(f32x4*)(out + off + bj * HALF + n * 16) = x1 + acc[ai][bj][m][n]; } }
        }
    }
};
}


namespace att {
typedef short bf16x8 __attribute__((ext_vector_type(8)));
typedef short s16x4 __attribute__((ext_vector_type(4)));
typedef float f32x16 __attribute__((ext_vector_type(16)));
typedef __attribute__((address_space(3))) unsigned char* ldsp;
typedef short v4i16_t __attribute__((ext_vector_type(4)));
constexpr int LBUF_OFF = 131072 + 3072;
__device__ __forceinline__ int crow(int r, int hi) { return (r & 3) + 8 * (r >> 2) + 4 * hi; }
__device__ __forceinline__ unsigned cvtpk(float lo, float hi) { unsigned r; asm volatile("v_cvt_pk_bf16_f32 %0, %1, %2" : "=v"(r) : "v"(lo), "v"(hi)); return r; }
__device__ __forceinline__ s16x4 vtr(ldsp p) { return __builtin_bit_cast(s16x4, __builtin_amdgcn_ds_read_tr16_b64_v4i16((__attribute__((address_space(3))) v4i16_t*)p)); }

struct TileRegs { v4u k[4], v[4]; };
struct TileAddr { unsigned loff, kw_e, kw_o, vw, kr0, vr; int lbase; };
__device__ __forceinline__ TileAddr make_tile_addr(int lane, int d) {
    const int r = lane >> 3, ch = lane & 7, r32 = lane & 31, hi = lane >> 5; TileAddr a;
    a.loff = (unsigned)((d * r * AW + ch * 8) * 2);
    a.kw_e = (unsigned)(r * 128 + ((ch ^ (r >> 1)) << 4)); a.kw_o = a.kw_e ^ 64u;
    a.vw = (unsigned)((ch >> 2) * 2048 + r * 64 + (ch & 3) * 16);
    a.kr0 = (unsigned)(r32 * 128 + ((hi ^ ((r32 >> 1) & 7)) << 4));
    a.vr = (unsigned)(4096 + ((lane >> 4) & 1) * 32 + (lane & 3) * 8 + (4 * hi + ((lane & 15) >> 2)) * 64);
    a.lbase = r32 - 4 * hi; return a;
}
__device__ __forceinline__ void load_tile_regs(const bf16* Kg, const bf16* Vg, int tok0, int d, int lane, const TileAddr& a, TileRegs& t) {
    if (tok0 >= 0) {
        const char* kb = (const char*)(Kg + (size_t)tok0 * AW); const char* vb = (const char*)(Vg + (size_t)tok0 * AW); const size_t step = (size_t)8 * d * AW * 2;
#pragma unroll
        for (int i = 0; i < 4; ++i) { t.k[i] = *(const v4u*)(kb + i * step + a.loff); t.v[i] = *(const v4u*)(vb + i * step + a.loff); }
    } else {
#pragma unroll
        for (int i = 0; i < 4; ++i) { int tk = tok0 + d * (8 * i + (lane >> 3)); tk = tk < 0 ? 0 : tk; const size_t off = (size_t)tk * AW + (lane & 7) * 8;
            t.k[i] = *(const v4u*)(Kg + off); t.v[i] = *(const v4u*)(Vg + off); }
    }
}
__device__ __forceinline__ void store_tile_lds(ldsp buf, const TileAddr& a, const TileRegs& t) {
#pragma unroll
    for (int i = 0; i < 4; ++i) {
        *(__attribute__((address_space(3))) v4u*)(buf + i * 1024 + ((i & 1) ? a.kw_o : a.kw_e)) = t.k[i];
        *(__attribute__((address_space(3))) v4u*)(buf + 4096 + (i >> 1) * 1024 + (i & 1) * 512 + a.vw) = t.v[i]; }
}

__device__ __forceinline__ void store_tile_lds_early(ldsp buf, int lane, int d, const TileRegs& t) { const TileAddr a = make_tile_addr(lane, d); store_tile_lds(buf, a, t); }

template <int NBLK> struct WinPre { TileRegs tr; bf16x8 q[NBLK][4]; };
template <int NBLK>
__device__ __forceinline__ void window_begin(const bf16* Qg, const bf16* Kg, const bf16* Vg, int tb, int d, int lane, WinPre<NBLK>& pre) {
    const int r32 = lane & 31, hi = lane >> 5;
    load_tile_regs(Kg, Vg, tb - 128 * d, d, lane, make_tile_addr(lane, d), pre.tr);
#pragma unroll
    for (int b = 0; b < NBLK; ++b)
#pragma unroll
        for (int d0 = 0; d0 < 4; ++d0) pre.q[b][d0] = *(const bf16x8*)(Qg + (size_t)(tb + d * (32 * b + r32)) * AW + d0 * 16 + hi * 8);
}
template <int NBLK>
__device__ __forceinline__ void window(const bf16* Kg, const bf16* Vg, int tb, int d, ldsp wbuf, f32x16 (&o)[NBLK][2], float (&l)[NBLK], float nshift, int lane_in, WinPre<NBLK>& pre) {
    const int lane = lane_in;
    constexpr int NT = NBLK + 4;
    TileRegs& tr = pre.tr; bf16x8 (&q)[NBLK][4] = pre.q;
#pragma unroll
    for (int b = 0; b < NBLK; ++b)
#pragma unroll
        for (int d0 = 0; d0 < 4; ++d0) asm volatile("" : "+v"(q[b][d0]));
    f32x16 zero16;
#pragma unroll
    for (int r = 0; r < 16; ++r) zero16[r] = 0.f;
    store_tile_lds_early(wbuf, lane, d, tr);
    auto body = [&](const int TT) __attribute__((always_inline)) {
        const int T = TT / ATT_TILE_REP; const float pscale = (TT % ATT_TILE_REP) ? 0.f : 1.f; const int tok0 = tb - 128 * d + 32 * d * T;
        int ln = lane_in; asm volatile("" : "+v"(ln));
        const TileAddr ta = make_tile_addr(ln, d); const int lane = ln, hi = lane >> 5, lbase = ta.lbase;
        const ldsp cb = wbuf + (TT & 1) * 8192;
        if (TT + 1 < NT * ATT_TILE_REP) load_tile_regs(Kg, Vg, tb - 128 * d + 32 * d * ((TT + 1) / ATT_TILE_REP), d, lane, ta, tr);
        bf16x8 kf[4];
#pragma unroll
        for (int d0 = 0; d0 < 4; ++d0) kf[d0] = *(const __attribute__((address_space(3))) bf16x8*)(cb + (ta.kr0 ^ (unsigned)(d0 << 5)));
        bf16x8 vf[2][2];
        { const ldsp vp = cb + ta.vr;
#pragma unroll
          for (int s = 0; s < 2; ++s)
#pragma unroll
            for (int dh = 0; dh < 2; ++dh) { const s16x4 lo = vtr(vp + dh * 2048 + s * 1024), hh = vtr(vp + dh * 2048 + s * 1024 + 512);
                vf[s][dh] = (bf16x8){lo[0], lo[1], lo[2], lo[3], hh[0], hh[1], hh[2], hh[3]}; } }
        const int kmin = tok0 < 0 ? (-tok0 + d - 1) / d : 0;
        f32x16 S[NBLK]; bf16x8 pa[NBLK][2];
#pragma unroll
        for (int b = 0; b < NBLK; ++b) { const int tb_ = T - b; if (tb_ < 0 || tb_ > 4) continue;
            S[b] = __builtin_amdgcn_mfma_f32_32x32x16_bf16(kf[0], q[b][0], zero16, 0, 0, 0);
            S[b] = __builtin_amdgcn_mfma_f32_32x32x16_bf16(kf[1], q[b][1], S[b], 0, 0, 0);
            S[b] = __builtin_amdgcn_mfma_f32_32x32x16_bf16(kf[2], q[b][2], S[b], 0, 0, 0);
            S[b] = __builtin_amdgcn_mfma_f32_32x32x16_bf16(kf[3], q[b][3], S[b], 0, 0, 0); }
#pragma unroll
        for (int b = 0; b < NBLK; ++b) { const int tb_ = T - b; if (tb_ < 0 || tb_ > 4) continue;
            const int dl = 128 - 32 * tb_;
            float p[16]; float ls = 0.f;
            if (kmin == 0) {
                if (tb_ >= 1 && tb_ <= 3) {
#pragma unroll
                    for (int r = 0; r < 16; ++r) { p[r] = __builtin_amdgcn_exp2f(ATT_NOSHIFT ? S[b][r] : S[b][r] + nshift); ls += p[r]; }
                } else if (tb_ == 0) {
#pragma unroll
                    for (int r = 0; r < 16; ++r) { const int cr = (r & 3) + 8 * (r >> 2); p[r] = (cr >= lbase) ? __builtin_amdgcn_exp2f(ATT_NOSHIFT ? S[b][r] : S[b][r] + nshift) : 0.f; ls += p[r]; }
                } else {
#pragma unroll
                    for (int r = 0; r < 16; ++r) { const int cr = (r & 3) + 8 * (r >> 2); p[r] = (cr <= lbase) ? __builtin_amdgcn_exp2f(ATT_NOSHIFT ? S[b][r] : S[b][r] + nshift) : 0.f; ls += p[r]; }
                }
            } else {
                const int x = lbase + dl;
#pragma unroll
                for (int r = 0; r < 16; ++r) { const int cr = (r & 3) + 8 * (r >> 2); const bool ok = ((unsigned)(x - cr) <= 128u) && (cr + 4 * hi >= kmin);
                    p[r] = ok ? __builtin_amdgcn_exp2f(ATT_NOSHIFT ? S[b][r] : S[b][r] + nshift) : 0.f; ls += p[r]; }
            }
            if (ATT_TILE_REP > 1) {
#pragma unroll
                for (int r = 0; r < 16; ++r) p[r] *= pscale;
                ls *= pscale; }
            l[b] += ls;
#pragma unroll
            for (int s = 0; s < 2; ++s) { typedef unsigned u4 __attribute__((ext_vector_type(4)));
                u4 w; w.x = cvtpk(p[8 * s + 0], p[8 * s + 1]); w.y = cvtpk(p[8 * s + 2], p[8 * s + 3]); w.z = cvtpk(p[8 * s + 4], p[8 * s + 5]); w.w = cvtpk(p[8 * s + 6], p[8 * s + 7]);
                pa[b][s] = __builtin_bit_cast(bf16x8, w); } }
#pragma unroll
        for (int b = 0; b < NBLK; ++b) { const int tb_ = T - b; if (tb_ < 0 || tb_ > 4) continue;
#pragma unroll
            for (int dh = 0; dh < 2; ++dh) { o[b][dh] = __builtin_amdgcn_mfma_f32_32x32x16_bf16(pa[b][0], vf[0][dh], o[b][dh], 0, 0, 0);
                                             o[b][dh] = __builtin_amdgcn_mfma_f32_32x32x16_bf16(pa[b][1], vf[1][dh], o[b][dh], 0, 0, 0); } }
        if (TT + 1 < NT * ATT_TILE_REP) store_tile_lds(wbuf + ((TT + 1) & 1) * 8192, ta, tr);
    };
    if constexpr ((NBLK == 2 && ATT_UNROLL2) || (NBLK == 1 && ATT_UNROLL1)) {
#pragma unroll
        for (int TT = 0; TT < NT * ATT_TILE_REP; ++TT) body(TT);
    } else {
#pragma unroll 1
        for (int TT = 0; TT < NT * ATT_TILE_REP; ++TT) body(TT);
    }
}

#define LDS_BARRIER() do { asm volatile("s_waitcnt lgkmcnt(0)" ::: "memory"); __builtin_amdgcn_s_barrier(); asm volatile("" ::: "memory"); } while (0)
template <int MODE>
__device__ __forceinline__ void exchange1(const f32x16 (&o)[1][2], float l, int tl0, int d, int j, f32x16 (&oc)[2][2], float (&lc)[2], ldsp lds, int w, int lane_in) {
    int lane = lane_in; asm volatile("" : "+v"(lane));
    const int r32 = lane & 31, hi = lane >> 5;
    __attribute__((address_space(3))) float* buf = (__attribute__((address_space(3))) float*)lds;
    __attribute__((address_space(3))) float* lbuf = (__attribute__((address_space(3))) float*)(lds + LBUF_OFF);
    LDS_BARRIER();
#pragma unroll
    for (int dh = 0; dh < 2; ++dh)
#pragma unroll
        for (int r = 0; r < 16; ++r) buf[(tl0 + d * crow(r, hi)) * 64 + dh * 32 + r32] = o[0][dh][r];
    { const float lt = l + __shfl_xor(l, 32); if (hi == 0) lbuf[tl0 + d * r32] = lt; }
    LDS_BARRIER();
    if (MODE == 16 || ((w >> 1) & 1) == j) {
#pragma unroll
        for (int b = 0; b < 2; ++b) {
#pragma unroll
            for (int dh = 0; dh < 2; ++dh)
#pragma unroll
                for (int r = 0; r < 16; ++r) { if (MODE == 16 && (r & 1) != j) continue; oc[b][dh][r] += buf[(64 * w + 32 * b + crow(r, hi)) * 64 + dh * 32 + r32]; }
            const float lv = lbuf[64 * w + 32 * b + r32];
            lc[b] += (MODE == 16 && (r32 & 1) != j) ? 0.f : lv; }
    }
    LDS_BARRIER();
}

__device__ __forceinline__ void unit(const bf16* Q, const bf16* K, const bf16* V, bf16* MIXo, float* SSQA, int h, int i0, float nshift, ldsp lds, int tid_in) {
    int tid = tid_in; asm volatile("" : "+v"(tid));
    const int lane = tid & 63, w = __builtin_amdgcn_readfirstlane(tid >> 6), r32 = lane & 31, hi = lane >> 5;
    const bf16* Qg = Q + h * 64; const bf16* Kg = K + h * 64; const bf16* Vg = V + h * 64;
    const ldsp wbuf = lds + w * 16384;
    f32x16 oc[2][2]; float lc[2];
    __attribute__((address_space(3))) float* xbuf = (__attribute__((address_space(3))) float*)lds;
    __attribute__((address_space(3))) float* xlbuf = (__attribute__((address_space(3))) float*)(lds + LBUF_OFF);
    WinPre<1> p1;
    { const int tlB = (w & 3) + 256 * (w >> 2);
      WinPre<2> pb; window_begin<2>(Qg, Kg, Vg, i0 + tlB, 4, lane, pb);
      float lb[2] = {0.f, 0.f};
#pragma unroll
      for (int b = 0; b < 2; ++b)
#pragma unroll
        for (int dh = 0; dh < 2; ++dh)
#pragma unroll
            for (int r = 0; r < 16; ++r) oc[b][dh][r] = 0.f;
      window<2>(Kg, Vg, i0 + tlB, 4, wbuf, oc, lb, nshift, lane, pb);
      window_begin<1>(Qg, Kg, Vg, i0 + 2 * w, 16, lane, p1);
      LDS_BARRIER();
      int lx = lane; asm volatile("" : "+v"(lx)); const int r32 = lx & 31, hi = lx >> 5;
#pragma unroll
      for (int b = 0; b < 2; ++b) {
#pragma unroll
        for (int dh = 0; dh < 2; ++dh)
#pragma unroll
            for (int r = 0; r < 16; ++r) xbuf[(tlB + 128 * b + 4 * crow(r, hi)) * 64 + dh * 32 + r32] = oc[b][dh][r];
        const float lt = lb[b] + __shfl_xor(lb[b], 32);
        if (hi == 0) xlbuf[tlB + 128 * b + 4 * r32] = lt; }
      LDS_BARRIER();
#pragma unroll
      for (int b = 0; b < 2; ++b) {
#pragma unroll
        for (int dh = 0; dh < 2; ++dh)
#pragma unroll
            for (int r = 0; r < 16; ++r) oc[b][dh][r] = xbuf[(2 * w + b + 16 * crow(r, hi)) * 64 + dh * 32 + r32];
        lc[b] = xlbuf[2 * w + b + 16 * r32]; }
      LDS_BARRIER(); }
#pragma unroll
    for (int b = 0; b < 2; ++b) { f32x16 oa[1][2] = {{oc[b][0], oc[b][1]}}; float la[1] = {0.f};
        if (b == 1) window_begin<1>(Qg, Kg, Vg, i0 + 2 * w + 1, 16, lane, p1);
        window<1>(Kg, Vg, i0 + 2 * w + b, 16, wbuf, oa, la, nshift, lane, p1);
        oc[b][0] = oa[0][0]; oc[b][1] = oa[0][1]; lc[b] += la[0] + __shfl_xor(la[0], 32); }
    WinPre<2> pc;
    window_begin<2>(Qg, Kg, Vg, i0 + 64 * w, 1, lane, pc);
    { LDS_BARRIER();
      int lx = lane; asm volatile("" : "+v"(lx)); const int r32 = lx & 31, hi = lx >> 5;
#pragma unroll
      for (int b = 0; b < 2; ++b) {
#pragma unroll
        for (int dh = 0; dh < 2; ++dh)
#pragma unroll
            for (int r = 0; r < 16; ++r) xbuf[(2 * w + b + 16 * crow(r, hi)) * 64 + dh * 32 + r32] = oc[b][dh][r];
        if (hi == 0) xlbuf[2 * w + b + 16 * r32] = lc[b]; }
      LDS_BARRIER();
#pragma unroll
      for (int b = 0; b < 2; ++b) {
#pragma unroll
        for (int dh = 0; dh < 2; ++dh)
#pragma unroll
            for (int r = 0; r < 16; ++r) oc[b][dh][r] = xbuf[(64 * w + 32 * b + crow(r, hi)) * 64 + dh * 32 + r32];
        lc[b] = xlbuf[64 * w + 32 * b + r32]; }
      LDS_BARRIER(); }
    { float lC[2] = {0.f, 0.f};
      window<2>(Kg, Vg, i0 + 64 * w, 1, wbuf, oc, lC, nshift, lane, pc);
      lc[0] += lC[0] + __shfl_xor(lC[0], 32); lc[1] += lC[1] + __shfl_xor(lC[1], 32); }
    __attribute__((address_space(3))) float* buf = (__attribute__((address_space(3))) float*)lds;
    __attribute__((address_space(3))) float* lbuf = (__attribute__((address_space(3))) float*)(lds + LBUF_OFF);
#pragma unroll
    for (int b = 0; b < 2; ++b) {
#pragma unroll
        for (int dh = 0; dh < 2; ++dh)
#pragma unroll
            for (int r = 0; r < 16; ++r) buf[(64 * w + 32 * b + crow(r, hi)) * 64 + dh * 32 + r32] = oc[b][dh][r];
        if (hi == 0) lbuf[64 * w + 32 * b + r32] = lc[b]; }
    __syncthreads();
    int tid2 = tid; asm volatile("" : "+v"(tid2));
#pragma unroll
    for (int k = 0; k < 8; ++k) { const int item = tid2 + 512 * k, tok = item >> 3, ch = item & 7;
        const f32x4 a = *(const __attribute__((address_space(3))) f32x4*)(buf + tok * 64 + ch * 8), c = *(const __attribute__((address_space(3))) f32x4*)(buf + tok * 64 + ch * 8 + 4);
        const float inv = 1.f / lbuf[tok];
        const f32x4 x = a * inv, y = c * inv;
        float ss = (x[0] * x[0] + x[1] * x[1]) + (x[2] * x[2] + x[3] * x[3]) + (y[0] * y[0] + y[1] * y[1]) + (y[2] * y[2] + y[3] * y[3]);
        v4u wv; wv.x = cvtpk(x[0], x[1]); wv.y = cvtpk(x[2], x[3]); wv.z = cvtpk(y[0], y[1]); wv.w = cvtpk(y[2], y[3]);
        *(v4u*)(MIXo + (size_t)(i0 + tok) * D + h * 64 + ch * 8) = wv;
        ss += __shfl_xor(ss, 1); ss += __shfl_xor(ss, 2); ss += __shfl_xor(ss, 4);
        if (ch == 0) SSQA[(i0 + tok) * 8 + h] = ss; }
    __syncthreads();
}
}


namespace ssm {
typedef short bf16x8 __attribute__((ext_vector_type(8)));
typedef __attribute__((address_space(3))) unsigned char* ldsp;
__device__ __forceinline__ void load_u_frags(const bf16* U, int tile, int g, int lane, bf16x8 (&a)[8]) {
    const int chunk = lane & 15, kq = lane >> 4;
    const bf16* p = U + (size_t)(tile * TILE + 16 * chunk + (kq >> 1)) * SW + 16 * g + 8 * (kq & 1);
#pragma unroll
    for (int ks = 0; ks < 8; ++ks) a[ks] = *(const bf16x8*)(p + (size_t)(2 * ks) * SW);
}
__device__ __forceinline__ void table_load(const bf16* W, int tid, v4u (&v)[8]) {
#pragma unroll
    for (int i = 0; i < 8; ++i) v[i] = *(const v4u*)(W + ((size_t)(tid + NTHREADS * i) << 3));
}
__device__ __forceinline__ void table_store(const v4u (&v)[8], int cpr_log2, ldsp lds, int tid) {
#pragma unroll
    for (int i = 0; i < 8; ++i) { const int id = tid + NTHREADS * i, row = id >> cpr_log2, ch = id & ((1 << cpr_log2) - 1);
        *(__attribute__((address_space(3))) v4u*)(lds + (row << (cpr_log2 + 4)) + ((ch ^ (row & 15)) << 4)) = v[i]; }
}
constexpr int TM_LDS = 131072 + 1024, PART_LDS = TM_LDS + 8704;
__device__ __forceinline__ void phaseA(const unsigned char* ws_, int tile, int g, ldsp lds, ldsp scr, int tid) {
    unsigned char* ws = const_cast<unsigned char*>(ws_);
    const int lane = tid & 63;
    v4u tv[8]; table_load((const bf16*)(ws + WS_WST) + (size_t)g * 128 * 256, tid, tv);
    bf16x8 a[8]; load_u_frags((const bf16*)(ws + WS_U), tile, g, lane, a);
    const f32x2 al = ((const f32x2*)(ws + WS_ALP))[(g * 16 + 1) * 64 + lane];
    table_store(tv, 5, lds, tid);
    __syncthreads();
    const int n = lane & 15, kq = lane >> 4;
    __attribute__((address_space(3))) float* s = (__attribute__((address_space(3))) float*)scr;
#pragma unroll
    for (int nt = 0; nt < 8; ++nt) { f32x4 acc = {0.f, 0.f, 0.f, 0.f};
#pragma unroll
        for (int ks = 0; ks < 8; ++ks) { const bf16x8 b = *(const __attribute__((address_space(3))) bf16x8*)(lds + (16 * nt + n) * 512 + (((4 * ks + kq) ^ n) << 4));
            acc = __builtin_amdgcn_mfma_f32_16x16x32_bf16(a[ks], b, acc, 0, 0, 0); }
#pragma unroll
        for (int e = 0; e < 4; ++e) s[(4 * kq + e) * 128 + 16 * nt + n] = acc[e]; }
    asm volatile("s_waitcnt lgkmcnt(0)" ::: "memory");
    const int p = lane;
    float* XLOC = (float*)(ws + WS_XLOC) + ((size_t)(tile * NG + g) * 16) * 128;
    float xr = 0.f, xi = 0.f;
#pragma unroll
    for (int j = 0; j < NCH; ++j) { XLOC[j * 128 + p] = xr; XLOC[j * 128 + 64 + p] = xi;
        const float sr = s[j * 128 + p], si = s[j * 128 + 64 + p];
        const float nr = al.x * xr - al.y * xi + sr, ni = al.x * xi + al.y * xr + si; xr = nr; xi = ni; }
    float* ST = (float*)(ws + WS_STILE) + (size_t)(tile * NG + g) * 128; ST[p] = xr; ST[64 + p] = xi;
    asm volatile("s_waitcnt lgkmcnt(0)" ::: "memory");
}
__device__ __forceinline__ void prefix_terms(const f32x2* ATP, const float* ST, int pw0, int pstep, int j0, int jstep, int cnt, float& tr, float& ti) {
    f32x2 a[8]; float sr[8], si[8];
#pragma unroll
    for (int i = 0; i < 8; ++i) { const int ic = i < cnt ? i : 0;
        const int pw = pw0 - ic * pstep; a[i] = ATP[(pw < 0 ? 0 : pw) * 64]; sr[i] = ST[(size_t)(j0 + ic * jstep) * NG * 128]; si[i] = ST[(size_t)(j0 + ic * jstep) * NG * 128 + 64];
        if (i >= cnt) a[i] = (f32x2){0.f, 0.f}; }
#pragma unroll
    for (int i = 0; i < 8; ++i) { tr += a[i].x * sr[i] - a[i].y * si[i]; ti += a[i].x * si[i] + a[i].y * sr[i]; }
}
#define SUBP(k) do { if (PROBE_SUB == (k)) ta = __builtin_amdgcn_s_memrealtime(); if (PROBE_SUB + 1 == (k)) tb = __builtin_amdgcn_s_memrealtime(); } while (0)
__device__ __forceinline__ void phaseB(const unsigned char* ws_, int base, int g, ldsp lds, ldsp scr, int tid, unsigned long long& ta, unsigned long long& tb) {
    SUBP(0);
    unsigned char* ws = const_cast<unsigned char*>(ws_);
    const int lane = tid & 63, w = __builtin_amdgcn_readfirstlane(tid >> 6), tile = base + w;
    v4u tv[8]; table_load((const bf16*)(ws + WS_WCR) + (size_t)g * 256 * 128, tid, tv);
    v4u tmv[2]; { const v4u* TMg = (const v4u*)((const bf16*)(ws + WS_TM) + (size_t)g * 17 * 256); tmv[0] = TMg[tid]; tmv[1] = TMg[tid < 32 ? 512 + tid : tid]; }
    bf16x8 au[8]; load_u_frags((const bf16*)(ws + WS_U), tile, g, lane, au);
    const int p = lane;
    const f32x2* ATP = (const f32x2*)(ws + WS_ATP) + (size_t)g * 64 * 64 + p; const float* ST = (const float*)(ws + WS_STILE) + (size_t)g * 128 + p;
    const float* XLOC = (const float*)(ws + WS_XLOC) + ((size_t)(tile * NG + g) * 16) * 128;
    float xlr[NCH], xli[NCH];
#pragma unroll
    for (int j = 0; j < NCH; ++j) { xlr[j] = XLOC[j * 128 + p]; xli[j] = XLOC[j * 128 + 64 + p]; }
    const f32x2 al1 = ((const f32x2*)(ws + WS_ALP))[(g * 16 + 1) * 64 + p];
    f32x2 oa[8]; float osr[8], osi[8];
#pragma unroll
    for (int i = 0; i < 8; ++i) { const int ic = i < w ? i : 0; const int pw = w - 1 - ic;
        oa[i] = ATP[(pw < 0 ? 0 : pw) * 64]; osr[i] = ST[(size_t)(base + ic) * NG * 128]; osi[i] = ST[(size_t)(base + ic) * NG * 128 + 64];
        if (i >= w) oa[i] = (f32x2){0.f, 0.f}; }
    const f32x2 aw = ATP[w * 64];
    { float pr = 0.f, pi = 0.f; const int cnt = base > w ? (base - w + 7) / 8 : 0;
      prefix_terms(ATP, ST, base - 1 - w, 8, w, 8, cnt, pr, pi);
      __attribute__((address_space(3))) float* part = (__attribute__((address_space(3))) float*)(lds + PART_LDS) + w * 128; part[p] = pr; part[64 + p] = pi; }
    SUBP(1);
    table_store(tv, 4, lds, tid);
    { __attribute__((address_space(3))) v4u* tml = (__attribute__((address_space(3))) v4u*)(lds + TM_LDS); tml[tid] = tmv[0]; if (tid < 32) tml[512 + tid] = tmv[1]; }
    __syncthreads();
    SUBP(2);
    { float br = 0.f, bi = 0.f;
      const __attribute__((address_space(3))) float* part = (const __attribute__((address_space(3))) float*)(lds + PART_LDS);
#pragma unroll
      for (int k = 0; k < 8; ++k) { br += part[k * 128 + p]; bi += part[k * 128 + 64 + p]; }
      float tr = aw.x * br - aw.y * bi, ti = aw.x * bi + aw.y * br;
#pragma unroll
      for (int i = 0; i < 8; ++i) { tr += oa[i].x * osr[i] - oa[i].y * osi[i]; ti += oa[i].x * osi[i] + oa[i].y * osr[i]; }
      __attribute__((address_space(3))) bf16* xp = (__attribute__((address_space(3))) bf16*)scr;
      float cr = tr, ci = ti;
#pragma unroll
      for (int j = 0; j < NCH; ++j) { xp[j * 128 + p] = (bf16)f2bf(xlr[j] + cr); xp[j * 128 + 64 + p] = (bf16)f2bf(xli[j] + ci);
          const float nr = al1.x * cr - al1.y * ci, ni = al1.x * ci + al1.y * cr; cr = nr; ci = ni; } }
    asm volatile("s_waitcnt lgkmcnt(0)" ::: "memory");
    const int c = lane & 15, kq = lane >> 4;
    bf16x8 ax[4];
#pragma unroll
    for (int ks = 0; ks < 4; ++ks) ax[ks] = *(const __attribute__((address_space(3))) bf16x8*)(scr + c * 256 + (32 * ks + 8 * kq) * 2);
    asm volatile("s_waitcnt lgkmcnt(0)" ::: "memory");
    SUBP(3);
    const ldsp TMl = lds + TM_LDS + c * 32 + 16 * (kq & 1);
    const bf16* TMgl = (const bf16*)(ws + WS_TM) + (size_t)g * 17 * 256 + c * 16 + 8 * (kq & 1); (void)TMgl; (void)TMl;
    __attribute__((address_space(3))) bf16* zt = (__attribute__((address_space(3))) bf16*)scr;
#pragma unroll
    for (int t = 0; t < 16; ++t) { f32x4 acc = {0.f, 0.f, 0.f, 0.f};
#pragma unroll
        for (int ks = 0; ks < 4; ++ks) { const bf16x8 b = *(const __attribute__((address_space(3))) bf16x8*)(lds + (16 * t + c) * 256 + (((4 * ks + kq) ^ c) << 4));
            acc = __builtin_amdgcn_mfma_f32_16x16x32_bf16(ax[ks], b, acc, 0, 0, 0); }
#pragma unroll
        for (int ks = 0; ks <= t / 2; ++ks) { const int li = t - 2 * ks - (kq >> 1) + 1;
#if SSMB_TMG
            const bf16x8 b = *(const bf16x8*)(TMgl + (li < 0 ? 0 : li) * 256);
#else
            const bf16x8 b = *(const __attribute__((address_space(3))) bf16x8*)(TMl + (li < 0 ? 0 : li) * 512);
#endif
            acc = __builtin_amdgcn_mfma_f32_16x16x32_bf16(au[ks], b, acc, 0, 0, 0); }
#pragma unroll
        for (int e = 0; e < 4; ++e) { const float y = acc[e]; const float u2 = 1.5957691216057308f * (y + 0.044715f * y * y * y);
            const float z = y * __builtin_amdgcn_rcpf(1.f + __builtin_amdgcn_exp2f(-1.4426950408889634f * u2));
            zt[(16 * (4 * kq + e) + t) * 16 + c] = (bf16)f2bf(z); } }
    asm volatile("s_waitcnt lgkmcnt(0)" ::: "memory");
    SUBP(4);
    bf16* Z = (bf16*)(ws + WS_Z) + (size_t)tile * TILE * SW + 16 * g;
#pragma unroll
    for (int k = 0; k < 8; ++k) { const int item = lane + 64 * k, tok = item >> 1, hf = item & 1;
        const v4u v = *(const __attribute__((address_space(3))) v4u*)(scr + tok * 32 + hf * 16);
        *(v4u*)(Z + (size_t)tok * SW + 8 * hf) = v; }
    asm volatile("s_waitcnt lgkmcnt(0)" ::: "memory");
    if (PROBE_SUB >= 0) asm volatile("s_waitcnt vmcnt(0)" ::: "memory");
    SUBP(5);
}

constexpr unsigned AGG_TAG = 1u;
constexpr int XB_LDS = PART_LDS + 4096;
__device__ __forceinline__ void fused(const unsigned char* ws_, int b, int g, ldsp lds, ldsp scr, int tid) {
    unsigned char* ws = const_cast<unsigned char*>(ws_);
    const int lane = tid & 63, w = __builtin_amdgcn_readfirstlane(tid >> 6), tile = 8 * b + w, p = lane;
    typedef __attribute__((address_space(1))) unsigned long long gu64;
    gu64* AGG = (gu64*)(ws + WS_AGG) + (size_t)g * 8 * 128;
    const f32x2* ATP = (const f32x2*)(ws + WS_ATP) + (size_t)g * 64 * 64 + p;
    v4u tv[8]; table_load((const bf16*)(ws + WS_WST) + (size_t)g * 128 * 256, tid, tv);
    v4u tv2[8]; table_load((const bf16*)(ws + WS_WCR) + (size_t)g * 256 * 128, tid, tv2);
    v4u tmv[2]; { const v4u* TMg = (const v4u*)((const bf16*)(ws + WS_TM) + (size_t)g * 17 * 256); tmv[0] = TMg[tid]; tmv[1] = TMg[tid < 32 ? 512 + tid : tid]; }
    bf16x8 au[8]; load_u_frags((const bf16*)(ws + WS_U), tile, g, lane, au);
    const f32x2 al1 = ((const f32x2*)(ws + WS_ALP))[(g * 16 + 1) * 64 + p];
    f32x2 atw[8];
#pragma unroll
    for (int i = 0; i < 8; ++i) atw[i] = ATP[i * 64];
    table_store(tv, 5, lds, tid);
    { __attribute__((address_space(3))) v4u* tml = (__attribute__((address_space(3))) v4u*)(lds + TM_LDS); tml[tid] = tmv[0]; if (tid < 32) tml[512 + tid] = tmv[1]; }
    __syncthreads();
    const int n = lane & 15, kq = lane >> 4;
    { __attribute__((address_space(3))) float* s = (__attribute__((address_space(3))) float*)scr;
#pragma unroll
      for (int nt = 0; nt < 8; ++nt) { f32x4 acc = {0.f, 0.f, 0.f, 0.f};
#pragma unroll
        for (int ks = 0; ks < 8; ++ks) { const bf16x8 bb = *(const __attribute__((address_space(3))) bf16x8*)(lds + (16 * nt + n) * 512 + (((4 * ks + kq) ^ n) << 4));
            acc = __builtin_amdgcn_mfma_f32_16x16x32_bf16(au[ks], bb, acc, 0, 0, 0); }
#pragma unroll
        for (int e = 0; e < 4; ++e) s[(4 * kq + e) * 128 + 16 * nt + n] = acc[e]; } }
    asm volatile("s_waitcnt lgkmcnt(0)" ::: "memory");
    float xlr[NCH], xli[NCH];
    { const __attribute__((address_space(3))) float* s = (const __attribute__((address_space(3))) float*)scr; float xr = 0.f, xi = 0.f;
#pragma unroll
      for (int j = 0; j < NCH; ++j) { xlr[j] = xr; xli[j] = xi; const float sr = s[j * 128 + p], si = s[j * 128 + 64 + p];
          const float nr = al1.x * xr - al1.y * xi + sr, ni = al1.x * xi + al1.y * xr + si; xr = nr; xi = ni; }
      __attribute__((address_space(3))) float* st = (__attribute__((address_space(3))) float*)(lds + PART_LDS) + w * 128; st[p] = xr; st[64 + p] = xi; }
    __syncthreads();
    const __attribute__((address_space(3))) float* stl = (const __attribute__((address_space(3))) float*)(lds + PART_LDS);
    table_store(tv2, 4, lds, tid);
    if (w == 0) {
        float er = 0.f, ei = 0.f;
#pragma unroll
        for (int i = 0; i < 8; ++i) { const float sr = stl[i * 128 + p], si = stl[i * 128 + 64 + p]; const f32x2 a = atw[7 - i]; er += a.x * sr - a.y * si; ei += a.x * si + a.y * sr; }
        __hip_atomic_store(AGG + b * 128 + p, ((unsigned long long)AGG_TAG << 32) | __builtin_bit_cast(unsigned, er), __ATOMIC_RELAXED, __HIP_MEMORY_SCOPE_AGENT);
        __hip_atomic_store(AGG + b * 128 + 64 + p, ((unsigned long long)AGG_TAG << 32) | __builtin_bit_cast(unsigned, ei), __ATOMIC_RELAXED, __HIP_MEMORY_SCOPE_AGENT);
        float br = 0.f, bi = 0.f;
        if (b > 0) {
            unsigned long long vr[8], vi[8];
            for (unsigned spins = 0;; ++spins) { bool ok = true;
#pragma unroll
                for (int k = 0; k < 7; ++k) { const int kc = k < b ? k : 0;
                    vr[k] = __hip_atomic_load(AGG + kc * 128 + p, __ATOMIC_RELAXED, __HIP_MEMORY_SCOPE_AGENT); vi[k] = __hip_atomic_load(AGG + kc * 128 + 64 + p, __ATOMIC_RELAXED, __HIP_MEMORY_SCOPE_AGENT);
                    ok &= ((unsigned)(vr[k] >> 32) == AGG_TAG) & ((unsigned)(vi[k] >> 32) == AGG_TAG); }
                if (__all(ok) || spins > (1u << 16)) break;
                __builtin_amdgcn_s_sleep(2); }
            const f32x2 a8 = ATP[8 * 64];
            float pr = 1.f, pi = 0.f;
#pragma unroll
            for (int k = 6; k >= 0; --k) { if (k < b) { const float sr = __builtin_bit_cast(float, (unsigned)vr[k]), si = __builtin_bit_cast(float, (unsigned)vi[k]);
                    br += pr * sr - pi * si; bi += pr * si + pi * sr; const float nr = pr * a8.x - pi * a8.y, ni = pr * a8.y + pi * a8.x; pr = nr; pi = ni; } }
        }
        __attribute__((address_space(3))) float* xb = (__attribute__((address_space(3))) float*)(lds + XB_LDS); xb[p] = br; xb[64 + p] = bi;
    }
    __syncthreads();
    { const __attribute__((address_space(3))) float* xb = (const __attribute__((address_space(3))) float*)(lds + XB_LDS);
      const float br = xb[p], bi = xb[64 + p];
      float tr = atw[w & 7].x * br - atw[w & 7].y * bi, ti = atw[w & 7].x * bi + atw[w & 7].y * br;
#pragma unroll
      for (int i = 0; i < 7; ++i) { if (i < w) { const float sr = stl[i * 128 + p], si = stl[i * 128 + 64 + p]; const f32x2 a = atw[(w - 1 - i) & 7]; tr += a.x * sr - a.y * si; ti += a.x * si + a.y * sr; } }
      __attribute__((address_space(3))) bf16* xp = (__attribute__((address_space(3))) bf16*)scr;
      float cr = tr, ci = ti;
#pragma unroll
      for (int j = 0; j < NCH; ++j) { xp[j * 128 + p] = (bf16)f2bf(xlr[j] + cr); xp[j * 128 + 64 + p] = (bf16)f2bf(xli[j] + ci);
          const float nr = al1.x * cr - al1.y * ci, ni = al1.x * ci + al1.y * cr; cr = nr; ci = ni; } }
    asm volatile("s_waitcnt lgkmcnt(0)" ::: "memory");
    const int c = lane & 15;
    bf16x8 ax[4];
#pragma unroll
    for (int ks = 0; ks < 4; ++ks) ax[ks] = *(const __attribute__((address_space(3))) bf16x8*)(scr + c * 256 + (32 * ks + 8 * kq) * 2);
    asm volatile("s_waitcnt lgkmcnt(0)" ::: "memory");
    const ldsp TMl = lds + TM_LDS + c * 32 + 16 * (kq & 1);
    __attribute__((address_space(3))) bf16* zt = (__attribute__((address_space(3))) bf16*)scr;
#pragma unroll
    for (int t = 0; t < 16; ++t) { f32x4 acc = {0.f, 0.f, 0.f, 0.f};
#pragma unroll
        for (int ks = 0; ks < 4; ++ks) { const bf16x8 bb = *(const __attribute__((address_space(3))) bf16x8*)(lds + (16 * t + c) * 256 + (((4 * ks + kq) ^ c) << 4));
            acc = __builtin_amdgcn_mfma_f32_16x16x32_bf16(ax[ks], bb, acc, 0, 0, 0); }
#pragma unroll
        for (int ks = 0; ks <= t / 2; ++ks) { const int li = t - 2 * ks - (kq >> 1) + 1;
            const bf16x8 bb = *(const __attribute__((address_space(3))) bf16x8*)(TMl + (li < 0 ? 0 : li) * 512);
            acc = __builtin_amdgcn_mfma_f32_16x16x32_bf16(au[ks], bb, acc, 0, 0, 0); }
#pragma unroll
        for (int e = 0; e < 4; ++e) { const float y = acc[e]; const float u2 = 1.5957691216057308f * (y + 0.044715f * y * y * y);
            const float z = y * __builtin_amdgcn_rcpf(1.f + __builtin_amdgcn_exp2f(-1.4426950408889634f * u2));
            zt[(16 * (4 * kq + e) + t) * 16 + c] = (bf16)f2bf(z); } }
    asm volatile("s_waitcnt lgkmcnt(0)" ::: "memory");
    bf16* Z = (bf16*)(ws + WS_Z) + (size_t)tile * TILE * SW + 16 * g;
#pragma unroll
    for (int k = 0; k < 8; ++k) { const int item = lane + 64 * k, tok = item >> 1, hf = item & 1;
        const v4u v = *(const __attribute__((address_space(3))) v4u*)(scr + tok * 32 + hf * 16);
        *(v4u*)(Z + (size_t)tok * SW + 8 * hf) = v; }
    asm volatile("s_waitcnt lgkmcnt(0)" ::: "memory");
}
}

struct Args { const float* in[21]; float* out; unsigned char* ws; int ph_lo, ph_hi; };
struct Frame {
    LAS unsigned char* lds;
    int tid, lane, wave, G, bid;
    const float* in[21]; float* out; unsigned char* ws;
};
#define P_X 0
#define P_G1 1
#define P_WIN 2
#define P_GQ 3
#define P_GK 4
#define P_ARE 5
#define P_AIM 6
#define P_LDT 7
#define P_BRE 8
#define P_BIM 9
#define P_CRE 10
#define P_CIM 11
#define P_DSK 12
#define P_GLUW 13
#define P_GLUB 14
#define P_GA 15
#define P_GS 16
#define P_WOUT 17
#define P_G2 18
#define P_WUP 19
#define P_WDOWN 20

__device__ __forceinline__ void p0_transpose_item(const float* W, int K, int N, bf16* WT, const float* g_lo, const float* g_hi, int split, LAS float* scr, int item, int lane) {
    const int nblk = N / 32, kb = item / nblk, nb = item % nblk, k0 = 64 * kb, n0 = 32 * nb;
    f32x4 v[8];
#pragma unroll
    for (int i = 0; i < 8; ++i) v[i] = *(const GAS f32x4*)(W + (size_t)(k0 + 8 * i + (lane >> 3)) * N + n0 + 4 * (lane & 7));
#pragma unroll
    for (int i = 0; i < 8; ++i) { const int kk = 8 * i + (lane >> 3), k = k0 + kk;
        const float g = g_lo ? (k < split ? g_lo[k] : g_hi[k - split]) : 1.f;
        LAS float* d = scr + kk * 33 + 4 * (lane & 7);
        d[0] = v[i][0] * g; d[1] = v[i][1] * g; d[2] = v[i][2] * g; d[3] = v[i][3] * g; }
    asm volatile("s_waitcnt lgkmcnt(0)" ::: "memory");
    const int c = lane & 7;
#pragma unroll
    for (int j = 0; j < 4; ++j) { const int n = (lane >> 3) + 8 * j; const LAS float* s = scr + (8 * c) * 33 + n;
        v4u o; o.x = pk2(s[0 * 33], s[1 * 33]); o.y = pk2(s[2 * 33], s[3 * 33]); o.z = pk2(s[4 * 33], s[5 * 33]); o.w = pk2(s[6 * 33], s[7 * 33]);
        *(GAS v4u*)(WT + (size_t)(n0 + n) * K + k0 + 8 * c) = o; }
    asm volatile("s_waitcnt lgkmcnt(0)" ::: "memory");
}
__device__ __forceinline__ void rms_row_to_bf16(const float* xrow, bf16* orow, int lane) {
    const GAS f32x4* xr = (const GAS f32x4*)xrow + lane;
    f32x4 v[4]; float s = 0.f;
#pragma unroll
    for (int j = 0; j < 4; ++j) { v[j] = xr[64 * j]; s += (v[j].x * v[j].x + v[j].y * v[j].y) + (v[j].z * v[j].z + v[j].w * v[j].w); }
    const float rstd = 1.f / sqrtf(wave_sum(s) * (1.f / D) + EPS);
    GAS unsigned long long* o8 = (GAS unsigned long long*)orow + lane;
#pragma unroll
    for (int j = 0; j < 4; ++j) o8[64 * j] = (unsigned long long)pk2(v[j].x * rstd, v[j].y * rstd) | ((unsigned long long)pk2(v[j].z * rstd, v[j].w * rstd) << 32);
}
struct cd { double re, im; };
__device__ __forceinline__ cd cmul(cd a, cd b) { return cd{a.re * b.re - a.im * b.im, a.re * b.im + a.im * b.re}; }
struct cf { float re, im; };
__device__ __forceinline__ cf cmulf(cf a, cf b) { return cf{a.re * b.re - a.im * b.im, a.re * b.im + a.im * b.re}; }
__device__ __forceinline__ cf cpow_n(double lr, double li, double dt, double n) {
    const double ex = n * lr * dt; double rev = n * li * dt * 0.15915494309189535; rev -= rint(rev);
    float sn, cs; sincosf((float)(rev * 6.283185307179586), &sn, &cs); const float mag = expf((float)ex);
    return cf{mag * cs, mag * sn};
}
constexpr int NPART = 8;
__device__ __forceinline__ void p0_ssm_tables(Frame& F, int g, int part) {
    cf* apow = (cf*)(__attribute__((address_space(3))) cf*)(F.lds);
    cf* bbar = apow + 17 * 64;
    cf* cc = bbar + 64 * 16;
    cf* coef = cc + 16 * 64;
    const float* a_re = F.in[P_ARE] + g * 64; const float* a_im = F.in[P_AIM] + g * 64;
    const double dt = exp((double)F.in[P_LDT][g]);
    const int tid = F.tid;
    for (int i = tid; i < 17 * 64; i += NTHREADS) { const int j = i >> 6, p = i & 63; apow[i] = cpow_n(a_re[p], a_im[p], dt, (double)j); }
    for (int i = tid; i < 16 * 64; i += NTHREADS) cc[i] = cf{F.in[P_CRE][g * 1024 + i], F.in[P_CIM][g * 1024 + i]};
    if (tid < 64) { const int p = tid; const double lr = a_re[p], li = a_im[p];
        const double mag = exp(lr * dt); double sn, cs; sincos(li * dt, &sn, &cs); const double abr = mag * cs, abi = mag * sn;
        const double den = lr * lr + li * li, nr = abr - 1.0, ni = abi; coef[p] = cf{(float)((nr * lr + ni * li) / den), (float)((ni * lr - nr * li) / den)}; }
    __syncthreads();
    for (int i = tid; i < 64 * 16; i += NTHREADS) { const int p = i >> 4, c = i & 15;
        bbar[i] = cmulf(coef[p], cf{F.in[P_BRE][(g * 64 + p) * 16 + c], F.in[P_BIM][(g * 64 + p) * 16 + c]}); }
    __syncthreads();
    bf16* TM = (bf16*)(F.ws + WS_TM) + (size_t)g * 17 * 256;
    bf16* WST = (bf16*)(F.ws + WS_WST) + (size_t)g * 128 * 256;
    bf16* WCR = (bf16*)(F.ws + WS_WCR) + (size_t)g * 256 * 128;
    f32x2* ALP = (f32x2*)(F.ws + WS_ALP) + (size_t)g * 16 * 64;
    f32x2* ATP = (f32x2*)(F.ws + WS_ATP) + (size_t)g * 64 * 64;
    const int t0 = tid + NTHREADS * part, tstride = NTHREADS * NPART;
    for (int i = t0; i < 17 * 256; i += tstride) { const int l1 = i >> 8, c = (i >> 4) & 15, c2 = i & 15; float s = 0.f;
        if (l1 > 0) { const int lag = l1 - 1;
            for (int p = 0; p < 64; ++p) { const cf t = cmulf(cmulf(cc[c * 64 + p], apow[lag * 64 + p]), bbar[p * 16 + c2]); s += t.re; }
            if (lag == 0 && c == c2) s += F.in[P_DSK][g * 16 + c]; }
        TM[i] = (bf16)f2bf(s); }
    for (int i = t0; i < 128 * 256; i += tstride) { const int q = i >> 8, k = i & 255, s = k >> 4, c2 = k & 15, p = q & 63;
        const cf w = cmulf(apow[(15 - s) * 64 + p], bbar[p * 16 + c2]); WST[i] = (bf16)f2bf(q < 64 ? w.re : w.im); }
    for (int i = t0; i < 256 * 128; i += tstride) { const int n = i >> 7, q = i & 127, t = n >> 4, c = n & 15, p = q & 63;
        const cf w = cmulf(cc[c * 64 + p], apow[(t + 1) * 64 + p]); WCR[i] = (bf16)f2bf(q < 64 ? w.re : -w.im); }
    for (int i = t0; i < 16 * 64; i += tstride) { const int j = i >> 6, p = i & 63; const cf w = cpow_n(a_re[p], a_im[p], dt, 16.0 * j); ALP[i] = (f32x2){w.re, w.im}; }
    for (int i = t0; i < 64 * 64; i += tstride) { const int m = i >> 6, p = i & 63; const cf w = cpow_n(a_re[p], a_im[p], dt, 256.0 * m); ATP[i] = (f32x2){w.re, w.im}; }
    __syncthreads();
}
constexpr int XR = 8;
__device__ __forceinline__ void xn_load(Frame& F, int m0, int NGW, f32x4 (&v)[XR][4]) {
#pragma unroll
    for (int r = 0; r < XR; ++r) { const int m = (m0 + r * NGW) < M ? (m0 + r * NGW) : m0; const GAS f32x4* xr = (const GAS f32x4*)(F.in[P_X] + (size_t)m * D) + F.lane;
#pragma unroll
        for (int j = 0; j < 4; ++j) v[r][j] = xr[64 * j]; }
}
__device__ __forceinline__ void xn_finish(Frame& F, int m0, int NGW, const f32x4 (&v)[XR][4]) {
#pragma unroll
    for (int r = 0; r < XR; ++r) { float s = 0.f;
#pragma unroll
        for (int j = 0; j < 4; ++j) s += (v[r][j].x * v[r][j].x + v[r][j].y * v[r][j].y) + (v[r][j].z * v[r][j].z + v[r][j].w * v[r][j].w);
        const float ms = sqrtf(wave_sum(s) * (1.f / D) + EPS), q = 1.f / ms; const int m = m0 + r * NGW;
        if (m < M) { if (F.lane == 0) ((float*)(F.ws + WS_RN1))[m] = ms;
            GAS unsigned long long* o8 = (GAS unsigned long long*)((bf16*)(F.ws + WS_XN) + (size_t)m * D) + F.lane;
#pragma unroll
            for (int j = 0; j < 4; ++j) o8[64 * j] = (unsigned long long)pk2(v[r][j].x * q, v[r][j].y * q) | ((unsigned long long)pk2(v[r][j].z * q, v[r][j].w * q) << 32); } }
}
__device__ __forceinline__ void p0_prologue(Frame& F) {
    const int gw = F.bid * NWAVES + F.wave, NGW = F.G * NWAVES;
    f32x4 xv[XR][4]; xn_load(F, gw, NGW, xv);
    { typedef GAS unsigned long long gu64; gu64* AGG = (gu64*)(F.ws + WS_AGG);
      for (int i = F.bid * NTHREADS + F.tid; i < NG * 8 * 128; i += F.G * NTHREADS) __hip_atomic_store(AGG + i, 0ull, __ATOMIC_RELAXED, __HIP_MEMORY_SCOPE_AGENT); }
    for (int gp = F.bid; gp < NG * NPART; gp += F.G) p0_ssm_tables(F, gp & 31, gp >> 5);
    xn_finish(F, gw, NGW, xv);
    LAS float* scr = (LAS float*)(F.lds + F.wave * 16384);
    constexpr int I_IN = (D / 64) * (PW / 32), I_GLU = (SW / 64) * (SW / 32);
    constexpr int NITEMS = I_IN + I_GLU;
    for (int it = gw; it < NITEMS; it += NGW) {
        int r = it;
        if (r < I_IN) { p0_transpose_item(F.in[P_WIN], D, PW, (bf16*)(F.ws + WS_WIN), F.in[P_G1], F.in[P_G1], D, scr, r, F.lane); continue; } r -= I_IN;
        p0_transpose_item(F.in[P_GLUW], SW, SW, (bf16*)(F.ws + WS_WGLU), nullptr, nullptr, 0, scr, r, F.lane);
    }
    for (int m0 = gw + XR * NGW; m0 < M; m0 += XR * NGW) { xn_load(F, m0, NGW, xv); xn_finish(F, m0, NGW, xv); }
}

__device__ __forceinline__ void p4_late_weights(Frame& F, int gw, int ngw) {
    LAS float* scr = (LAS float*)(F.lds + F.wave * 16384);
    constexpr int I_OUT = (D / 64) * (D / 32), I_UP = (D / 64) * (FF / 32), I_DOWN = (FF / 64) * (D / 32);
    for (int it = gw; it < I_OUT + I_UP + I_DOWN; it += ngw) {
        int r = it;
        if (r < I_OUT) { p0_transpose_item(F.in[P_WOUT], D, D, (bf16*)(F.ws + WS_WOUT), F.in[P_GA], F.in[P_GS], AW, scr, r, F.lane); continue; } r -= I_OUT;
        if (r < I_UP) { p0_transpose_item(F.in[P_WUP], D, FF, (bf16*)(F.ws + WS_WUP), F.in[P_G2], F.in[P_G2], D, scr, r, F.lane); continue; } r -= I_UP;
        p0_transpose_item(F.in[P_WDOWN], FF, D, (bf16*)(F.ws + WS_WDOWN), nullptr, nullptr, 0, scr, r, F.lane);
    }
}

__device__ __forceinline__ float att_shift(Frame& F) {
    float mq = 0.f, mk = 0.f;
    for (int i = 0; i < 64; ++i) { mq = fmaxf(mq, fabsf(F.in[P_GQ][i])); mk = fmaxf(mk, fabsf(F.in[P_GK][i])); }
    return 64.f * mq * mk * C2 * 1.0001f;
}
__device__ __forceinline__ void p1_naive(Frame& F) {
    const bf16* XN = (const bf16*)(F.ws + WS_XN); const bf16* W = (const bf16*)(F.ws + WS_WIN);
    const size_t total = (size_t)M * PW, nthr = (size_t)F.G * NTHREADS;
    for (size_t idx = (size_t)F.bid * NTHREADS + F.tid; idx < total; idx += nthr) {
        const int m = (int)(idx / PW), n = (int)(idx % PW);
        const float acc = dot_bf16(XN + (size_t)m * D, W + (size_t)n * D, D);
        const int seg = n >> 9, c = n & 511;
        float v = acc;
        if (seg < 2) { const float ss = wave_sum(acc * acc); const float r = 1.f / sqrtf(ss * (1.f / 64.f) + EPS);
            v = acc * r * (seg == 0 ? F.in[P_GQ][c & 63] * C2 : F.in[P_GK][c & 63]); }
        bf16* dst = (bf16*)(F.ws + (seg == 0 ? WS_Q : seg == 1 ? WS_K : seg == 2 ? WS_V : WS_U));
        dst[(size_t)m * AW + c] = (bf16)f2bf(v);
    }
}
__device__ __forceinline__ void p2_attn_naive(Frame& F) {
    const bf16* Q = (const bf16*)(F.ws + WS_Q); const bf16* K = (const bf16*)(F.ws + WS_K); const bf16* V = (const bf16*)(F.ws + WS_V);
    bf16* ATT = (bf16*)(F.ws + WS_MIX); float* SSQA = (float*)(F.ws + WS_SSQA);
    const float shift = att_shift(F);
    const int gw = F.bid * NWAVES + F.wave, NGW = F.G * NWAVES;
    for (int it = gw; it < M * NH; it += NGW) {
        const int m = it >> 3, h = it & 7; const int col = h * 64 + F.lane;
        const float q = bf2f(Q[(size_t)m * AW + col]);
        float o = 0.f, l = 0.f;
        for (int di = 0; di < 3; ++di) { const int d = di == 0 ? 1 : di == 1 ? 4 : 16;
            for (int mm = 0; mm <= 128; ++mm) { const int j = m - d * mm; if (j < 0) break;
                const float s = wave_sum(q * bf2f(K[(size_t)j * AW + col]));
                const float p = exp2f(s - shift);
                l += p; o += p * bf2f(V[(size_t)j * AW + col]); } }
        const float r = o / l;
        ATT[(size_t)m * D + col] = (bf16)f2bf(r);
        const float ss = wave_sum(r * r);
        if (F.lane == 0) SSQA[m * 8 + h] = ss;
    }
}
__device__ __forceinline__ void p2_ssmA_naive(Frame& F) {
    const bf16* U = (const bf16*)(F.ws + WS_U);
    const size_t nthr = (size_t)F.G * NTHREADS;
    for (size_t idx = (size_t)F.bid * NTHREADS + F.tid; idx < (size_t)NTILE * NG * 64; idx += nthr) {
        const int p = (int)(idx & 63), g = (int)((idx >> 6) & 31), tile = (int)(idx >> 11);
        const bf16* Wr = (const bf16*)(F.ws + WS_WST) + ((size_t)g * 128 + p) * 256; const bf16* Wi = Wr + 64 * 256;
        const f32x2 al = ((const f32x2*)(F.ws + WS_ALP))[(g * 16 + 1) * 64 + p];
        float* XLOC = (float*)(F.ws + WS_XLOC) + ((size_t)(tile * NG + g) * 16) * 128;
        float xr = 0.f, xi = 0.f;
        for (int j = 0; j < NCH; ++j) {
            XLOC[j * 128 + p] = xr; XLOC[j * 128 + 64 + p] = xi;
            float sr = 0.f, si = 0.f;
            for (int k = 0; k < 256; ++k) { const float u = bf2f(U[(size_t)(tile * TILE + j * LCH + (k >> 4)) * SW + g * 16 + (k & 15)]); sr += u * bf2f(Wr[k]); si += u * bf2f(Wi[k]); }
            const float nr = al.x * xr - al.y * xi + sr, ni = al.x * xi + al.y * xr + si; xr = nr; xi = ni;
        }
        float* ST = (float*)(F.ws + WS_STILE) + (size_t)(tile * NG + g) * 128; ST[p] = xr; ST[64 + p] = xi;
    }
}
__device__ __forceinline__ float gelu_tanh(float y) { const float t = tanhf(0.7978845608028654f * (y + 0.044715f * y * y * y)); return 0.5f * y * (1.f + t); }
__device__ __forceinline__ void p3_ssmB_naive(Frame& F) {
    const bf16* U = (const bf16*)(F.ws + WS_U); bf16* Z = (bf16*)(F.ws + WS_Z);
    LAS float* xp = (LAS float*)F.lds;
    for (int pair = F.bid; pair < NTILE * NG; pair += F.G) {
        const int tile = pair >> 5, g = pair & 31;
        if (F.tid < 64) { const int p = F.tid; float tr = 0.f, ti = 0.f;
            const f32x2* ATP = (const f32x2*)(F.ws + WS_ATP) + (size_t)g * 64 * 64;
            for (int j = 0; j < tile; ++j) { const f32x2 a = ATP[(tile - 1 - j) * 64 + p]; const float* ST = (const float*)(F.ws + WS_STILE) + (size_t)(j * NG + g) * 128;
                const float sr = ST[p], si = ST[64 + p]; tr += a.x * sr - a.y * si; ti += a.x * si + a.y * sr; }
            const float* XLOC = (const float*)(F.ws + WS_XLOC) + ((size_t)(tile * NG + g) * 16) * 128;
            const f32x2* ALP = (const f32x2*)(F.ws + WS_ALP) + (size_t)g * 16 * 64;
            for (int j = 0; j < NCH; ++j) { const f32x2 a = ALP[j * 64 + p];
                xp[j * 128 + p] = XLOC[j * 128 + p] + a.x * tr - a.y * ti; xp[j * 128 + 64 + p] = XLOC[j * 128 + 64 + p] + a.x * ti + a.y * tr; } }
        __syncthreads();
        const bf16* TM = (const bf16*)(F.ws + WS_TM) + (size_t)g * 17 * 256; const bf16* WCR = (const bf16*)(F.ws + WS_WCR) + (size_t)g * 256 * 128;
        for (int o = F.tid; o < TILE * 16; o += NTHREADS) { const int tl = o >> 4, c = o & 15, j = tl >> 4, t = tl & 15; float y = 0.f;
            for (int s = 0; s <= t; ++s) { const bf16* tm = TM + ((t - s + 1) * 16 + c) * 16; const bf16* u = U + (size_t)(tile * TILE + j * LCH + s) * SW + g * 16;
                for (int c2 = 0; c2 < 16; ++c2) y += bf2f(tm[c2]) * bf2f(u[c2]); }
            const bf16* wc = WCR + (size_t)(t * 16 + c) * 128;
            for (int q = 0; q < 128; ++q) y += xp[j * 128 + q] * bf2f(wc[q]);
            Z[(size_t)(tile * TILE + tl) * SW + g * 16 + c] = (bf16)f2bf(gelu_tanh(y)); }
        __syncthreads();
    }
}
__device__ __forceinline__ void p4_glu_naive(Frame& F) {
    const bf16* Z = (const bf16*)(F.ws + WS_Z); const bf16* W = (const bf16*)(F.ws + WS_WGLU); bf16* O = (bf16*)(F.ws + WS_MIX) + AW; float* SSQS = (float*)(F.ws + WS_SSQS);
    const size_t total = (size_t)M * SW, nthr = (size_t)F.G * NTHREADS;
    for (size_t idx = (size_t)F.bid * NTHREADS + F.tid; idx < total; idx += nthr) {
        const int m = (int)(idx >> 9), n = (int)(idx & 511);
        const float acc = dot_bf16(Z + (size_t)m * SW, W + (size_t)n * SW, SW) + F.in[P_GLUB][n];
        const float z = bf2f(Z[(size_t)m * SW + n]); const float o = z / (1.f + expf(-acc));
        O[(size_t)m * D + n] = (bf16)f2bf(o);
        const float ss = wave_sum(o * o); if (F.lane == 0) SSQS[m * 8 + (n >> 6)] = ss;
    }
}
__device__ __forceinline__ void p5_out_naive(Frame& F) {
    const bf16* A = (const bf16*)(F.ws + WS_MIX); const bf16* S = (const bf16*)(F.ws + WS_MIX) + AW; const bf16* W = (const bf16*)(F.ws + WS_WOUT);
    const float* SSQA = (const float*)(F.ws + WS_SSQA); const float* SSQS = (const float*)(F.ws + WS_SSQS); float* SSQ2 = (float*)(F.ws + WS_SSQ2); bf16* X1B = (bf16*)(F.ws + WS_XN);
    const size_t total = (size_t)M * D, nthr = (size_t)F.G * NTHREADS;
    for (size_t idx = (size_t)F.bid * NTHREADS + F.tid; idx < total; idx += nthr) {
        const int m = (int)(idx >> 10), n = (int)(idx & 1023);
        float sa = 0.f, ss = 0.f;
        for (int i = 0; i < 8; ++i) { sa += SSQA[m * 8 + i]; ss += SSQS[m * 8 + i]; }
        const float ra = 1.f / sqrtf(sa * (1.f / 512.f) + EPS), rs = 1.f / sqrtf(ss * (1.f / 512.f) + EPS);
        const float accA = dot_bf16(A + (size_t)m * D, W + (size_t)n * D, AW), accS = dot_bf16(S + (size_t)m * D, W + (size_t)n * D + AW, SW);
        const float x1 = F.in[P_X][(size_t)m * D + n] + ra * accA + rs * accS;
        F.out[(size_t)m * D + n] = x1; X1B[(size_t)m * D + n] = (bf16)f2bf(x1);
        const float q = wave_sum(x1 * x1); if (F.lane == 0) SSQ2[m * 16 + (n >> 6)] = q;
    }
}
__device__ __forceinline__ void p6_up_naive(Frame& F) {
    const bf16* A = (const bf16*)(F.ws + WS_XN); const bf16* W = (const bf16*)(F.ws + WS_WUP); const float* SSQ2 = (const float*)(F.ws + WS_SSQ2); bf16* H = (bf16*)(F.ws + WS_H);
    const size_t total = (size_t)M * FF, nthr = (size_t)F.G * NTHREADS;
    for (size_t idx = (size_t)F.bid * NTHREADS + F.tid; idx < total; idx += nthr) {
        const int m = (int)(idx >> 12), n = (int)(idx & 4095);
        float s2 = 0.f; for (int i = 0; i < 16; ++i) s2 += SSQ2[m * 16 + i];
        const float r2 = 1.f / sqrtf(s2 * (1.f / 1024.f) + EPS);
        const float a = fmaxf(r2 * dot_bf16(A + (size_t)m * D, W + (size_t)n * D, D), 0.f);
        H[(size_t)m * FF + n] = (bf16)f2bf(a * a);
    }
}
__device__ __forceinline__ void p7_down_naive(Frame& F) {
    const bf16* H = (const bf16*)(F.ws + WS_H); const bf16* W = (const bf16*)(F.ws + WS_WDOWN);
    const size_t total = (size_t)M * D, nthr = (size_t)F.G * NTHREADS;
    for (size_t idx = (size_t)F.bid * NTHREADS + F.tid; idx < total; idx += nthr) {
        const int m = (int)(idx >> 10), n = (int)(idx & 1023);
        F.out[(size_t)m * D + n] += dot_bf16(H + (size_t)m * FF, W + (size_t)n * FF, FF);
    }
}


__device__ __forceinline__ int wg_pm(int c) { return 8 * (c & 7) + ((c >> 3) & 7); }
__device__ __forceinline__ void p1_fast(Frame& F) {
    pg8::Gemm g{(const bf16*)(F.ws + WS_XN), (const bf16*)(F.ws + WS_WIN), M, PW, D}; pg8::StaticOrder S; S.init(M, PW, F.G, F.bid);
    pg8::EpiInProj E{(bf16*)(F.ws + WS_Q), (bf16*)(F.ws + WS_K), (bf16*)(F.ws + WS_V), (bf16*)(F.ws + WS_U), F.in[P_GQ], F.in[P_GK]};
    pg8::gemm_phase<pg8::EpiInProj, pg8::StaticOrder, true>(F.lds, g, S, E);
}
__device__ __forceinline__ void p4_fast(Frame& F) {
    constexpr int GLU_UNITS = (M / 256) * (SW / 256);
    if (F.G > GLU_UNITS) { if (F.bid >= GLU_UNITS) { p4_late_weights(F, (F.bid - GLU_UNITS) * NWAVES + F.wave, (F.G - GLU_UNITS) * NWAVES); return; } }
    else p4_late_weights(F, F.bid * NWAVES + F.wave, F.G * NWAVES);
    pg8::Gemm g{(const bf16*)(F.ws + WS_Z), (const bf16*)(F.ws + WS_WGLU), M, SW, SW}; pg8::StaticOrder S; S.init(M, SW, F.G, F.bid);
    pg8::EpiGlu E{(const bf16*)(F.ws + WS_Z), (bf16*)(F.ws + WS_MIX) + AW, F.in[P_GLUB], (float*)(F.ws + WS_SSQS)};
    pg8::gemm_phase<pg8::EpiGlu, pg8::StaticOrder, true>(F.lds, g, S, E);
}
__device__ __forceinline__ void p5_fast(Frame& F) {
    pg8::Gemm g{(const bf16*)(F.ws + WS_MIX), (const bf16*)(F.ws + WS_WOUT), M, D, D}; pg8::StaticOrder S; S.init(M, D, F.G, F.bid);
    pg8::EpiOut E{F.in[P_X], F.out, (bf16*)(F.ws + WS_XN), (float*)(F.ws + WS_SSQ2), (const float*)(F.ws + WS_SSQA), (const float*)(F.ws + WS_SSQS), (const float*)(F.ws + WS_RN1)};
    pg8::gemm_phase<pg8::EpiOut, pg8::StaticOrder, true>(F.lds, g, S, E);
}
__device__ __forceinline__ void p6_fast(Frame& F) {
    pg8::Gemm g{(const bf16*)(F.ws + WS_XN), (const bf16*)(F.ws + WS_WUP), M, FF, D}; pg8::StaticOrder S; S.init(M, FF, F.G, F.bid);
    pg8::EpiUp E{(bf16*)(F.ws + WS_H), (const float*)(F.ws + WS_SSQ2)};
    pg8::gemm_phase<pg8::EpiUp, pg8::StaticOrder, true>(F.lds, g, S, E);
}
__device__ __forceinline__ void p7_fast(Frame& F) {
    pg8::Gemm g{(const bf16*)(F.ws + WS_H), (const bf16*)(F.ws + WS_WDOWN), M, D, FF}; pg8::StaticOrder S; S.init(M, D, F.G, F.bid);
    pg8::EpiDown E{F.out, (const bf16*)(F.ws + WS_XN)};
    pg8::gemm_phase<pg8::EpiDown, pg8::StaticOrder, true>(F.lds, g, S, E);
}


__device__ __forceinline__ void p2_attn_fast(Frame& F) {
    float mq = fabsf(F.in[P_GQ][F.lane]), mk = fabsf(F.in[P_GK][F.lane]);
#pragma unroll
    for (int o = 1; o < 64; o <<= 1) { mq = fmaxf(mq, __shfl_xor(mq, o)); mk = fmaxf(mk, __shfl_xor(mk, o)); }
    const float nshift = -(64.f * mq * mk * C2 * 1.0001f);
    for (int u = F.bid; u < NH * (M / 512); u += F.G)
        att::unit((const bf16*)(F.ws + WS_Q), (const bf16*)(F.ws + WS_K), (const bf16*)(F.ws + WS_V), (bf16*)(F.ws + WS_MIX), (float*)(F.ws + WS_SSQA), u & 7, (u >> 3) * 512, nshift, F.lds, F.tid);
}


__device__ __forceinline__ void p2_ssmA_fast(Frame& F) {
    for (int batch = F.bid; batch < NTILE * NG / NWAVES; batch += F.G) { const int g = batch & 31, tile = (batch >> 5) * 8 + F.wave;
        __syncthreads();
        ssm::phaseA(F.ws, tile, g, F.lds, F.lds + 65536 + F.wave * 8192, F.tid); }
    __syncthreads();
}
__device__ __forceinline__ void p3_ssmB_fast(Frame& F, unsigned long long& ta, unsigned long long& tb) {
    for (int batch = F.bid; batch < NTILE * NG / NWAVES; batch += F.G) { const int g = batch & 31, base = (batch >> 5) * 8;
        __syncthreads();
        ssm::phaseB(F.ws, base, g, F.lds, F.lds + 65536 + F.wave * 8192, F.tid, ta, tb); }
    __syncthreads();
}

__device__ __forceinline__ void p2_ssm_fused(Frame& F) {
    for (int batch = F.bid; batch < NTILE * NG / NWAVES; batch += F.G) { const int g = batch & 31, b = batch >> 5;
        __syncthreads();
        ssm::fused(F.ws, b, g, F.lds, F.lds + 65536 + F.wave * 8192, F.tid); }
    __syncthreads();
}

constexpr int N_PHASES = 8;
__global__ void __launch_bounds__(NTHREADS, 2) mk_fwd(Args args) {
    extern __shared__ __attribute__((aligned(16))) unsigned char lds_raw[];
    Frame F;
    F.lds = (LAS unsigned char*)lds_raw;
    F.tid = threadIdx.x; F.lane = F.tid & 63; F.wave = __builtin_amdgcn_readfirstlane(F.tid >> 6);
    F.G = gridDim.x; F.bid = blockIdx.x;
#pragma unroll
    for (int i = 0; i < 21; ++i) F.in[i] = args.in[i];
    F.out = args.out; F.ws = args.ws;
    volatile LAS unsigned* MISC = (volatile LAS unsigned*)(F.lds + MISC_OFF);
    for (int u = F.tid; u < 64; u += NTHREADS) MISC[u] = 0u;
    __syncthreads();
    unsigned* const barw = USE_GLOBAL_BAR ? g_barrier_words : (unsigned*)(F.ws + WS_CTL) + CW_BAR;
    XcdBarrier bar; bar.bar = barw; bar.x = 0; bar.st = nullptr;
    if (!MK_SPLIT) bar = xcd_barrier_post(barw, MISC + 8);
    const int lo = args.ph_lo, hi = args.ph_hi;
#define IN(k) (lo <= (k) && (k) < hi)
#define SEAM(k) do { if (IN(k) && IN((k) + 1)) xcd_barrier(bar); } while (0)
#define REPS(bit) (((REP_MASK >> (bit)) & 1) ? REP_N : 1)
#define RUN(bit, body) do { _Pragma("unroll 1") for (int rep_ = 0; rep_ < REPS(bit); ++rep_) { if (rep_) xcd_barrier(bar); body; } } while (0)
#define STAMP_A(k) do { if (PROBE_PHASE == (k)) t_a = __builtin_amdgcn_s_memrealtime(); if (PROBE_PHASE == 30 + (k)) { t_a = __builtin_amdgcn_s_memrealtime(); c_a = __builtin_amdgcn_s_memtime(); } } while (0)
#define STAMP_B(k) do { if (PROBE_PHASE == (k)) t_b = __builtin_amdgcn_s_memrealtime(); if (PROBE_PHASE == 30 + (k)) { t_b = __builtin_amdgcn_s_memrealtime(); c_b = __builtin_amdgcn_s_memtime(); } } while (0)
    unsigned long long t_a = 0, t_b = 0, c_a = 0, c_b = 0;
    if (PROBE_PHASE == 9) t_a = __builtin_amdgcn_s_memrealtime();
    STAMP_A(0); if (IN(0)) { RUN(0, p0_prologue(F)); } SEAM(0); STAMP_B(0);
    STAMP_A(1); if (IN(1)) { RUN(1, if (FAST_MASK & 2) p1_fast(F); else p1_naive(F)); } SEAM(1); STAMP_B(1);
    STAMP_A(2); if (IN(2)) { RUN(8, if (SSM_FUSED) p2_ssm_fused(F); else if (FAST_MASK & 1) p2_ssmA_fast(F); else p2_ssmA_naive(F)); STAMP_A(8); RUN(2, if (FAST_MASK & 4) p2_attn_fast(F); else p2_attn_naive(F)); } SEAM(2); STAMP_B(2); STAMP_B(8);
    if (!SSM_FUSED) { STAMP_A(3); if (IN(3)) { RUN(3, if (FAST_MASK & 8) p3_ssmB_fast(F, t_a, t_b); else p3_ssmB_naive(F)); } SEAM(3); STAMP_B(3); }
    STAMP_A(4); STAMP_A(14); if (IN(4)) { RUN(4, if (FAST_MASK & 16) p4_fast(F); else p4_glu_naive(F)); } if (PROBE_PHASE == 14) asm volatile("s_waitcnt vmcnt(0)" ::: "memory"); STAMP_B(14); SEAM(4); STAMP_B(4);
    STAMP_A(5); if (IN(5)) { RUN(5, if (FAST_MASK & 32) p5_fast(F); else p5_out_naive(F)); } SEAM(5); STAMP_B(5);
    STAMP_A(6); if (IN(6)) { RUN(6, if (FAST_MASK & 64) p6_fast(F); else p6_up_naive(F)); } SEAM(6); STAMP_B(6);
    STAMP_A(7); if (IN(7)) { if (FAST_MASK & 128) p7_fast(F); else p7_down_naive(F); }
    if (PROBE_PHASE >= 0 || PROBE_SUB >= 0) { asm volatile("s_waitcnt vmcnt(0)" ::: "memory"); if (PROBE_PHASE == 7 || PROBE_PHASE == 9) t_b = __builtin_amdgcn_s_memrealtime(); if (PROBE_PHASE == 37) { t_b = __builtin_amdgcn_s_memrealtime(); c_b = __builtin_amdgcn_s_memtime(); }
        if (PROBE_PHASE >= 30) { if (F.bid == 0 && F.tid == 0) F.out[0] += 5.f * floorf((float)(c_b - c_a) / (float)(t_b - t_a) * 2.f + 0.5f); }
        else if (F.bid == 0 && F.tid == 0) F.out[0] += (PROBE_SUB >= 0) ? 10.f * floorf((float)(t_b - t_a) * 0.005f + 0.5f) : (PROBE_PHASE == 9) ? floorf((float)(t_b - t_a) * 0.001f + 0.5f) : 2.f * floorf((float)(t_b - t_a) * 0.005f + 0.5f); }
#undef STAMP_A
#undef STAMP_B
    if (USE_GLOBAL_BAR && !MK_SPLIT) {
        __syncthreads();
        if (F.tid == 0) { const unsigned old = xb_add(&barw[XB_EXIT], 1u); MISC[16] = (old + 1u == (unsigned)F.G) ? 1u : 0u; }
        __syncthreads();
        if (MISC[16]) { for (int i = F.tid; i < XCD_BAR_WORDS + 64; i += NTHREADS) __hip_atomic_store(&barw[i], 0u, __ATOMIC_RELAXED, __HIP_MEMORY_SCOPE_AGENT); }
    }
#undef RUN
#undef REPS
#undef IN
#undef SEAM
}

extern "C" void kernel_launch(void* const* d_in, const int* in_sizes, int n_in, void* d_out, int out_size, void* d_ws, size_t ws_size, hipStream_t stream) {
    static int grid = 0;
    if (grid == 0) {
        if (n_in != 21 || in_sizes[0] != M * D || out_size != M * D || ws_size < WS_END) { fprintf(stderr, "kernel_launch: unexpected shapes (n_in %d, in0 %d, out %d, ws %zu)\n", n_in, n_in > 0 ? in_sizes[0] : -1, out_size, ws_size); grid = -1; return; }
        int dev = 0, cus = 0;
        if (hipGetDevice(&dev) != hipSuccess || hipDeviceGetAttribute(&cus, hipDeviceAttributeMultiprocessorCount, dev) != hipSuccess) { grid = -1; return; }
        if (hipFuncSetAttribute((const void*)mk_fwd, hipFuncAttributeMaxDynamicSharedMemorySize, LDS_BYTES) != hipSuccess) { fprintf(stderr, "kernel_launch: hipFuncSetAttribute failed\n"); grid = -1; return; }
        int per_cu = 0;
        if (hipOccupancyMaxActiveBlocksPerMultiprocessor(&per_cu, (const void*)mk_fwd, NTHREADS, LDS_BYTES) != hipSuccess || per_cu < 1) fprintf(stderr, "kernel_launch: occupancy query says %d\n", per_cu);
        (void)hipGetLastError();
        grid = cus;
    }
    if (grid < 0) return;
    if (!USE_GLOBAL_BAR) (void)hipMemsetAsync((char*)d_ws + WS_CTL, 0, CTL_ZERO_BYTES, stream);
    Args a{};
    for (int i = 0; i < 21; ++i) a.in[i] = (const float*)d_in[i];
    a.out = (float*)d_out; a.ws = (unsigned char*)d_ws;
    if (MK_SPLIT) {
        for (int p = 0; p < N_PHASES; ++p) { a.ph_lo = p; a.ph_hi = p + 1; hipLaunchKernelGGL(mk_fwd, dim3(grid), dim3(NTHREADS), LDS_BYTES, stream, a); }
    } else {
        a.ph_lo = 0; a.ph_hi = N_PHASES; hipLaunchKernelGGL(mk_fwd, dim3(grid), dim3(NTHREADS), LDS_BYTES, stream, a);
    }
}
```
